# Optimizing an MI355X kernel written in HIP

```python
import math
import jax, jax.numpy as jnp
from jax import lax
import numpy as np

D_MODEL = 1024
BATCH = 4
SEQ = 4096
DEPTH = 2

A_HEADS = 8
A_HEAD_DIM = 64
A_WIDTH = A_HEADS * A_HEAD_DIM
DILATED_CONFIGS = ((128, 1), (512, 4), (2048, 16))
A_BLOCK = 128
A_SPAN = A_BLOCK * max(d for _, d in DILATED_CONFIGS)
B_WIDTH = 512
B_GROUP = 16
B_GROUPS = B_WIDTH // B_GROUP
B_STATE = 64
AB_WIDTH = A_WIDTH + B_WIDTH
AB_IN = 3 * A_WIDTH + B_WIDTH + AB_WIDTH
C_HEADS = 8
C_DK = 128
C_DV = 128
C_CONV = 4
C_CHUNK = 64
C_WIDTH = C_HEADS * C_DV
QKV_WIDTH = 2 * C_HEADS * C_DK + C_WIDTH
C_IN = QKV_WIDTH + C_WIDTH + 2 * C_HEADS
REL_BUCKETS = 32
REL_MAX_DIST = 2048
N_EVEN = (DEPTH + 1) // 2
N_ODD = DEPTH // 2
EPS = 1e-6

kernel_name = "hybrid_dilated_s5_gdn_block"


def rms_norm(x, g):
    xf = x.astype(jnp.float32)
    y = xf * lax.rsqrt(jnp.mean(xf * xf, axis=-1, keepdims=True) + EPS)
    return (y * g.astype(jnp.float32)).astype(x.dtype)


def t5_bucket_np(dist):
    dist = np.maximum(dist, 0)
    max_exact = REL_BUCKETS // 2
    large = max_exact + (np.log(np.maximum(dist, 1) / max_exact)
                         / math.log(REL_MAX_DIST / max_exact) * (REL_BUCKETS - max_exact)).astype(np.int32)
    large = np.minimum(large, REL_BUCKETS - 1)
    return np.where(dist < max_exact, dist, large).astype(np.int32)


def dilated_attention(q, k, v, rel_bias):
    bsz, s_len = q.shape[:2]
    sp = -(-s_len // A_SPAN) * A_SPAN
    pad = ((0, 0), (0, sp - s_len), (0, 0), (0, 0))
    q, k, v = jnp.pad(q, pad), jnp.pad(k, pad), jnp.pad(v, pad)
    scale = A_HEAD_DIM ** -0.5
    qi = np.arange(A_BLOCK)[:, None]
    kj = np.arange(2 * A_BLOCK)[None, :]
    rel = qi + A_BLOCK - kj
    neg = jnp.finfo(jnp.float32).min
    outs, lses = [], []
    for window, dil in DILATED_CONFIGS:
        n_keys = window // dil
        nb = sp // dil // A_BLOCK
        qb, kb, vb = (t.reshape(bsz, nb, A_BLOCK, dil, A_HEADS, A_HEAD_DIM) for t in (q, k, v))
        prev = lambda t: jnp.pad(t[:, :-1], ((0, 0), (1, 0), (0, 0), (0, 0), (0, 0), (0, 0)))
        kw = jnp.concatenate([prev(kb), kb], axis=2)
        vw = jnp.concatenate([prev(vb), vb], axis=2)
        bias = jnp.transpose(rel_bias[t5_bucket_np(rel * dil)], (2, 0, 1)).astype(jnp.float32)
        band = (rel >= 0) & (rel <= n_keys)
        first = band & (kj >= A_BLOCK)
        blk_mask = np.concatenate([first[None], np.broadcast_to(band, (nb - 1,) + band.shape)], 0)
        s = jnp.einsum('bnqrhd,bnkrhd->bnrhqk', qb, kw, preferred_element_type=jnp.float32) * scale
        s = jnp.where(blk_mask[None, :, None, None], s + bias[None, None, None], neg)
        m = jnp.max(s, axis=-1, keepdims=True)
        p = jnp.exp(s - m)
        den = jnp.sum(p, axis=-1)
        o = jnp.einsum('bnrhqk,bnkrhd->bnqrhd', p, vw.astype(jnp.float32))
        den_t = jnp.transpose(den, (0, 1, 4, 2, 3))
        lse = jnp.transpose(m[..., 0], (0, 1, 4, 2, 3)) + jnp.log(den_t)
        outs.append((o / den_t[..., None]).reshape(bsz, sp, A_HEADS, A_HEAD_DIM))
        lses.append(lse.reshape(bsz, sp, A_HEADS))
    w = jax.nn.softmax(jnp.stack(lses, 0), axis=0)
    out = jnp.einsum('cbsh,cbshd->bshd', w, jnp.stack(outs, 0))
    return out[:, :s_len].reshape(bsz, s_len, A_WIDTH)


def _complex_affine_combine(e1, e2):
    a1r, a1i, b1r, b1i = e1
    a2r, a2i, b2r, b2i = e2
    return (a2r * a1r - a2i * a1i, a2r * a1i + a2i * a1r,
            a2r * b1r - a2i * b1i + b2r, a2r * b1i + a2i * b1r + b2i)


def s5_layer(u, a_re, a_im, log_dt, b_re, b_im, c_re, c_im, d_skip, glu_w, glu_b):
    bsz, s_len = u.shape[:2]
    uf = u.astype(jnp.float32)
    ug = uf.reshape(bsz, s_len, B_GROUPS, B_GROUP)
    dt = jnp.exp(log_dt.astype(jnp.float32))[:, None]
    ar, ai = a_re.astype(jnp.float32), a_im.astype(jnp.float32)
    mag = jnp.exp(dt * ar)
    abar_r, abar_i = mag * jnp.cos(dt * ai), mag * jnp.sin(dt * ai)
    den = ar * ar + ai * ai
    fr = ((abar_r - 1.0) * ar + abar_i * ai) / den
    fi = (abar_i * ar - (abar_r - 1.0) * ai) / den
    br, bi = b_re.astype(jnp.float32), b_im.astype(jnp.float32)
    bbar_r = fr[..., None] * br - fi[..., None] * bi
    bbar_i = fr[..., None] * bi + fi[..., None] * br
    bu_r = jnp.einsum('bsgm,gpm->bsgp', ug, bbar_r)
    bu_i = jnp.einsum('bsgm,gpm->bsgp', ug, bbar_i)
    a_r = jnp.broadcast_to(abar_r, bu_r.shape)
    a_i = jnp.broadcast_to(abar_i, bu_i.shape)
    _, _, x_r, x_i = lax.associative_scan(_complex_affine_combine, (a_r, a_i, bu_r, bu_i), axis=1)
    y = (jnp.einsum('gmp,bsgp->bsgm', c_re.astype(jnp.float32), x_r)
         - jnp.einsum('gmp,bsgp->bsgm', c_im.astype(jnp.float32), x_i))
    y = jax.nn.gelu(y.reshape(bsz, s_len, B_WIDTH) + d_skip.astype(jnp.float32) * uf)
    return (y * jax.nn.sigmoid(y @ glu_w.astype(jnp.float32) + glu_b.astype(jnp.float32))).astype(u.dtype)


def ab_mixer(h, w_in, w_out, rel_bias, a_re, a_im, log_dt, b_re, b_im, c_re, c_im, d_skip, glu_w, glu_b):
    bsz, s_len, _ = h.shape
    z = h @ w_in
    q, k, v, u, gate = jnp.split(z, [A_WIDTH, 2 * A_WIDTH, 3 * A_WIDTH, 3 * A_WIDTH + B_WIDTH], axis=-1)
    hs = (bsz, s_len, A_HEADS, A_HEAD_DIM)
    o_a = dilated_attention(q.reshape(hs), k.reshape(hs), v.reshape(hs), rel_bias).astype(h.dtype)
    o_b = s5_layer(u, a_re, a_im, log_dt, b_re, b_im, c_re, c_im, d_skip, glu_w, glu_b)
    o = jnp.concatenate([o_a, o_b], axis=-1) * jax.nn.silu(gate)
    return o @ w_out


def l2_normalize(t):
    return t * lax.rsqrt(jnp.sum(t * t, axis=-1, keepdims=True) + EPS)


def gdn_mixer(h, w_in, conv_w, a_log, dt_bias, norm_g, w_out):
    bsz, s_len, _ = h.shape
    z = h @ w_in
    qkv, gate, beta_raw, a_raw = jnp.split(z, [QKV_WIDTH, QKV_WIDTH + C_WIDTH, QKV_WIDTH + C_WIDTH + C_HEADS], axis=-1)
    qkv = lax.conv_general_dilated(qkv, conv_w[:, None, :].astype(qkv.dtype), (1,), [(C_CONV - 1, 0)],
                                   dimension_numbers=('NWC', 'WIO', 'NWC'), feature_group_count=QKV_WIDTH)
    qkv = jax.nn.silu(qkv).astype(jnp.float32)
    q, k, v = jnp.split(qkv, [C_HEADS * C_DK, 2 * C_HEADS * C_DK], axis=-1)
    q = l2_normalize(q.reshape(bsz, s_len, C_HEADS, C_DK)) * (C_DK ** -0.5)
    k = l2_normalize(k.reshape(bsz, s_len, C_HEADS, C_DK))
    v = v.reshape(bsz, s_len, C_HEADS, C_DV)
    beta = jax.nn.sigmoid(beta_raw.astype(jnp.float32))
    g = -jnp.exp(a_log.astype(jnp.float32)) * jax.nn.softplus(a_raw.astype(jnp.float32) + dt_bias.astype(jnp.float32))
    n_chunks = s_len // C_CHUNK

    def chunks(t):
        return jnp.moveaxis(t.reshape(bsz, n_chunks, C_CHUNK, C_HEADS, *t.shape[3:]), 3, 1)

    qc, kc, vc, bc = chunks(q), chunks(k), chunks(v), chunks(beta)
    gc = jnp.cumsum(chunks(g), axis=-1)
    idx = np.arange(C_CHUNK)
    tril = idx[:, None] >= idx[None, :]
    strict = idx[:, None] > idx[None, :]
    decay = jnp.exp(jnp.where(tril, gc[..., :, None] - gc[..., None, :], -jnp.inf))
    kb = kc * bc[..., None]
    lower = jnp.where(strict, jnp.einsum('bhnid,bhnjd->bhnij', kb, kc) * decay, 0.0)
    tri = lower + jnp.eye(C_CHUNK, dtype=lower.dtype)
    u_c = lax.linalg.triangular_solve(tri, vc * bc[..., None], left_side=True, lower=True, unit_diagonal=True)
    w_c = lax.linalg.triangular_solve(tri, kb * jnp.exp(gc)[..., None], left_side=True, lower=True, unit_diagonal=True)
    aqk = jnp.einsum('bhnid,bhnjd->bhnij', qc, kc) * decay
    qg = qc * jnp.exp(gc)[..., None]
    g_last = gc[..., -1]
    kd = kc * jnp.exp(g_last[..., None] - gc)[..., None]
    xs = tuple(jnp.moveaxis(t, 2, 0) for t in (w_c, u_c, qg, kd, aqk, jnp.exp(g_last)))

    def step(state, xs_c):
        w_i, u_i, qg_i, kd_i, aqk_i, dec_i = xs_c
        v_new = u_i - jnp.einsum('bhik,bhkv->bhiv', w_i, state)
        o_i = jnp.einsum('bhik,bhkv->bhiv', qg_i, state) + jnp.einsum('bhij,bhjv->bhiv', aqk_i, v_new)
        state = state * dec_i[..., None, None] + jnp.einsum('bhik,bhiv->bhkv', kd_i, v_new)
        return state, o_i

    s0 = jnp.zeros((bsz, C_HEADS, C_DK, C_DV), jnp.float32)
    _, o = lax.scan(step, s0, xs)
    o = jnp.transpose(o, (1, 0, 3, 2, 4)).reshape(bsz, s_len, C_HEADS, C_DV)
    o = rms_norm(o, norm_g).reshape(bsz, s_len, C_WIDTH).astype(h.dtype) * jax.nn.silu(gate)
    return o @ w_out


def setup_inputs(seed: int = 0) -> dict:
    key = jax.random.key(seed)
    ks = iter(jax.random.split(key, 32))
    nrm = lambda shape, s: jax.random.normal(next(ks), shape, jnp.float32) * s
    uni = lambda shape, lo, hi: jax.random.uniform(next(ks), shape, jnp.float32, lo, hi)
    n_idx = jnp.arange(B_STATE, dtype=jnp.float32)
    dt_c = uni((N_ODD, C_HEADS), 0.001, 0.1)
    return {
        "x": nrm((BATCH, SEQ, D_MODEL), 1.0),
        "c": nrm((BATCH, D_MODEL), 1.0),
        "ada_w": nrm((DEPTH, D_MODEL, 3 * D_MODEL), 0.3 * D_MODEL ** -0.5),
        "ada_b": nrm((DEPTH, 3 * D_MODEL), 0.02),
        "pre_g": 1.0 + nrm((DEPTH, D_MODEL), 0.02),
        "post_g": 1.0 + nrm((DEPTH, D_MODEL), 0.02),
        "rel_bias": nrm((REL_BUCKETS, A_HEADS), 0.5),
        "ab_w_in": nrm((N_EVEN, D_MODEL, AB_IN), D_MODEL ** -0.5),
        "ab_w_out": nrm((N_EVEN, AB_WIDTH, D_MODEL), AB_WIDTH ** -0.5),
        "s5_a_re": -0.5 + nrm((N_EVEN, B_GROUPS, B_STATE), 0.01),
        "s5_a_im": math.pi * n_idx + nrm((N_EVEN, B_GROUPS, B_STATE), 0.01),
        "s5_log_dt": uni((N_EVEN, B_GROUPS), math.log(0.001), math.log(0.1)),
        "s5_b_re": nrm((N_EVEN, B_GROUPS, B_STATE, B_GROUP), (2 * B_GROUP) ** -0.5),
        "s5_b_im": nrm((N_EVEN, B_GROUPS, B_STATE, B_GROUP), (2 * B_GROUP) ** -0.5),
        "s5_c_re": nrm((N_EVEN, B_GROUPS, B_GROUP, B_STATE), (2 * B_STATE) ** -0.5),
        "s5_c_im": nrm((N_EVEN, B_GROUPS, B_GROUP, B_STATE), (2 * B_STATE) ** -0.5),
        "s5_d": nrm((N_EVEN, B_WIDTH), 1.0),
        "s5_glu_w": nrm((N_EVEN, B_WIDTH, B_WIDTH), B_WIDTH ** -0.5),
        "s5_glu_b": nrm((N_EVEN, B_WIDTH), 0.02),
        "gdn_w_in": nrm((N_ODD, D_MODEL, C_IN), D_MODEL ** -0.5),
        "gdn_conv": nrm((N_ODD, C_CONV, QKV_WIDTH), C_CONV ** -0.5),
        "gdn_a_log": jnp.log(uni((N_ODD, C_HEADS), 1.0, 16.0)),
        "gdn_dt_bias": dt_c + jnp.log(-jnp.expm1(-dt_c)),
        "gdn_norm_g": 1.0 + nrm((N_ODD, C_DV), 0.02),
        "gdn_w_out": nrm((N_ODD, C_WIDTH, D_MODEL), C_WIDTH ** -0.5),
    }


def reference(x, c, ada_w, ada_b, pre_g, post_g, rel_bias, ab_w_in, ab_w_out,
              s5_a_re, s5_a_im, s5_log_dt, s5_b_re, s5_b_im, s5_c_re, s5_c_im, s5_d, s5_glu_w, s5_glu_b,
              gdn_w_in, gdn_conv, gdn_a_log, gdn_dt_bias, gdn_norm_g, gdn_w_out):
    c_act = jax.nn.silu(c)
    for layer in range(DEPTH):
        mod = c_act @ ada_w[layer] + ada_b[layer]
        shift, scale, gate = jnp.split(mod, 3, axis=-1)
        h = rms_norm(x, pre_g[layer]) * (1.0 + scale[:, None]) + shift[:, None]
        j = layer // 2
        if layer % 2 == 0:
            y = ab_mixer(h, ab_w_in[j], ab_w_out[j], rel_bias, s5_a_re[j], s5_a_im[j], s5_log_dt[j],
                         s5_b_re[j], s5_b_im[j], s5_c_re[j], s5_c_im[j], s5_d[j], s5_glu_w[j], s5_glu_b[j])
        else:
            y = gdn_mixer(h, gdn_w_in[j], gdn_conv[j], gdn_a_log[j], gdn_dt_bias[j], gdn_norm_g[j], gdn_w_out[j])
        x = x + gate[:, None] * rms_norm(y, post_g[layer])
    return x
```

```cpp
#include <hip/hip_runtime.h>
#include <hip/hip_cooperative_groups.h>
#include <cstdio>
#include <cstdint>
namespace cg = cooperative_groups;

constexpr int NB = 4, SEQ = 4096, M = NB * SEQ, D = 1024;
constexpr int AB_IN = 3072, C_IN = 4112;
constexpr float EPS = 1e-6f;
constexpr float LOG2E = 1.4426950408889634f;

enum { I_X = 0, I_C, I_ADAW, I_ADAB, I_PREG, I_POSTG, I_RELB, I_ABWIN, I_ABWOUT, I_S5ARE, I_S5AIM, I_S5LOGDT, I_S5BRE, I_S5BIM, I_S5CRE, I_S5CIM,
       I_S5D, I_S5GLUW, I_S5GLUB, I_GDNWIN, I_GDNCONV, I_GDNALOG, I_GDNDTB, I_GDNNORMG, I_GDNWOUT, N_IN };

constexpr size_t MiB = 1u << 20;
constexpr size_t WS_CTL = 0;
constexpr size_t WS_MOD = 1 * MiB;
constexpr size_t WS_LAM = WS_MOD + 128 * 1024;
constexpr size_t WS_DEC = WS_MOD + 256 * 1024;
constexpr size_t WS_WIN0 = 2 * MiB, WS_WOUT0 = 8 * MiB, WS_WGLU = 10 * MiB, WS_WIN1 = 11 * MiB, WS_WEXT = 19 * MiB, WS_WOUT1 = 20 * MiB;
constexpr size_t WS_EXTRA = 22 * MiB;
constexpr size_t WS_EGC = 23 * MiB;
constexpr size_t WS_RA = 24 * MiB;
constexpr size_t WS_RZ = 56 * MiB;
constexpr size_t WS_RB = 184 * MiB;
constexpr size_t WS_SC = WS_RB, WS_XS = WS_RB + 4 * MiB, WS_YB = WS_RB + 8 * MiB, WS_KT = WS_RB + 24 * MiB, WS_ET = WS_RB + 25 * MiB, WS_FT = WS_RB + 33 * MiB;
constexpr size_t WS_WNEG = WS_RB, WS_KTP = WS_RB + 32 * MiB, WS_HALO = WS_RB + 64 * MiB;
constexpr size_t WS_END = 256 * MiB;

constexpr int LDS_BYTES = 147456;

#define GAS __attribute__((address_space(1)))
#define LAS __attribute__((address_space(3)))
typedef unsigned short bf16;
typedef unsigned v4u __attribute__((ext_vector_type(4)));
typedef unsigned v2u __attribute__((ext_vector_type(2)));
typedef float f32x4 __attribute__((ext_vector_type(4)));
typedef float f32x2 __attribute__((ext_vector_type(2)));
typedef short bf16x8 __attribute__((ext_vector_type(8)));
typedef short s16x4 __attribute__((ext_vector_type(4)));
#define LDS_WAIT() asm volatile("s_waitcnt lgkmcnt(0)" ::: "memory")
#define VM_WAIT() asm volatile("s_waitcnt vmcnt(0)" ::: "memory")
__device__ __forceinline__ unsigned f2bf(float f) { unsigned u = __builtin_bit_cast(unsigned, f); return (u + 0x7fffu + ((u >> 16) & 1u)) >> 16; }
__device__ __forceinline__ unsigned pk2(float lo, float hi) { return f2bf(lo) | (f2bf(hi) << 16); }
__device__ __forceinline__ float bflo(unsigned w) { return __builtin_bit_cast(float, w << 16); }
__device__ __forceinline__ float bfhi(unsigned w) { return __builtin_bit_cast(float, w & 0xffff0000u); }
__device__ __forceinline__ float bf2f(bf16 b) { return __builtin_bit_cast(float, ((unsigned)b) << 16); }
__device__ __forceinline__ float wave_sum(float v) {
#pragma unroll
    for (int o = 1; o < 64; o <<= 1) v += __shfl_xor(v, o);
    return v;
}
__device__ __forceinline__ float sigmoidf_(float x) { return 1.0f / (1.0f + __expf(-x)); }
__device__ __forceinline__ float siluf_(float x) { return x / (1.0f + __expf(-x)); }
__device__ __forceinline__ float gelu_tanh(float x) { const float u = 0.7978845608028654f * (x + 0.044715f * x * x * x); const float e = __expf(2.0f * u); const float t = 1.0f - 2.0f / (e + 1.0f); return 0.5f * x * (1.0f + t); }
typedef __attribute__((address_space(3))) const char* lds_cptr;
typedef short v4i16_t __attribute__((ext_vector_type(4)));
__device__ __forceinline__ s16x4 vtr(lds_cptr p) { return __builtin_bit_cast(s16x4, __builtin_amdgcn_ds_read_tr16_b64_v4i16((__attribute__((address_space(3))) v4i16_t*)p)); }
#define MFMA16(a, b, c) __builtin_amdgcn_mfma_f32_16x16x32_bf16((a), (b), (c), 0, 0, 0)

namespace pg8 {
#define PG8_LAS __attribute__((address_space(3)))
typedef unsigned short bf16_t;
typedef short bf16x8 __attribute__((ext_vector_type(8)));
typedef float f32x4 __attribute__((ext_vector_type(4)));
typedef unsigned u32x4 __attribute__((ext_vector_type(4)));
constexpr int BM = 256, BK = 64, HALF = 128, HTB = HALF * BK * 2  , STAGE_BYTES = 8 * HTB, NXCD = 8, WGM = 8;

__host__ __device__ __forceinline__ int lds_byte(int r, int c) { const int st = (r >> 4) * 2 + (c >> 5), rr = r & 15, cc = c & 31, ob = rr * 64 + cc * 2; return st * 1024 + (ob ^ (((ob >> 9) & 1) << 5)); }
__host__ __device__ __forceinline__ void stage_rc(int b, int& R, int& C) { const int st = b / 1024, sb = b % 1024, swz = sb ^ (((sb >> 9) & 1) << 5); R = (st >> 1) * 16 + swz / 64; C = (st & 1) * 32 + (swz % 64) / 2; }
__host__ __device__ __forceinline__ int perm32(int rho) { const int n = rho >> 4, i = rho & 15; return 8 * (i >> 2) + 4 * n + (i & 3); }

struct Unit { int pm, pn; };
struct Gemm { const bf16_t* A; const bf16_t* Bt; int M, N, K; };

struct StaticOrder {
    int nM, nN, nwg, G, c;
    __host__ __device__ void init(int M, int N, int G_, int c_) { nM = M / BM; nN = N / BM; nwg = nM * nN; G = G_; c = c_; }
    __host__ __device__ bool next(int i, Unit& u) const {
        const long L = (long)i * G + c; if (L >= nwg) return false;
        int wgid = (int)L; { const int q = nwg / NXCD, r = nwg % NXCD, xcd = wgid % NXCD, off = wgid / NXCD; wgid = (xcd < r ? xcd * (q + 1) : r * (q + 1) + (xcd - r) * q) + off; }
        const int nig = WGM * nN, gid = wgid / nig, fm = gid * WGM, gsz = (nM - fm) < WGM ? (nM - fm) : WGM;
        u.pm = fm + ((wgid % nig) % gsz); u.pn = (wgid % nig) / gsz; return true;
    }
    __device__ __forceinline__ void a_ready(const Unit&) const {}
    __device__ __forceinline__ void done(const Unit&) const {}
};


__device__ __forceinline__ unsigned cvt_pk_bf16(float lo, float hi) { unsigned r; asm volatile("v_cvt_pk_bf16_f32 %0, %1, %2" : "=v"(r) : "v"(lo), "v"(hi)); return r; }

template <bool HALO> struct EpiBf16 {
    static constexpr bool PERM = true, AFTER_DRAIN = false;
    bf16_t* O; int ldc; bf16_t* halo; int halo_cols;
    __device__ __forceinline__ void operator()(const f32x4 (&acc)[2][2][4][2], const Unit& u, int wr, int wc, int fr, int fq) const {
        const int row0 = u.pm * BM + wr * 64 + fr; const int col0 = u.pn * BM + wc * 32 + 8 * fq;
#pragma unroll
        for (int ai = 0; ai < 2; ++ai)
#pragma unroll
            for (int m = 0; m < 4; ++m) { const int row = row0 + ai * HALF + m * 16; bf16_t* rowp = O + (size_t)row * ldc + col0;
#pragma unroll
                for (int bj = 0; bj < 2; ++bj) { const f32x4 v0 = acc[ai][bj][m][0], v1 = acc[ai][bj][m][1];
                    u32x4 w; w.x = cvt_pk_bf16(v0[0], v0[1]); w.y = cvt_pk_bf16(v0[2], v0[3]); w.z = cvt_pk_bf16(v1[0], v1[1]); w.w = cvt_pk_bf16(v1[2], v1[3]);
                    *(u32x4*)(rowp + bj * HALF) = w;
                    if (HALO) { if (m == 3 && fr >= 13 && (col0 + bj * HALF) < halo_cols) *(u32x4*)(halo + ((size_t)(row >> 6) * 3 + (fr - 13)) * halo_cols + col0 + bj * HALF) = w; }
                } }
    }
};
struct EpiF32 {
    static constexpr bool PERM = false, AFTER_DRAIN = false;
    float* C; int ldc;
    __device__ __forceinline__ void operator()(const f32x4 (&acc)[2][2][4][2], const Unit& u, int wr, int wc, int fr, int fq) const {
        const int row0 = u.pm * BM + wr * 64 + fr, col0 = u.pn * BM + wc * 32 + 4 * fq;
#pragma unroll
        for (int ai = 0; ai < 2; ++ai)
#pragma unroll
            for (int m = 0; m < 4; ++m) { float* rowp = C + (size_t)(row0 + ai * HALF + m * 16) * ldc + col0;
#pragma unroll
                for (int bj = 0; bj < 2; ++bj)
#pragma unroll
                    for (int n = 0; n < 2; ++n) *(f32x4*)(rowp + bj * HALF + n * 16) = acc[ai][bj][m][n]; }
    }
};
struct EpiGlu {
    static constexpr bool PERM = true, AFTER_DRAIN = false;
    const bf16_t* yb; const bf16_t* z0; const float* glu_b; bf16_t* O;
    __device__ __forceinline__ void operator()(const f32x4 (&acc)[2][2][4][2], const Unit& u, int wr, int wc, int fr, int fq) const {
        const int row0 = u.pm * BM + wr * 64 + fr; const int col0 = u.pn * BM + wc * 32 + 8 * fq;
#pragma unroll
        for (int bj = 0; bj < 2; ++bj) { const int c = col0 + bj * HALF;
            const f32x4 b0 = *(const f32x4*)(glu_b + c), b1 = *(const f32x4*)(glu_b + c + 4);
#pragma unroll
            for (int ai = 0; ai < 2; ++ai)
#pragma unroll
                for (int m = 0; m < 4; ++m) { const size_t row = (size_t)(row0 + ai * HALF + m * 16);
                    const u32x4 yw = *(const u32x4*)(yb + row * 512 + c); const u32x4 gw = *(const u32x4*)(z0 + row * 3072 + 2560 + c);
                    const f32x4 v0 = acc[ai][bj][m][0] + b0, v1 = acc[ai][bj][m][1] + b1;
                    float r[8];
#pragma unroll
                    for (int j = 0; j < 4; ++j) { const unsigned ywj = yw[j], gwj = gw[j];
                        const float ylo = __builtin_bit_cast(float, ywj << 16), yhi = __builtin_bit_cast(float, ywj & 0xffff0000u);
                        const float glo = __builtin_bit_cast(float, gwj << 16), ghi = __builtin_bit_cast(float, gwj & 0xffff0000u);
                        const float a0 = (j < 2) ? v0[2 * j] : v1[2 * j - 4], a1 = (j < 2) ? v0[2 * j + 1] : v1[2 * j - 3];
                        r[2 * j] = ylo / (1.0f + __expf(-a0)) * (glo / (1.0f + __expf(-glo)));
                        r[2 * j + 1] = yhi / (1.0f + __expf(-a1)) * (ghi / (1.0f + __expf(-ghi))); }
                    u32x4 w; w.x = cvt_pk_bf16(r[0], r[1]); w.y = cvt_pk_bf16(r[2], r[3]); w.z = cvt_pk_bf16(r[4], r[5]); w.w = cvt_pk_bf16(r[6], r[7]);
                    *(u32x4*)(O + row * 1024 + 512 + c) = w; } }
    }
};
template <class Epi, class Sched, bool ALIGN_EPI = false, bool SP2 = false>
__device__ __forceinline__ void gemm_phase(PG8_LAS unsigned char* lds, const Gemm g, const Sched& S, const Epi& E) {
    const int tid = threadIdx.x, wid = __builtin_amdgcn_readfirstlane(tid >> 6), lane = tid & 63, wr = wid >> 2, wc = wid & 3, fr = lane & 15, fq = lane >> 4;
    const int K = g.K, nt = K / BK;
    unsigned voffA[2], voffB[2];
#pragma unroll
    for (int i = 0; i < 2; ++i) { int R, C; stage_rc(tid * 16 + i * 8192, R, C); const int Rb = Epi::PERM ? ((R & ~31) + perm32(R & 31)) : R;
        voffA[i] = (unsigned)(R * K + C) * 2u; voffB[i] = (unsigned)(Rb * K + C) * 2u; }
    const size_t kstep = (size_t)(BK * 2);
    const size_t hstep = (size_t)HALF * K * 2;
    const size_t tstep = 2 * hstep;
    const unsigned ldsw = (unsigned)wid * 1024u;
    const int aoff = lds_byte(wr * 64 + fr, fq * 8), boff = lds_byte(wc * 32 + fr, fq * 8);
#define PG8_SA(b, h) (((b) * 2 + (h)) * HTB)
#define PG8_SB(b, h) ((4 + (b) * 2 + (h)) * HTB)
#define PG8_STAGE(bufoff, gbase, voff) do { _Pragma("unroll") for (int _i = 0; _i < 2; ++_i) \
        __builtin_amdgcn_global_load_lds((const unsigned*)((const char*)(gbase) + (voff)[_i]), (PG8_LAS unsigned*)(lds + (bufoff) + ldsw + _i * 8192), 16, 0, 0); } while (0)
#define PG8_LDA(dst, b, h) do { _Pragma("unroll") for (int m = 0; m < 4; ++m) _Pragma("unroll") for (int k = 0; k < 2; ++k) dst[m][k] = *(const PG8_LAS bf16x8*)(lds + PG8_SA(b, h) + aoff + m * 2048 + k * 1024); } while (0)
#define PG8_LDB(dst, b, h) do { _Pragma("unroll") for (int n = 0; n < 2; ++n) _Pragma("unroll") for (int k = 0; k < 2; ++k) dst[n][k] = *(const PG8_LAS bf16x8*)(lds + PG8_SB(b, h) + boff + n * 2048 + k * 1024); } while (0)
#define PG8_MMA(ai, bj, At, Bt) do { __builtin_amdgcn_s_setprio(1); _Pragma("unroll") for (int m = 0; m < 4; ++m) _Pragma("unroll") for (int n = 0; n < 2; ++n) _Pragma("unroll") for (int k = 0; k < 2; ++k) \
        acc[ai][bj][m][n] = __builtin_amdgcn_mfma_f32_16x16x32_bf16(Bt[n][k], At[m][k], acc[ai][bj][m][n], 0, 0, 0); __builtin_amdgcn_s_setprio(0); } while (0)
#define PG8_WAIT_V(n) asm volatile("s_waitcnt vmcnt(" #n ")" ::: "memory")
#define PG8_WAIT_L(n) asm volatile("s_waitcnt lgkmcnt(" #n ")" ::: "memory")
#define PG8_BAR __builtin_amdgcn_s_barrier()
#define PG8_SCHED __builtin_amdgcn_sched_barrier(0)
    Unit cur, nxt; int ui = 0;
    if (!S.next(0, cur)) return;
    f32x4 acc[2][2][4][2];
#pragma unroll
    for (int a = 0; a < 2; ++a)
#pragma unroll
        for (int b = 0; b < 2; ++b)
#pragma unroll
            for (int m = 0; m < 4; ++m)
#pragma unroll
                for (int n = 0; n < 2; ++n) acc[a][b][m][n] = (f32x4){0.f, 0.f, 0.f, 0.f};
    bf16x8 At[4][2], B0[2][2], B1[2][2];
    const char* cA = (const char*)g.A + (size_t)cur.pm * tstep; const char* cB = (const char*)g.Bt + (size_t)cur.pn * tstep;
    S.a_ready(cur);
    if constexpr (SP2) {
        PG8_STAGE(PG8_SB(0, 0), cB, voffB); PG8_STAGE(PG8_SB(0, 1), cB + hstep, voffB); PG8_STAGE(PG8_SA(0, 0), cA, voffA); PG8_STAGE(PG8_SA(0, 1), cA + hstep, voffA);
        if (wr == 1) PG8_BAR;
        PG8_WAIT_V(2); PG8_BAR;
        PG8_STAGE(PG8_SB(1, 0), cB + kstep, voffB); PG8_STAGE(PG8_SA(1, 0), cA + kstep, voffA); PG8_STAGE(PG8_SB(1, 1), cB + hstep + kstep, voffB);
        PG8_WAIT_V(6); PG8_BAR;
    } else {
        PG8_STAGE(PG8_SB(0, 0), cB, voffB); PG8_STAGE(PG8_SA(0, 0), cA, voffA); PG8_STAGE(PG8_SB(0, 1), cB + hstep, voffB); PG8_STAGE(PG8_SA(0, 1), cA + hstep, voffA);
        if (wr == 1) PG8_BAR;
        PG8_WAIT_V(4); PG8_BAR;
        PG8_STAGE(PG8_SB(1, 0), cB + kstep, voffB); PG8_STAGE(PG8_SA(1, 0), cA + kstep, voffA); PG8_STAGE(PG8_SB(1, 1), cB + hstep + kstep, voffB);
        PG8_WAIT_V(6); PG8_BAR;
    }
    for (;;) {
        const bool has_next = S.next(ui + 1, nxt);
        const char* nA = has_next ? (const char*)g.A + (size_t)nxt.pm * tstep : cA; const char* nB = has_next ? (const char*)g.Bt + (size_t)nxt.pn * tstep : cB;
        for (int t = 0; t < nt; t += 2) {
            const bool last = (t == nt - 2);
            const char* a1 = cA + (size_t)(t + 1) * kstep;
            const char* a2 = last ? nA : cA + (size_t)(t + 2) * kstep; const char* b2 = last ? nB : cB + (size_t)(t + 2) * kstep;
            const char* a3 = a2 + kstep; const char* b3 = b2 + kstep;
            if (last && has_next) S.a_ready(nxt);
            if constexpr (SP2) {
            PG8_LDB(B0, 0, 0); PG8_LDB(B1, 0, 1); PG8_SCHED; PG8_LDA(At, 0, 0); PG8_STAGE(PG8_SA(1, 1), a1 + hstep, voffA);
            PG8_WAIT_V(8); PG8_WAIT_L(0); PG8_BAR; PG8_MMA(0, 0, At, B0); PG8_MMA(0, 1, At, B1); PG8_BAR; PG8_SCHED;
            PG8_LDA(At, 0, 1); PG8_STAGE(PG8_SB(0, 0), b2, voffB); PG8_STAGE(PG8_SB(0, 1), b2 + hstep, voffB); PG8_STAGE(PG8_SA(0, 0), a2, voffA);
            PG8_WAIT_V(8); PG8_WAIT_L(0); PG8_BAR; PG8_MMA(1, 0, At, B0); PG8_MMA(1, 1, At, B1); PG8_BAR; PG8_SCHED;
            PG8_LDB(B0, 1, 0); PG8_LDB(B1, 1, 1); PG8_SCHED; PG8_LDA(At, 1, 0); PG8_STAGE(PG8_SA(0, 1), a2 + hstep, voffA);
            PG8_WAIT_V(8); PG8_WAIT_L(0); PG8_BAR; PG8_MMA(0, 0, At, B0); PG8_MMA(0, 1, At, B1); PG8_BAR; PG8_SCHED;
            PG8_LDA(At, 1, 1); PG8_STAGE(PG8_SB(1, 0), b3, voffB); PG8_STAGE(PG8_SB(1, 1), b3 + hstep, voffB); PG8_STAGE(PG8_SA(1, 0), a3, voffA);
            PG8_WAIT_V(8); PG8_WAIT_L(0); PG8_BAR; PG8_MMA(1, 0, At, B0); PG8_MMA(1, 1, At, B1); PG8_BAR; PG8_SCHED;
            } else {
            PG8_LDB(B0, 0, 0); PG8_SCHED; PG8_LDA(At, 0, 0); PG8_STAGE(PG8_SA(1, 1), a1 + hstep, voffA);
            PG8_WAIT_L(8); PG8_BAR; PG8_WAIT_L(0); PG8_MMA(0, 0, At, B0); PG8_BAR; PG8_SCHED;
            PG8_LDB(B1, 0, 1); PG8_STAGE(PG8_SB(0, 0), b2, voffB);
            PG8_BAR; PG8_WAIT_L(0); PG8_MMA(0, 1, At, B1); PG8_BAR;
            PG8_LDA(At, 0, 1); PG8_STAGE(PG8_SA(0, 0), a2, voffA);
            PG8_BAR; PG8_WAIT_L(0); PG8_MMA(1, 0, At, B0); PG8_BAR; PG8_SCHED;
            PG8_STAGE(PG8_SB(0, 1), b2 + hstep, voffB);
            PG8_WAIT_V(6); PG8_BAR; PG8_MMA(1, 1, At, B1); PG8_BAR;
            PG8_LDB(B0, 1, 0); PG8_SCHED; PG8_LDA(At, 1, 0); PG8_STAGE(PG8_SA(0, 1), a2 + hstep, voffA);
            PG8_WAIT_L(8); PG8_BAR; PG8_WAIT_L(0); PG8_MMA(0, 0, At, B0); PG8_BAR; PG8_SCHED;
            PG8_LDB(B1, 1, 1); PG8_STAGE(PG8_SB(1, 0), b3, voffB);
            PG8_BAR; PG8_WAIT_L(0); PG8_MMA(0, 1, At, B1); PG8_BAR;
            PG8_LDA(At, 1, 1); PG8_STAGE(PG8_SA(1, 0), a3, voffA);
            PG8_BAR; PG8_WAIT_L(0); PG8_MMA(1, 0, At, B0); PG8_BAR; PG8_SCHED;
            PG8_STAGE(PG8_SB(1, 1), b3 + hstep, voffB);
            PG8_WAIT_V(6); PG8_BAR; PG8_MMA(1, 1, At, B1); PG8_BAR;
            }
        }
        if constexpr (ALIGN_EPI) { if (wr == 0) PG8_BAR; }
        if constexpr (!Epi::AFTER_DRAIN) { E(acc, cur, wr, wc, fr, fq); S.done(cur); }
        if (!has_next) break;
#pragma unroll
        for (int a = 0; a < 2; ++a)
#pragma unroll
            for (int b = 0; b < 2; ++b)
#pragma unroll
                for (int m = 0; m < 4; ++m)
#pragma unroll
                    for (int n = 0; n < 2; ++n) acc[a][b][m][n] = (f32x4){0.f, 0.f, 0.f, 0.f};
        cur = nxt; cA = nA; cB = nB; ++ui;
        if constexpr (ALIGN_EPI) { if (wr == 1) PG8_BAR; }
    }
    PG8_WAIT_V(0);
    if constexpr (!ALIGN_EPI) { if (wr == 0) PG8_BAR; }
    PG8_BAR;
    if constexpr (Epi::AFTER_DRAIN) { E.fused(acc, cur, wr, wc, fr, fq, lds, wid, lane); S.done(cur); }
#undef PG8_SA
#undef PG8_SB
#undef PG8_STAGE
#undef PG8_LDA
#undef PG8_LDB
#undef PG8_MMA
#undef PG8_WAIT_V
#undef PG8_WAIT_L
#undef PG8_BAR
#undef PG8_SCHED
}
}

struct Frame {
    LAS unsigned char* lds;
    int tid, lane, wave, G, bid;
    const float* in[N_IN];
    float* out;
    unsigned char* ws;
};

__device__ __forceinline__ void p0_transpose_item(const float* W, int K, int N, int ldn, bf16* WT, LAS float* scr, int item, int lane) {
    const int nblk = N / 32, kb = item / nblk, nb = item % nblk, k0 = 64 * kb, n0 = 32 * nb;
#pragma unroll 8
    for (int i = 0; i < 32; ++i) { const int kk = 2 * i + (lane >> 5); scr[kk * 33 + (lane & 31)] = W[(size_t)(k0 + kk) * ldn + n0 + (lane & 31)]; }
    LDS_WAIT(); asm volatile("" ::: "memory");
    const int c = lane & 7;
#pragma unroll
    for (int j = 0; j < 4; ++j) { const int n = (lane >> 3) + 8 * j; const LAS float* s = scr + (8 * c) * 33 + n;
        v4u o; o.x = pk2(s[0 * 33], s[1 * 33]); o.y = pk2(s[2 * 33], s[3 * 33]); o.z = pk2(s[4 * 33], s[5 * 33]); o.w = pk2(s[6 * 33], s[7 * 33]);
        *(GAS v4u*)(WT + (size_t)(n0 + n) * K + k0 + 8 * c) = o; }
    LDS_WAIT(); asm volatile("" ::: "memory");
}

__device__ __forceinline__ void p0_mod_item(Frame& F, int item) {
    LAS float* sc = (LAS float*)(F.lds);
    LAS float* red = (LAS float*)(F.lds + 16384);
    const float* c = F.in[I_C];
    for (int i = F.tid; i < 4096; i += 512) sc[i] = siluf_(c[i]);
    __syncthreads();
    const int l = item / 96, nb = item % 96, n = nb * 32 + (F.lane & 31), kh = F.lane >> 5;
    const float* W = F.in[I_ADAW] + (size_t)l * 1024 * 3072;
    float a0 = 0.f, a1 = 0.f, a2 = 0.f, a3 = 0.f;
    const int kbase = F.wave * 128;
#pragma unroll 8
    for (int i = 0; i < 64; ++i) { const int k = kbase + 2 * i + kh; const float w = W[(size_t)k * 3072 + n];
        a0 += sc[k] * w; a1 += sc[1024 + k] * w; a2 += sc[2048 + k] * w; a3 += sc[3072 + k] * w; }
    a0 += __shfl_xor(a0, 32); a1 += __shfl_xor(a1, 32); a2 += __shfl_xor(a2, 32); a3 += __shfl_xor(a3, 32);
    if (F.lane < 32) { red[(F.wave * 4 + 0) * 32 + F.lane] = a0; red[(F.wave * 4 + 1) * 32 + F.lane] = a1; red[(F.wave * 4 + 2) * 32 + F.lane] = a2; red[(F.wave * 4 + 3) * 32 + F.lane] = a3; }
    __syncthreads();
    if (F.tid < 128) { const int b = F.tid >> 5, nn = F.tid & 31; float s = 0.f;
#pragma unroll
        for (int w = 0; w < 8; ++w) s += red[(w * 4 + b) * 32 + nn];
        float* mod = (float*)(F.ws + WS_MOD);
        mod[(size_t)(l * 4 + b) * 3072 + nb * 32 + nn] = s + F.in[I_ADAB][l * 3072 + nb * 32 + nn]; }
    __syncthreads();
}

__device__ __forceinline__ void p0_s5_tables(Frame& F, int g) {
    LAS float* pw = (LAS float*)(F.lds);
    LAS float* bb = (LAS float*)(F.lds + 34816);
    LAS float* cc = (LAS float*)(F.lds + 34816 + 8192);
    const float dt = __expf(F.in[I_S5LOGDT][g]);
    for (int i = F.tid; i < 65 * 64; i += 512) { const int tau = i >> 6, p = i & 63;
        const float ar = F.in[I_S5ARE][g * 64 + p], ai = F.in[I_S5AIM][g * 64 + p];
        const float mag = expf((float)tau * (dt * ar)); float sn, cs; sincosf((float)tau * (dt * ai), &sn, &cs);
        pw[2 * i] = mag * cs; pw[2 * i + 1] = mag * sn; }
    for (int i = F.tid; i < 64 * 16; i += 512) { const int p = i >> 4, m = i & 15;
        const float ar = F.in[I_S5ARE][g * 64 + p], ai = F.in[I_S5AIM][g * 64 + p];
        const float mag = expf(dt * ar); float sn, cs; sincosf(dt * ai, &sn, &cs);
        const float abr = mag * cs, abi = mag * sn, den = ar * ar + ai * ai;
        const float fr = ((abr - 1.0f) * ar + abi * ai) / den, fi = (abi * ar - (abr - 1.0f) * ai) / den;
        const float br = F.in[I_S5BRE][(size_t)(g * 64 + p) * 16 + m], bi = F.in[I_S5BIM][(size_t)(g * 64 + p) * 16 + m];
        bb[2 * i] = fr * br - fi * bi; bb[2 * i + 1] = fr * bi + fi * br; }
    for (int i = F.tid; i < 16 * 64; i += 512) { cc[2 * i] = F.in[I_S5CRE][(size_t)g * 1024 + i]; cc[2 * i + 1] = F.in[I_S5CIM][(size_t)g * 1024 + i]; }
    __syncthreads();
    if (F.tid < 64) { float* lam = (float*)(F.ws + WS_LAM); lam[(g * 64 + F.tid) * 2] = pw[2 * (64 * 64 + F.tid)]; lam[(g * 64 + F.tid) * 2 + 1] = pw[2 * (64 * 64 + F.tid) + 1]; }
    { const int tau = F.tid >> 3, m0 = (F.tid & 7) * 2;
      float acc[2][16];
#pragma unroll
      for (int a = 0; a < 2; ++a)
#pragma unroll
          for (int b = 0; b < 16; ++b) acc[a][b] = 0.f;
      for (int p = 0; p < 64; ++p) { const float wr_ = pw[2 * (tau * 64 + p)], wi_ = pw[2 * (tau * 64 + p) + 1];
#pragma unroll
          for (int a = 0; a < 2; ++a) { const float cr = cc[2 * ((m0 + a) * 64 + p)], ci = cc[2 * ((m0 + a) * 64 + p) + 1];
              const float hr = cr * wr_ - ci * wi_, hi = cr * wi_ + ci * wr_;
#pragma unroll
              for (int b = 0; b < 16; ++b) acc[a][b] += hr * bb[2 * (p * 16 + b)] - hi * bb[2 * (p * 16 + b) + 1]; } }
      bf16* Kt = (bf16*)(F.ws + WS_KT) + (size_t)g * 64 * 256;
#pragma unroll
      for (int a = 0; a < 2; ++a) { unsigned* dst = (unsigned*)(Kt + (size_t)tau * 256 + (m0 + a) * 16);
#pragma unroll
          for (int b = 0; b < 8; ++b) dst[b] = pk2(acc[a][2 * b], acc[a][2 * b + 1]); } }
    { unsigned* Et = (unsigned*)((bf16*)(F.ws + WS_ET) + (size_t)g * 128 * 1024);
      for (int i = F.tid; i < 128 * 512; i += 512) { const int row = i >> 9, k = (i & 511) * 2, part = row >> 6, p = row & 63, t = k >> 4, m = k & 15;
          const float wr_ = pw[2 * ((63 - t) * 64 + p)], wi_ = pw[2 * ((63 - t) * 64 + p) + 1];
          const float b0r = bb[2 * (p * 16 + m)], b0i = bb[2 * (p * 16 + m) + 1], b1r = bb[2 * (p * 16 + m + 1)], b1i = bb[2 * (p * 16 + m + 1) + 1];
          const float v0 = part ? (wr_ * b0i + wi_ * b0r) : (wr_ * b0r - wi_ * b0i), v1 = part ? (wr_ * b1i + wi_ * b1r) : (wr_ * b1r - wi_ * b1i);
          Et[i] = pk2(v0, v1); } }
    { unsigned* Ft = (unsigned*)((bf16*)(F.ws + WS_FT) + (size_t)g * 1024 * 128);
      for (int i = F.tid; i < 1024 * 64; i += 512) { const int row = i >> 6, pk = (i & 63) * 2, ti = row >> 4, m = row & 15, part = pk >> 6, p = pk & 63;
          float v[2];
#pragma unroll
          for (int e = 0; e < 2; ++e) { const float wr_ = pw[2 * ((ti + 1) * 64 + p + e)], wi_ = pw[2 * ((ti + 1) * 64 + p + e) + 1];
              const float cr = cc[2 * (m * 64 + p + e)], ci = cc[2 * (m * 64 + p + e) + 1];
              v[e] = part ? -(cr * wi_ + ci * wr_) : (cr * wr_ - ci * wi_); }
          Ft[i] = pk2(v[0], v[1]); } }
    __syncthreads();
}

__device__ __forceinline__ void p0_prologue(Frame& F) {
    if (F.bid < 192) p0_mod_item(F, F.bid);
    else if (F.bid < 224) p0_s5_tables(F, F.bid - 192);
    __syncthreads();
    LAS float* scr = (LAS float*)(F.lds + F.wave * 16384);
    const int gw = F.bid * 8 + F.wave, NGW = F.G * 8;
    constexpr int I_A = 16 * 96, I_B = 16 * 32, I_C2 = 8 * 16, I_D = 16 * 128, I_E = 16 * 32;
    constexpr int NITEMS = I_A + I_B + I_C2 + I_D + I_E;
    for (int it = gw; it < NITEMS; it += NGW) {
        int r = it;
        if (r < I_A) { p0_transpose_item(F.in[I_ABWIN], 1024, 3072, 3072, (bf16*)(F.ws + WS_WIN0), scr, r, F.lane); continue; } r -= I_A;
        if (r < I_B) { p0_transpose_item(F.in[I_ABWOUT], 1024, 1024, 1024, (bf16*)(F.ws + WS_WOUT0), scr, r, F.lane); continue; } r -= I_B;
        if (r < I_C2) { p0_transpose_item(F.in[I_S5GLUW], 512, 512, 512, (bf16*)(F.ws + WS_WGLU), scr, r, F.lane); continue; } r -= I_C2;
        if (r < I_D) { p0_transpose_item(F.in[I_GDNWIN], 1024, 4096, C_IN, (bf16*)(F.ws + WS_WIN1), scr, r, F.lane); continue; } r -= I_D;
        p0_transpose_item(F.in[I_GDNWOUT], 1024, 1024, 1024, (bf16*)(F.ws + WS_WOUT1), scr, r, F.lane);
    }
    { bf16* we = (bf16*)(F.ws + WS_WEXT); const float* W = F.in[I_GDNWIN];
      for (int i = F.bid * 512 + F.tid; i < 16 * 1024; i += F.G * 512) { const int j = i >> 10, k = i & 1023; we[i] = (bf16)f2bf(W[(size_t)k * C_IN + 4096 + j]); } }
}

__device__ __forceinline__ void modnorm_row(const f32x4 (&v)[4], int lane, const float* g, const float* shift, const float* scale, bf16* orow) {
    float s = 0.f;
#pragma unroll
    for (int j = 0; j < 4; ++j) s += (v[j].x * v[j].x + v[j].y * v[j].y) + (v[j].z * v[j].z + v[j].w * v[j].w);
    const float r = rsqrtf(wave_sum(s) * (1.f / D) + EPS);
    GAS unsigned long long* o8 = (GAS unsigned long long*)orow + lane;
#pragma unroll
    for (int j = 0; j < 4; ++j) { const int c = 4 * lane + 256 * j;
        const f32x4 gg = *(const f32x4*)(g + c), sh = *(const f32x4*)(shift + c), sc = *(const f32x4*)(scale + c);
        const float h0 = v[j].x * r * gg.x * (1.f + sc.x) + sh.x, h1 = v[j].y * r * gg.y * (1.f + sc.y) + sh.y;
        const float h2 = v[j].z * r * gg.z * (1.f + sc.z) + sh.z, h3 = v[j].w * r * gg.w * (1.f + sc.w) + sh.w;
        o8[64 * j] = (unsigned long long)pk2(h0, h1) | ((unsigned long long)pk2(h2, h3) << 32); }
}
__device__ __forceinline__ void p1_modnorm(Frame& F, const float* x, int layer) {
    const int gw = F.bid * 8 + F.wave, NGW = F.G * 8;
    const float* mod = (const float*)(F.ws + WS_MOD) + (size_t)layer * 4 * 3072;
    bf16* H = (bf16*)(F.ws + WS_RA);
    for (int m = gw; m < M; m += NGW) { const int b = m >> 12;
        const GAS f32x4* xr = (const GAS f32x4*)(x + (size_t)m * D) + F.lane;
        f32x4 v[4];
#pragma unroll
        for (int j = 0; j < 4; ++j) v[j] = xr[64 * j];
        modnorm_row(v, F.lane, F.in[I_PREG] + layer * 1024, mod + b * 3072, mod + b * 3072 + 1024, H + (size_t)m * D); }
}
template <bool NEXT> __device__ __forceinline__ void p_residual(Frame& F, const float* xin, const float* y, float* xout, int layer) {
    const int gw = F.bid * 8 + F.wave, NGW = F.G * 8;
    const float* mod = (const float*)(F.ws + WS_MOD) + (size_t)layer * 4 * 3072;
    const float* modn = (const float*)(F.ws + WS_MOD) + (size_t)(layer + 1) * 4 * 3072;
    const float* pg = F.in[I_POSTG] + layer * 1024;
    bf16* H = (bf16*)(F.ws + WS_RA);
    for (int m = gw; m < M; m += NGW) { const int b = m >> 12;
        const GAS f32x4* yr = (const GAS f32x4*)(y + (size_t)m * D) + F.lane; const GAS f32x4* xr = (const GAS f32x4*)(xin + (size_t)m * D) + F.lane;
        f32x4 v[4], xv[4]; float s = 0.f;
#pragma unroll
        for (int j = 0; j < 4; ++j) { v[j] = yr[64 * j]; xv[j] = xr[64 * j]; s += (v[j].x * v[j].x + v[j].y * v[j].y) + (v[j].z * v[j].z + v[j].w * v[j].w); }
        const float r = rsqrtf(wave_sum(s) * (1.f / D) + EPS);
        GAS f32x4* orow = (GAS f32x4*)(xout + (size_t)m * D) + F.lane;
#pragma unroll
        for (int j = 0; j < 4; ++j) { const int c = 4 * F.lane + 256 * j;
            const f32x4 gg = *(const f32x4*)(pg + c), gt = *(const f32x4*)(mod + b * 3072 + 2048 + c);
            xv[j].x += gt.x * (v[j].x * r * gg.x); xv[j].y += gt.y * (v[j].y * r * gg.y); xv[j].z += gt.z * (v[j].z * r * gg.z); xv[j].w += gt.w * (v[j].w * r * gg.w);
            orow[64 * j] = xv[j]; }
        if (NEXT) modnorm_row(xv, F.lane, F.in[I_PREG] + (layer + 1) * 1024, modn + b * 3072, modn + b * 3072 + 1024, H + (size_t)m * D);
    }
}

__constant__ unsigned char T5B[3][132] = {
{0,1,2,3,4,5,6,7,8,9,10,11,12,13,14,15,16,16,16,16,16,16,17,17,17,17,17,17,17,17,18,18,18,18,18,18,18,18,18,18,19,19,19,19,19,19,19,19,19,19,19,19,19,19,20,20,20,20,20,20,20,20,20,20,20,20,20,20,20,20,20,20,20,21,21,21,21,21,21,21,21,21,21,21,21,21,21,21,21,21,21,21,21,21,21,21,21,21,21,22,22,22,22,22,22,22,22,22,22,22,22,22,22,22,22,22,22,22,22,22,22,22,22,22,22,22,22,22,22,0,0,0},
{0,4,8,12,16,16,17,17,18,18,19,19,19,19,20,20,20,20,20,21,21,21,21,21,21,22,22,22,22,22,22,22,22,22,23,23,23,23,23,23,23,23,23,23,23,23,24,24,24,24,24,24,24,24,24,24,24,24,24,24,24,24,25,25,25,25,25,25,25,25,25,25,25,25,25,25,25,25,25,25,25,25,25,26,26,26,26,26,26,26,26,26,26,26,26,26,26,26,26,26,26,26,26,26,26,26,26,26,26,26,26,26,26,27,27,27,27,27,27,27,27,27,27,27,27,27,27,27,27,0,0,0},
{0,16,18,19,20,21,21,22,22,23,23,23,24,24,24,24,25,25,25,25,25,26,26,26,26,26,26,26,26,27,27,27,27,27,27,27,27,27,27,28,28,28,28,28,28,28,28,28,28,28,28,28,29,29,29,29,29,29,29,29,29,29,29,29,29,29,29,29,29,29,30,30,30,30,30,30,30,30,30,30,30,30,30,30,30,30,30,30,30,30,30,30,30,30,30,31,31,31,31,31,31,31,31,31,31,31,31,31,31,31,31,31,31,31,31,31,31,31,31,31,31,31,31,31,31,31,31,31,31,0,0,0}};

constexpr int ATT_VB_OFF = 2048, ATT_VB_WAVE = 4608;
struct AttLd { bf16x8 kf[2][2]; v4u vv[4]; };
__device__ __forceinline__ void att_step_geom(int st, int P0r, int& ci, int& sh, int& q0, int& qs, int& kbase) {
    ci = st >= 18 ? 2 : (st >= 12 ? 1 : 0); const int kt = st - (ci == 0 ? 0 : (ci == 1 ? 12 : 18));
    sh = 2 * ci; q0 = P0r >> sh; qs = 16 >> sh; kbase = q0 - 128 + 32 * kt;
}
__device__ __forceinline__ void att_load(AttLd& L, const bf16* zb, int st, int P0r, int h, int lane) {
    int ci, sh, q0, qs, kbase; att_step_geom(st, P0r, ci, sh, q0, qs, kbase);
    const int res = P0r & ((1 << sh) - 1), jq = lane & 15, g = lane >> 4;
#pragma unroll
    for (int tt = 0; tt < 2; ++tt) { int kidx = kbase + 16 * tt + jq; kidx = kidx < 0 ? 0 : kidx; const int kpos = (kidx << sh) + res;
        const bf16* kp = zb + (size_t)kpos * 3072 + 512 + h * 64 + 8 * g;
        L.kf[tt][0] = *(const bf16x8*)kp; L.kf[tt][1] = *(const bf16x8*)(kp + 32); }
#pragma unroll
    for (int i = 0; i < 4; ++i) { int kidx = kbase + (lane >> 3) + 8 * i; kidx = kidx < 0 ? 0 : kidx; const int kpos = (kidx << sh) + res;
        L.vv[i] = *(const v4u*)(zb + (size_t)kpos * 3072 + 1024 + h * 64 + 8 * (lane & 7)); }
}
__device__ __forceinline__ void attn_task(Frame& F, int task) {
    const int b = task >> 7, h = (task >> 4) & 7, span = task & 15, lane = F.lane;
    LAS float* biasT = (LAS float*)(F.lds);
    LAS unsigned char* vbuf = F.lds + ATT_VB_OFF + F.wave * ATT_VB_WAVE;
    __syncthreads();
    for (int i = F.tid; i < 3 * 132; i += 512) { const int ci = i / 132, rel = i % 132; biasT[i] = F.in[I_RELB][T5B[ci][rel] * 8 + h] * LOG2E; }
    __syncthreads();
    const bf16* zb = (const bf16*)(F.ws + WS_RZ) + (size_t)b * SEQ * 3072;
    bf16* O = (bf16*)(F.ws + WS_RA) + (size_t)b * SEQ * 1024;
    const int jq = lane & 15, g = lane >> 4;
    for (int it = 0; it < 2; ++it) {
        const int P0r = span * 256 + F.wave + 8 * it;
        const int qpos = P0r + 16 * jq;
        bf16x8 qf[2];
        { const bf16* qp = zb + (size_t)qpos * 3072 + h * 64 + 8 * g; qf[0] = *(const bf16x8*)qp; qf[1] = *(const bf16x8*)(qp + 32); }
        float mrun = -1e30f, lrun = 0.f; f32x4 o[4];
#pragma unroll
        for (int hb = 0; hb < 4; ++hb) o[hb] = (f32x4){0.f, 0.f, 0.f, 0.f};
        AttLd cur, nxt; att_load(cur, zb, 0, P0r, h, lane);
        for (int st = 0; st < 23; ++st) {
            if (st + 1 < 23) att_load(nxt, zb, st + 1, P0r, h, lane);
            int ci, sh, q0, qs, kbase; att_step_geom(st, P0r, ci, sh, q0, qs, kbase);
            const int qidx = q0 + qs * jq;
            f32x4 s0 = (f32x4){0.f, 0.f, 0.f, 0.f}, s1 = s0;
            s0 = MFMA16(cur.kf[0][0], qf[0], s0); s0 = MFMA16(cur.kf[0][1], qf[1], s0);
            s1 = MFMA16(cur.kf[1][0], qf[0], s1); s1 = MFMA16(cur.kf[1][1], qf[1], s1);
            float sv[8]; float tm = -1e30f;
#pragma unroll
            for (int e = 0; e < 8; ++e) { const int tt = e >> 2, rr = e & 3; const int kidx = kbase + 16 * tt + 4 * g + rr, rel = qidx - kidx;
                const bool ok = (rel >= 0) && (rel <= 128) && (kidx >= 0); const int relc = rel < 0 ? 0 : (rel > 128 ? 128 : rel);
                const float sc = (tt ? s1[rr] : s0[rr]) * (0.125f * LOG2E) + biasT[ci * 132 + relc];
                sv[e] = ok ? sc : -1e30f; tm = fmaxf(tm, sv[e]); }
            tm = fmaxf(tm, __shfl_xor(tm, 16)); tm = fmaxf(tm, __shfl_xor(tm, 32));
            const float mnew = fmaxf(mrun, tm), alpha = exp2f(mrun - mnew); mrun = mnew;
            float ps = 0.f;
#pragma unroll
            for (int e = 0; e < 8; ++e) { sv[e] = exp2f(sv[e] - mnew); ps += sv[e]; }
            lrun = lrun * alpha + ps;
#pragma unroll
            for (int hb = 0; hb < 4; ++hb) o[hb] = o[hb] * alpha;
            v4u pw; pw.x = pk2(sv[0], sv[1]); pw.y = pk2(sv[2], sv[3]); pw.z = pk2(sv[4], sv[5]); pw.w = pk2(sv[6], sv[7]);
            const bf16x8 pf = __builtin_bit_cast(bf16x8, pw);
            asm volatile("" ::: "memory");
#pragma unroll
            for (int i = 0; i < 4; ++i) *(LAS v4u*)(vbuf + ((lane >> 3) + 8 * i) * 144 + (lane & 7) * 16) = cur.vv[i];
            asm volatile("" ::: "memory");
            const lds_cptr va = (lds_cptr)vbuf + (4 * g + (jq >> 2)) * 144 + 8 * (jq & 3);
#pragma unroll
            for (int hb = 0; hb < 4; ++hb) { const s16x4 lo4 = vtr(va + 32 * hb), hi4 = vtr(va + 32 * hb + 16 * 144);
                const bf16x8 vf = (bf16x8){lo4[0], lo4[1], lo4[2], lo4[3], hi4[0], hi4[1], hi4[2], hi4[3]};
                o[hb] = MFMA16(vf, pf, o[hb]); }
            asm volatile("" ::: "memory");
            cur = nxt;
        }
        float lt = lrun + __shfl_xor(lrun, 16); lt += __shfl_xor(lt, 32);
        const float inv = 1.0f / lt;
#pragma unroll
        for (int hb = 0; hb < 4; ++hb) { const int col = h * 64 + 16 * hb + 4 * g;
            const v2u gw = *(const v2u*)(zb + (size_t)qpos * 3072 + 2048 + col);
            const float g0 = bflo(gw.x), g1 = bfhi(gw.x), g2 = bflo(gw.y), g3 = bfhi(gw.y);
            v2u w; w.x = pk2(o[hb][0] * inv * siluf_(g0), o[hb][1] * inv * siluf_(g1)); w.y = pk2(o[hb][2] * inv * siluf_(g2), o[hb][3] * inv * siluf_(g3));
            *(v2u*)(O + (size_t)qpos * 1024 + col) = w; }
    }
}

__device__ __forceinline__ void s5_pass1(Frame& F, int task) {
    const int g = task >> 4, ct = task & 15, n = F.lane & 15, gq = F.lane >> 4;
    const int cgi = ct * 16 + n, b = cgi >> 6, c = cgi & 63;
    const bf16* Et = (const bf16*)(F.ws + WS_ET) + (size_t)g * 128 * 1024 + (size_t)n * 1024 + 8 * gq;
    const bf16* ub = (const bf16*)(F.ws + WS_RZ) + (size_t)(b * SEQ + c * 64) * 3072 + 1536 + g * 16 + 8 * (gq & 1);
    f32x4 acc[8];
#pragma unroll
    for (int st = 0; st < 8; ++st) acc[st] = (f32x4){0.f, 0.f, 0.f, 0.f};
    for (int s = 0; s < 32; ++s) { const int tok = 2 * s + (gq >> 1);
        const bf16x8 bfr = *(const bf16x8*)(ub + (size_t)tok * 3072);
#pragma unroll
        for (int st = 0; st < 8; ++st) { const bf16x8 afr = *(const bf16x8*)(Et + (size_t)st * 16 * 1024 + 32 * s); acc[st] = MFMA16(afr, bfr, acc[st]); } }
    float* SC = (float*)(F.ws + WS_SC) + (size_t)((b * 32 + g) * 64 + c) * 128 + 4 * gq;
#pragma unroll
    for (int st = 0; st < 8; ++st) *(f32x4*)(SC + 16 * st) = acc[st];
}
__device__ __forceinline__ void s5_carry(Frame& F) {
    const int idx = F.bid * 512 + F.tid; if (idx >= NB * 32 * 64) return;
    const int b = idx >> 11, g = (idx >> 6) & 31, p = idx & 63;
    const float* lam = (const float*)(F.ws + WS_LAM); const float lr = lam[(g * 64 + p) * 2], li = lam[(g * 64 + p) * 2 + 1];
    const float* sc = (const float*)(F.ws + WS_SC) + (size_t)((b * 32 + g) * 64) * 128 + p;
    float* xs = (float*)(F.ws + WS_XS) + (size_t)((b * 32 + g) * 64) * 128 + p;
    float xr = 0.f, xi = 0.f;
#pragma unroll 8
    for (int c = 0; c < 64; ++c) { xs[c * 128] = xr; xs[c * 128 + 64] = xi; const float sr = sc[c * 128], si = sc[c * 128 + 64];
        const float nr = lr * xr - li * xi + sr, ni = lr * xi + li * xr + si; xr = nr; xi = ni; }
}
__device__ __forceinline__ void s5_pass2(Frame& F, int task) {
    const int g = task >> 6, ct = (task >> 2) & 15, q = task & 3, n = F.lane & 15, gq = F.lane >> 4;
    const int cgi = ct * 16 + n, b = cgi >> 6, c = cgi & 63;
    const bf16* Kt = (const bf16*)(F.ws + WS_KT) + (size_t)g * 64 * 256 + n * 16 + 8 * (gq & 1);
    const bf16* Ft = (const bf16*)(F.ws + WS_FT) + (size_t)g * 1024 * 128 + (size_t)n * 128 + 8 * gq;
    const float* XS = (const float*)(F.ws + WS_XS) + (size_t)((b * 32 + g) * 64 + c) * 128 + 8 * gq;
    const bf16* zrow = (const bf16*)(F.ws + WS_RZ) + (size_t)(b * SEQ + c * 64) * 3072 + 1536 + g * 16;
    f32x4 acc[16];
#pragma unroll
    for (int ii = 0; ii < 16; ++ii) acc[ii] = (f32x4){0.f, 0.f, 0.f, 0.f};
    for (int sp = 0; sp < 4; ++sp) { const f32x4 x0 = *(const f32x4*)(XS + 32 * sp), x1 = *(const f32x4*)(XS + 32 * sp + 4);
        v4u xw; xw.x = pk2(x0.x, x0.y); xw.y = pk2(x0.z, x0.w); xw.z = pk2(x1.x, x1.y); xw.w = pk2(x1.z, x1.w); const bf16x8 xf = __builtin_bit_cast(bf16x8, xw);
#pragma unroll
        for (int ii = 0; ii < 16; ++ii) { const int i = q + 4 * ii; const bf16x8 afr = *(const bf16x8*)(Ft + (size_t)i * 16 * 128 + 32 * sp); acc[ii] = MFMA16(afr, xf, acc[ii]); } }
    for (int s = 0; s < 32; ++s) { const int tok = 2 * s + (gq >> 1);
        const bf16x8 bfr = *(const bf16x8*)(zrow + (size_t)tok * 3072 + 8 * (gq & 1));
#pragma unroll
        for (int ii = 0; ii < 16; ++ii) { const int i = q + 4 * ii;
            if ((i >> 1) >= s) { const int tau = i - tok; const bf16x8 ld = *(const bf16x8*)(Kt + (size_t)(tau < 0 ? 0 : tau) * 256);
                const bf16x8 afr = tau < 0 ? (bf16x8){0, 0, 0, 0, 0, 0, 0, 0} : ld; acc[ii] = MFMA16(afr, bfr, acc[ii]); } } }
    const f32x4 dsk = *(const f32x4*)(F.in[I_S5D] + g * 16 + 4 * gq);
    bf16* YB = (bf16*)(F.ws + WS_YB) + (size_t)(b * SEQ + c * 64) * 512 + g * 16 + 4 * gq;
#pragma unroll
    for (int ii = 0; ii < 16; ++ii) { const int i = q + 4 * ii; const v2u uw = *(const v2u*)(zrow + (size_t)i * 3072 + 4 * gq);
        const float y0 = gelu_tanh(acc[ii][0] + dsk.x * bflo(uw.x)), y1 = gelu_tanh(acc[ii][1] + dsk.y * bfhi(uw.x));
        const float y2 = gelu_tanh(acc[ii][2] + dsk.z * bflo(uw.y)), y3 = gelu_tanh(acc[ii][3] + dsk.w * bfhi(uw.y));
        v2u w; w.x = pk2(y0, y1); w.y = pk2(y2, y3); *(v2u*)(YB + (size_t)i * 512) = w; }
}

__device__ __forceinline__ int perm_pos(int o) { return (o & ~31) | (((o >> 2) & 3) << 3) | (((o >> 4) & 1) << 2) | (o & 3); }

__device__ __forceinline__ void gdn_extras_item(Frame& F, int item) {
    if (F.wave >= 4) return;
    const int n = F.lane & 15, g = F.lane >> 4, row0 = item * 64 + F.wave * 16;
    const bf16* A = (const bf16*)(F.ws + WS_RA) + (size_t)(row0 + n) * 1024 + 8 * g;
    const bf16* B = (const bf16*)(F.ws + WS_WEXT) + (size_t)n * 1024 + 8 * g;
    f32x4 acc0 = (f32x4){0.f, 0.f, 0.f, 0.f}, acc1 = acc0;
#pragma unroll 4
    for (int s = 0; s < 32; s += 2) { acc0 = MFMA16(*(const bf16x8*)(A + 32 * s), *(const bf16x8*)(B + 32 * s), acc0); acc1 = MFMA16(*(const bf16x8*)(A + 32 * s + 32), *(const bf16x8*)(B + 32 * s + 32), acc1); }
    float* ex = (float*)(F.ws + WS_EXTRA);
#pragma unroll
    for (int e = 0; e < 4; ++e) ex[(size_t)(row0 + 4 * g + e) * 16 + n] = acc0[e] + acc1[e];
}

constexpr int GP_QS = 0, GP_KS = 17408, GP_VS = 34816, GP_LS = 52224, GP_TB = 69632, GP_TW = 78848, GP_SM = 88064;
__device__ __forceinline__ void gdn_prep_task(Frame& F, int task) {
    const int b = task >> 9, h = (task >> 6) & 7, c = task & 63, tid = F.tid, lane = F.lane, wave = F.wave;
    LAS unsigned char* L = F.lds;
    LAS float* bet = (LAS float*)(L + GP_SM); LAS float* gg = bet + 64; LAS float* gcs = bet + 128;
    bf16* z1 = (bf16*)(F.ws + WS_RZ);
    const size_t row0 = (size_t)b * SEQ + c * 64;
    __syncthreads();
    { const int t = tid >> 3, seg = tid & 7;
      const bf16* halo = (const bf16*)(F.ws + WS_HALO) + (size_t)(b * 64 + c - 1) * 3 * 3072;
#pragma unroll 1
      for (int w3 = 0; w3 < 3; ++w3) { const int ch = w3 * 1024 + h * 128 + seg * 16;
          float a[16];
#pragma unroll
          for (int e = 0; e < 16; ++e) a[e] = 0.f;
#pragma unroll
          for (int j = 0; j < 4; ++j) { const int tl = t - 3 + j;
              v4u r0 = (v4u){0u, 0u, 0u, 0u}, r1 = r0;
              if (tl >= 0) { const bf16* p = z1 + (row0 + tl) * 4096 + ch; r0 = *(const v4u*)p; r1 = *(const v4u*)(p + 8); }
              else if (c > 0) { const bf16* p = halo + (size_t)(tl + 3) * 3072 + ch; r0 = *(const v4u*)p; r1 = *(const v4u*)(p + 8); }
              const float* cw = F.in[I_GDNCONV] + j * 3072 + ch;
              const f32x4 w0 = *(const f32x4*)cw, w1 = *(const f32x4*)(cw + 4), w2 = *(const f32x4*)(cw + 8), w3v = *(const f32x4*)(cw + 12);
              a[0] += w0.x * bflo(r0.x); a[1] += w0.y * bfhi(r0.x); a[2] += w0.z * bflo(r0.y); a[3] += w0.w * bfhi(r0.y);
              a[4] += w1.x * bflo(r0.z); a[5] += w1.y * bfhi(r0.z); a[6] += w1.z * bflo(r0.w); a[7] += w1.w * bfhi(r0.w);
              a[8] += w2.x * bflo(r1.x); a[9] += w2.y * bfhi(r1.x); a[10] += w2.z * bflo(r1.y); a[11] += w2.w * bfhi(r1.y);
              a[12] += w3v.x * bflo(r1.z); a[13] += w3v.y * bfhi(r1.z); a[14] += w3v.z * bflo(r1.w); a[15] += w3v.w * bfhi(r1.w); }
          float s = 0.f;
#pragma unroll
          for (int e = 0; e < 16; ++e) { a[e] = siluf_(a[e]); s += a[e] * a[e]; }
          s += __shfl_xor(s, 1); s += __shfl_xor(s, 2); s += __shfl_xor(s, 4);
          const float r = (w3 == 2) ? 1.0f : rsqrtf(s + EPS) * (w3 == 0 ? 0.08838834764831845f : 1.0f);
#pragma unroll
          for (int e = 0; e < 16; ++e) a[e] *= r;
          LAS unsigned char* dst = L + w3 * 17408 + t * 272 + seg * 32;
          v4u o0, o1; o0.x = pk2(a[0], a[1]); o0.y = pk2(a[2], a[3]); o0.z = pk2(a[4], a[5]); o0.w = pk2(a[6], a[7]);
          o1.x = pk2(a[8], a[9]); o1.y = pk2(a[10], a[11]); o1.z = pk2(a[12], a[13]); o1.w = pk2(a[14], a[15]);
          *(LAS v4u*)dst = o0; *(LAS v4u*)(dst + 16) = o1; }
      if (seg == 0) { const float* ex = (const float*)(F.ws + WS_EXTRA) + (row0 + t) * 16;
          const float braw = ex[h], araw = ex[8 + h] + F.in[I_GDNDTB][h];
          const float sp = araw > 20.f ? araw : log1pf(expf(araw));
          bet[t] = 1.0f / (1.0f + expf(-braw)); gg[t] = -expf(F.in[I_GDNALOG][h]) * sp; } }
    __syncthreads();
    if (wave == 0) { float v = gg[lane];
#pragma unroll
        for (int o = 1; o < 64; o <<= 1) { const float u = __shfl_up(v, o); if (lane >= o) v += u; }
        const float glast = __shfl(v, 63);
        gcs[lane] = v;
        float* egc = (float*)(F.ws + WS_EGC); egc[(row0 + lane) * 8 + h] = expf(v); egc[(size_t)M * 8 + (row0 + lane) * 8 + h] = expf(glast - v);
        if (lane == 0) ((float*)(F.ws + WS_DEC))[(b * 8 + h) * 64 + c] = expf(glast); }
    __syncthreads();
    { const int n = lane & 15, g = lane >> 4;
#pragma unroll
      for (int x = 0; x < 2; ++x) { const int tl = wave + 8 * x, it = tl >> 2, jt = tl & 3;
          const int i = 16 * it + n, j0 = 16 * jt + 4 * g;
          bf16* aq = z1 + (row0 + i) * 4096 + 1024 + h * 128 + ((jt >> 1) * 32 + 8 * g + 4 * (jt & 1));
          if (jt > it) { *(v2u*)aq = (v2u){0u, 0u}; *(LAS f32x4*)(L + GP_LS + i * 272 + j0 * 4) = (f32x4){0.f, 0.f, 0.f, 0.f}; continue; }
          f32x4 kk = (f32x4){0.f, 0.f, 0.f, 0.f}, qk = kk;
#pragma unroll
          for (int s = 0; s < 4; ++s) { const bf16x8 af = *(const LAS bf16x8*)(L + GP_KS + (16 * jt + n) * 272 + 64 * s + 16 * g);
              const bf16x8 bk = *(const LAS bf16x8*)(L + GP_KS + (16 * it + n) * 272 + 64 * s + 16 * g);
              const bf16x8 bq = *(const LAS bf16x8*)(L + GP_QS + (16 * it + n) * 272 + 64 * s + 16 * g);
              kk = MFMA16(af, bk, kk); qk = MFMA16(af, bq, qk); }
          const float gi = gcs[i], bi = bet[i]; f32x4 lv; float av[4];
#pragma unroll
          for (int e = 0; e < 4; ++e) { const int j = j0 + e; const float dcy = expf(gi - gcs[j]);
              lv[e] = (j < i) ? bi * kk[e] * dcy : 0.f; av[e] = (j <= i) ? qk[e] * dcy : 0.f; }
          *(LAS f32x4*)(L + GP_LS + i * 272 + j0 * 4) = lv;
          v2u w; w.x = pk2(av[0], av[1]); w.y = pk2(av[2], av[3]); *(v2u*)aq = w; } }
    __syncthreads();
    if (wave == 0) {
        float t[64];
#pragma unroll
        for (int i = 0; i < 64; ++i) { float a0 = (i == lane) ? 1.f : 0.f, a1 = 0.f;
#pragma unroll
            for (int j4 = 0; j4 < (i + 3) / 4; ++j4) { const f32x4 lr = *(const LAS f32x4*)(L + GP_LS + i * 272 + j4 * 16);
                if (4 * j4 + 0 < i) a0 -= lr.x * t[4 * j4 + 0];
                if (4 * j4 + 1 < i) a1 -= lr.y * t[4 * j4 + 1];
                if (4 * j4 + 2 < i) a0 -= lr.z * t[4 * j4 + 2];
                if (4 * j4 + 3 < i) a1 -= lr.w * t[4 * j4 + 3]; }
            t[i] = a0 + a1; asm volatile("" ::: "memory"); }
        const float bc = bet[lane], bw = bc * expf(gcs[lane]);
#pragma unroll
        for (int i = 0; i < 64; ++i) { *(LAS bf16*)(L + GP_TB + i * 144 + lane * 2) = (bf16)f2bf(t[i] * bc); *(LAS bf16*)(L + GP_TW + i * 144 + lane * 2) = (bf16)f2bf(t[i] * bw); }
    } else {
        const int lt = tid - 64;
        for (int q = lt; q < 1024; q += 448) { const int t = q >> 4, ck = q & 15, J = ck >> 2, g = ck & 3;
            const v2u lo = *(const LAS v2u*)(L + GP_QS + t * 272 + (32 * J + 4 * g) * 2), hi = *(const LAS v2u*)(L + GP_QS + t * 272 + (32 * J + 16 + 4 * g) * 2);
            *(v4u*)(z1 + (row0 + t) * 4096 + h * 128 + 32 * J + 8 * g) = (v4u){lo.x, lo.y, hi.x, hi.y}; }
        bf16* kT = (bf16*)(F.ws + WS_KTP) + (size_t)((b * 8 + h) * 64 + c) * 8192;
        const int n = lane & 15, g = lane >> 4;
        for (int op = wave - 1; op < 16; op += 7) { const int db = op >> 1, J = op & 1;
            const lds_cptr a = (lds_cptr)(L + GP_KS) + (32 * J + 4 * g + (n >> 2)) * 272 + (16 * db + 4 * (n & 3)) * 2;
            const s16x4 lo4 = vtr(a), hi4 = vtr(a + 16 * 272);
            *(v4u*)(kT + (size_t)(16 * db + n) * 64 + 32 * J + 8 * g) = __builtin_bit_cast(v4u, (bf16x8){lo4[0], lo4[1], lo4[2], lo4[3], hi4[0], hi4[1], hi4[2], hi4[3]}); }
    }
    __syncthreads();
    { const int n = lane & 15, g = lane >> 4;
      bf16x8 vfr[2], kfr[2];
#pragma unroll
      for (int s = 0; s < 2; ++s) { const int roff = (32 * s + 8 * g + (n >> 2)) * 272 + (16 * wave + 4 * (n & 3)) * 2;
          const s16x4 v0 = vtr((lds_cptr)(L + GP_VS) + roff), v1 = vtr((lds_cptr)(L + GP_VS) + roff + 4 * 272);
          const s16x4 k0 = vtr((lds_cptr)(L + GP_KS) + roff), k1 = vtr((lds_cptr)(L + GP_KS) + roff + 4 * 272);
          vfr[s] = (bf16x8){v0[0], v0[1], v0[2], v0[3], v1[0], v1[1], v1[2], v1[3]}; kfr[s] = (bf16x8){k0[0], k0[1], k0[2], k0[3], k1[0], k1[1], k1[2], k1[3]}; }
      bf16* uT = (bf16*)(F.ws + WS_RA) + (size_t)((b * 8 + h) * 64 + c) * 8192 + (size_t)(16 * wave + n) * 64;
      bf16* wn = (bf16*)(F.ws + WS_WNEG) + h * 128 + ((wave >> 1) * 32 + 8 * g + 4 * (wave & 1));
#pragma unroll
      for (int it = 0; it < 4; ++it) { f32x4 ua = (f32x4){0.f, 0.f, 0.f, 0.f}, wa = ua;
#pragma unroll
          for (int s = 0; s < 2; ++s) { if (s == 1 && it < 2) continue;
              const bf16x8 tb = *(const LAS bf16x8*)(L + GP_TB + (16 * it + n) * 144 + 64 * s + 16 * g), tw = *(const LAS bf16x8*)(L + GP_TW + (16 * it + n) * 144 + 64 * s + 16 * g);
              ua = MFMA16(tb, vfr[s], ua);
              wa = MFMA16(kfr[s], tw, wa); }
          v2u uw; uw.x = pk2(ua[0], ua[1]); uw.y = pk2(ua[2], ua[3]); *(v2u*)(uT + 16 * it + 4 * g) = uw;
          v2u ww; ww.x = pk2(-wa[0], -wa[1]); ww.y = pk2(-wa[2], -wa[3]); *(v2u*)(wn + (row0 + 16 * it + n) * 1024) = ww; } }
}

constexpr int GS_W = 0, GS_Q = 17408, GS_K = 34816, GS_A = 53248, GS_U = 62464, GS_E = 64768, GS_BUF = 65536;
__device__ __forceinline__ void gdn_scan_stage(Frame& F, LAS unsigned char* buf, int b, int h, int c, int dv0, int lt) {
    const size_t row0 = (size_t)b * SEQ + c * 64;
    const bf16* z1 = (const bf16*)(F.ws + WS_RZ); const bf16* wn = (const bf16*)(F.ws + WS_WNEG);
    const bf16* kT = (const bf16*)(F.ws + WS_KTP) + (size_t)((b * 8 + h) * 64 + c) * 8192;
    const bf16* uT = (const bf16*)(F.ws + WS_RA) + (size_t)((b * 8 + h) * 64 + c) * 8192 + (size_t)dv0 * 64;
    for (int q = lt; q < 3712; q += 448) {
        v4u v; LAS unsigned char* dst;
        if (q < 1024) { const int r = q >> 4, ck = q & 15; v = *(const v4u*)(wn + (row0 + r) * 1024 + h * 128 + ck * 8); dst = buf + GS_W + r * 272 + ck * 16; }
        else if (q < 2048) { const int r = (q - 1024) >> 4, ck = q & 15; v = *(const v4u*)(z1 + (row0 + r) * 4096 + h * 128 + ck * 8); dst = buf + GS_Q + r * 272 + ck * 16; }
        else if (q < 3072) { const int r = (q - 2048) >> 3, ck = q & 7; v = *(const v4u*)(kT + r * 64 + ck * 8); dst = buf + GS_K + r * 144 + ck * 16; }
        else if (q < 3584) { const int r = (q - 3072) >> 3, ck = q & 7; v = *(const v4u*)(z1 + (row0 + r) * 4096 + 1024 + h * 128 + ck * 8); dst = buf + GS_A + r * 144 + ck * 16; }
        else { const int r = (q - 3584) >> 3, ck = q & 7; v = *(const v4u*)(uT + r * 64 + ck * 8); dst = buf + GS_U + r * 144 + ck * 16; }
        *(LAS v4u*)dst = v; }
    if (lt < 128) { const float* egc = (const float*)(F.ws + WS_EGC) + (size_t)(lt >> 6) * M * 8; ((LAS float*)(buf + GS_E))[lt] = egc[(row0 + (lt & 63)) * 8 + h]; }
}
__device__ __forceinline__ void gdn_scan_task(Frame& F, int task) {
    const int b = task >> 6, h = (task >> 3) & 7, dv0 = (task & 7) * 16, lane = F.lane, n = lane & 15, g = lane >> 4;
    __syncthreads();
    if (F.wave != 0) gdn_scan_stage(F, F.lds, b, h, 0, dv0, F.tid - 64);
    __syncthreads();
    f32x4 S[8];
#pragma unroll
    for (int d = 0; d < 8; ++d) S[d] = (f32x4){0.f, 0.f, 0.f, 0.f};
    bf16* z1 = (bf16*)(F.ws + WS_RZ);
    const float* decp = (const float*)(F.ws + WS_DEC) + (b * 8 + h) * 64;
    for (int c = 0; c < 64; ++c) {
        LAS unsigned char* buf = F.lds + (c & 1) * GS_BUF;
        if (F.wave != 0) { if (c + 1 < 64) gdn_scan_stage(F, F.lds + ((c + 1) & 1) * GS_BUF, b, h, c + 1, dv0, F.tid - 64); }
        else {
            const float dec = decp[c];
            bf16x8 Sb[4];
#pragma unroll
            for (int kq = 0; kq < 4; ++kq) { v4u w; w.x = pk2(S[2 * kq][0], S[2 * kq][1]); w.y = pk2(S[2 * kq][2], S[2 * kq][3]); w.z = pk2(S[2 * kq + 1][0], S[2 * kq + 1][1]); w.w = pk2(S[2 * kq + 1][2], S[2 * kq + 1][3]); Sb[kq] = __builtin_bit_cast(bf16x8, w); }
            f32x4 vn[4];
#pragma unroll
            for (int it = 0; it < 4; ++it) { const v2u uw = *(const LAS v2u*)(buf + GS_U + n * 144 + (16 * it + 4 * g) * 2);
                f32x4 a = (f32x4){bflo(uw.x), bfhi(uw.x), bflo(uw.y), bfhi(uw.y)};
#pragma unroll
                for (int kq = 0; kq < 4; ++kq) a = MFMA16(*(const LAS bf16x8*)(buf + GS_W + (16 * it + n) * 272 + 64 * kq + 16 * g), Sb[kq], a);
                vn[it] = a; }
            bf16x8 Vb[2], Vs[2];
            const LAS float* eg = (const LAS float*)(buf + GS_E);
#pragma unroll
            for (int J = 0; J < 2; ++J) { const f32x4 a = vn[2 * J], c2 = vn[2 * J + 1];
                v4u w; w.x = pk2(a[0], a[1]); w.y = pk2(a[2], a[3]); w.z = pk2(c2[0], c2[1]); w.w = pk2(c2[2], c2[3]); Vb[J] = __builtin_bit_cast(bf16x8, w);
                const f32x4 e0 = *(const LAS f32x4*)(eg + 64 + 32 * J + 4 * g), e1 = *(const LAS f32x4*)(eg + 64 + 32 * J + 16 + 4 * g);
                v4u s; s.x = pk2(a[0] * e0.x, a[1] * e0.y); s.y = pk2(a[2] * e0.z, a[3] * e0.w); s.z = pk2(c2[0] * e1.x, c2[1] * e1.y); s.w = pk2(c2[2] * e1.z, c2[3] * e1.w); Vs[J] = __builtin_bit_cast(bf16x8, s); }
#pragma unroll
            for (int it = 0; it < 4; ++it) { f32x4 qo = (f32x4){0.f, 0.f, 0.f, 0.f};
#pragma unroll
                for (int kq = 0; kq < 4; ++kq) qo = MFMA16(Sb[kq], *(const LAS bf16x8*)(buf + GS_Q + (16 * it + n) * 272 + 64 * kq + 16 * g), qo);
                qo = qo * eg[16 * it + n];
#pragma unroll
                for (int J = 0; J < 2; ++J) { if (J == 1 && it < 2) continue; qo = MFMA16(Vb[J], *(const LAS bf16x8*)(buf + GS_A + (16 * it + n) * 144 + 64 * J + 16 * g), qo); }
                v2u w; w.x = pk2(qo[0], qo[1]); w.y = pk2(qo[2], qo[3]);
                *(v2u*)(z1 + ((size_t)b * SEQ + c * 64 + 16 * it + n) * 4096 + 2048 + h * 128 + dv0 + 4 * g) = w; }
#pragma unroll
            for (int d = 0; d < 8; ++d) { f32x4 a = S[d] * dec;
#pragma unroll
                for (int J = 0; J < 2; ++J) a = MFMA16(*(const LAS bf16x8*)(buf + GS_K + (16 * d + n) * 144 + 64 * J + 16 * g), Vs[J], a);
                S[d] = a; }
        }
        __syncthreads();
    }
}

__device__ __forceinline__ void gdn_outnorm(Frame& F) {
    const int gw = F.bid * 8 + F.wave, NGW = F.G * 8, lane = F.lane;
    const bf16* z1 = (const bf16*)(F.ws + WS_RZ); bf16* og = (bf16*)(F.ws + WS_RA);
    const float* ng = F.in[I_GDNNORMG] + (lane & 7) * 16;
    for (int m = gw; m < M; m += NGW) {
        const v4u o0 = *(const v4u*)(z1 + (size_t)m * 4096 + 2048 + lane * 16), o1 = *(const v4u*)(z1 + (size_t)m * 4096 + 2048 + lane * 16 + 8);
        const v4u g0 = *(const v4u*)(z1 + (size_t)m * 4096 + 3072 + lane * 16), g1 = *(const v4u*)(z1 + (size_t)m * 4096 + 3072 + lane * 16 + 8);
        float ov[16], gv[16];
#pragma unroll
        for (int e = 0; e < 4; ++e) { ov[2 * e] = bflo(o0[e]); ov[2 * e + 1] = bfhi(o0[e]); ov[8 + 2 * e] = bflo(o1[e]); ov[8 + 2 * e + 1] = bfhi(o1[e]);
            gv[2 * e] = bflo(g0[e]); gv[2 * e + 1] = bfhi(g0[e]); gv[8 + 2 * e] = bflo(g1[e]); gv[8 + 2 * e + 1] = bfhi(g1[e]); }
        float s = 0.f;
#pragma unroll
        for (int e = 0; e < 16; ++e) s += ov[e] * ov[e];
        s += __shfl_xor(s, 1); s += __shfl_xor(s, 2); s += __shfl_xor(s, 4);
        const float r = rsqrtf(s * (1.f / 128.f) + EPS);
        float rv[16];
#pragma unroll
        for (int e = 0; e < 16; ++e) rv[e] = ov[e] * r * ng[e] * siluf_(gv[e]);
        v4u w0, w1; w0.x = pk2(rv[0], rv[1]); w0.y = pk2(rv[2], rv[3]); w0.z = pk2(rv[4], rv[5]); w0.w = pk2(rv[6], rv[7]);
        w1.x = pk2(rv[8], rv[9]); w1.y = pk2(rv[10], rv[11]); w1.z = pk2(rv[12], rv[13]); w1.w = pk2(rv[14], rv[15]);
        *(v4u*)(og + (size_t)m * 1024 + lane * 16) = w0; *(v4u*)(og + (size_t)m * 1024 + lane * 16 + 8) = w1; }
}

struct Args { const float* in[N_IN]; float* out; unsigned char* ws; int ph_lo, ph_hi; };
constexpr int NPH = 16;

__global__ void __launch_bounds__(512, 2) mega(Args args) {
    extern __shared__ __attribute__((aligned(16))) unsigned char lds[];
    cg::grid_group grid = cg::this_grid();
    Frame F;
    F.lds = (LAS unsigned char*)lds;
    F.tid = threadIdx.x; F.lane = F.tid & 63; F.wave = __builtin_amdgcn_readfirstlane(F.tid >> 6);
    F.G = gridDim.x; F.bid = blockIdx.x;
#pragma unroll
    for (int i = 0; i < N_IN; ++i) F.in[i] = args.in[i];
    F.out = args.out; F.ws = args.ws;
    const int lo = args.ph_lo, hi = args.ph_hi;
#ifdef PH_ONLY
#define IN(k) ((k) == PH_ONLY && lo <= (k) && (k) < hi)
#else
#define IN(k) (lo <= (k) && (k) < hi)
#endif
#define SEAM(k) do { if (IN(k) && IN((k) + 1)) grid.sync(); } while (0)
    const int gw = F.bid * 8 + F.wave, NGW = F.G * 8;

    if (IN(0)) { p0_prologue(F); } SEAM(0);
    if (IN(1)) { p1_modnorm(F, F.in[I_X], 0); } SEAM(1);
    if (IN(2)) { pg8::Gemm g{(const bf16*)(F.ws + WS_RA), (const bf16*)(F.ws + WS_WIN0), M, AB_IN, D}; pg8::StaticOrder S; S.init(M, AB_IN, F.G, F.bid);
        pg8::EpiBf16<false> E{(bf16*)(F.ws + WS_RZ), AB_IN, nullptr, 0};
        pg8::gemm_phase<pg8::EpiBf16<false>, pg8::StaticOrder, true, true>(F.lds, g, S, E); } SEAM(2);
    if (IN(3)) { if (F.wave < 2) { for (int t = F.bid * 2 + F.wave; t < 512; t += F.G * 2) s5_pass1(F, t); }
        for (int t = F.bid; t < 512; t += F.G) attn_task(F, t); } SEAM(3);
    if (IN(4)) { s5_carry(F); } SEAM(4);
    if (IN(5)) { for (int t = gw; t < 2048; t += NGW) s5_pass2(F, t); } SEAM(5);
    if (IN(6)) { pg8::Gemm g{(const bf16*)(F.ws + WS_YB), (const bf16*)(F.ws + WS_WGLU), M, 512, 512}; pg8::StaticOrder S; S.init(M, 512, F.G, F.bid);
        pg8::EpiGlu E{(const bf16*)(F.ws + WS_YB), (const bf16*)(F.ws + WS_RZ), F.in[I_S5GLUB], (bf16*)(F.ws + WS_RA)};
        pg8::gemm_phase<pg8::EpiGlu, pg8::StaticOrder, true, true>(F.lds, g, S, E); } SEAM(6);
    if (IN(7)) { pg8::Gemm g{(const bf16*)(F.ws + WS_RA), (const bf16*)(F.ws + WS_WOUT0), M, D, D}; pg8::StaticOrder S; S.init(M, D, F.G, F.bid);
        pg8::EpiF32 E{(float*)(F.ws + WS_RZ), D};
        pg8::gemm_phase<pg8::EpiF32, pg8::StaticOrder, true, true>(F.lds, g, S, E); } SEAM(7);
    if (IN(8)) { p_residual<true>(F, F.in[I_X], (const float*)(F.ws + WS_RZ), F.out, 0); } SEAM(8);
    if (IN(9)) { for (int t = F.bid; t < 256; t += F.G) gdn_extras_item(F, t);
        pg8::Gemm g{(const bf16*)(F.ws + WS_RA), (const bf16*)(F.ws + WS_WIN1), M, 4096, D}; pg8::StaticOrder S; S.init(M, 4096, F.G, F.bid);
        pg8::EpiBf16<true> E{(bf16*)(F.ws + WS_RZ), 4096, (bf16*)(F.ws + WS_HALO), 3072};
        pg8::gemm_phase<pg8::EpiBf16<true>, pg8::StaticOrder, true, true>(F.lds, g, S, E); } SEAM(9);
    if (IN(10)) { for (int t = F.bid; t < 2048; t += F.G) gdn_prep_task(F, t); } SEAM(10);
    if (IN(11)) { for (int t = F.bid; t < 256; t += F.G) gdn_scan_task(F, t); } SEAM(11);
    if (IN(12)) { gdn_outnorm(F); } SEAM(12);
    if (IN(13)) { pg8::Gemm g{(const bf16*)(F.ws + WS_RA), (const bf16*)(F.ws + WS_WOUT1), M, D, D}; pg8::StaticOrder S; S.init(M, D, F.G, F.bid);
        pg8::EpiF32 E{(float*)(F.ws + WS_RZ), D};
        pg8::gemm_phase<pg8::EpiF32, pg8::StaticOrder, true, true>(F.lds, g, S, E); } SEAM(13);
    if (IN(14)) { p_residual<false>(F, F.out, (const float*)(F.ws + WS_RZ), F.out, 1); }
#undef IN
#undef SEAM
}

extern "C" void kernel_launch(void* const* d_in, const int* in_sizes, int n_in, void* d_out, int out_size, void* d_ws, size_t ws_size, hipStream_t stream) {
    static int grid = 0;
    if (grid == 0) {
        if (n_in != N_IN || out_size != M * D || ws_size < WS_END) { fprintf(stderr, "kernel_launch: unexpected shapes n_in %d out %d ws %zu\n", n_in, out_size, ws_size); grid = -1; return; }
        int dev = 0, cus = 0, per_cu = 0;
        if (hipGetDevice(&dev) != hipSuccess || hipDeviceGetAttribute(&cus, hipDeviceAttributeMultiprocessorCount, dev) != hipSuccess) { grid = -1; return; }
        if (hipFuncSetAttribute((const void*)mega, hipFuncAttributeMaxDynamicSharedMemorySize, LDS_BYTES) != hipSuccess) { fprintf(stderr, "hipFuncSetAttribute failed\n"); grid = -1; return; }
        if (hipOccupancyMaxActiveBlocksPerMultiprocessor(&per_cu, (const void*)mega, 512, LDS_BYTES) != hipSuccess || per_cu < 1) { fprintf(stderr, "occupancy query: %d\n", per_cu); per_cu = 1; }
        (void)hipGetLastError();
        grid = cus;
        fprintf(stderr, "kernel_launch: grid %d (per_cu %d)\n", grid, per_cu);
    }
    if (grid < 0) return;
    Args a{};
    for (int i = 0; i < N_IN; ++i) a.in[i] = (const float*)d_in[i];
    a.out = (float*)d_out; a.ws = (unsigned char*)d_ws;
#ifdef MULTI_LAUNCH
    for (int p = 0; p < NPH; ++p) { a.ph_lo = p; a.ph_hi = p + 1; void* kargs[] = {&a};
        hipError_t e = hipLaunchCooperativeKernel((const void*)mega, dim3(grid), dim3(512), kargs, LDS_BYTES, stream);
        if (e != hipSuccess) { fprintf(stderr, "launch %d failed: %s\n", p, hipGetErrorString(e)); break; } }
#else
    a.ph_lo = 0; a.ph_hi = NPH; void* kargs[] = {&a};
    hipError_t e = hipLaunchCooperativeKernel((const void*)mega, dim3(grid), dim3(512), kargs, LDS_BYTES, stream);
    if (e != hipSuccess) fprintf(stderr, "cooperative launch failed: %s (grid %d)\n", hipGetErrorString(e), grid);
#endif
}
```

```cpp
#include <hip/hip_runtime.h>
#include <hip/hip_cooperative_groups.h>
#include <cstdio>
#include <cstdint>
namespace cg = cooperative_groups;

constexpr int NB = 4, SEQ = 4096, M = NB * SEQ, D = 1024;
constexpr int AB_IN = 3072, C_IN = 4112;
constexpr float EPS = 1e-6f;
constexpr float LOG2E = 1.4426950408889634f;

enum { I_X = 0, I_C, I_ADAW, I_ADAB, I_PREG, I_POSTG, I_RELB, I_ABWIN, I_ABWOUT, I_S5ARE, I_S5AIM, I_S5LOGDT, I_S5BRE, I_S5BIM, I_S5CRE, I_S5CIM,
       I_S5D, I_S5GLUW, I_S5GLUB, I_GDNWIN, I_GDNCONV, I_GDNALOG, I_GDNDTB, I_GDNNORMG, I_GDNWOUT, N_IN };

constexpr size_t MiB = 1u << 20;
constexpr size_t WS_CTL = 0;
constexpr size_t WS_MOD = 1 * MiB;
constexpr size_t WS_LAM = WS_MOD + 128 * 1024;
constexpr size_t WS_DEC = WS_MOD + 256 * 1024;
constexpr size_t WS_WIN0 = 2 * MiB, WS_WOUT0 = 8 * MiB, WS_WGLU = 10 * MiB, WS_WIN1 = 11 * MiB, WS_WEXT = 19 * MiB, WS_WOUT1 = 20 * MiB;
constexpr size_t WS_EXTRA = 22 * MiB;
constexpr size_t WS_EGC = 23 * MiB;
constexpr size_t WS_RA = 24 * MiB;
constexpr size_t WS_RZ = 56 * MiB;
constexpr size_t WS_RB = 184 * MiB;
constexpr size_t WS_SC = WS_RB, WS_XS = WS_RB + 4 * MiB, WS_YB = WS_RB + 8 * MiB, WS_KT = WS_RB + 24 * MiB, WS_ET = WS_RB + 25 * MiB, WS_FT = WS_RB + 33 * MiB;
constexpr size_t WS_WNEG = WS_RB, WS_KTP = WS_RB + 32 * MiB, WS_HALO = WS_RB + 64 * MiB;
constexpr size_t WS_END = 256 * MiB;

constexpr int LDS_BYTES = 147456;

#define GAS __attribute__((address_space(1)))
#define LAS __attribute__((address_space(3)))
typedef unsigned short bf16;
typedef unsigned v4u __attribute__((ext_vector_type(4)));
typedef unsigned v2u __attribute__((ext_vector_type(2)));
typedef float f32x4 __attribute__((ext_vector_type(4)));
typedef float f32x2 __attribute__((ext_vector_type(2)));
typedef short bf16x8 __attribute__((ext_vector_type(8)));
typedef short s16x4 __attribute__((ext_vector_type(4)));
#define LDS_WAIT() asm volatile("s_waitcnt lgkmcnt(0)" ::: "memory")
#define VM_WAIT() asm volatile("s_waitcnt vmcnt(0)" ::: "memory")
__device__ __forceinline__ unsigned f2bf(float f) { unsigned u = __builtin_bit_cast(unsigned, f); return (u + 0x7fffu + ((u >> 16) & 1u)) >> 16; }
__device__ __forceinline__ unsigned pk2(float lo, float hi) { return f2bf(lo) | (f2bf(hi) << 16); }
__device__ __forceinline__ float bflo(unsigned w) { return __builtin_bit_cast(float, w << 16); }
__device__ __forceinline__ float bfhi(unsigned w) { return __builtin_bit_cast(float, w & 0xffff0000u); }
__device__ __forceinline__ float bf2f(bf16 b) { return __builtin_bit_cast(float, ((unsigned)b) << 16); }
__device__ __forceinline__ float wave_sum(float v) {
#pragma unroll
    for (int o = 1; o < 64; o <<= 1) v += __shfl_xor(v, o);
    return v;
}
__device__ __forceinline__ float sigmoidf_(float x) { return 1.0f / (1.0f + __expf(-x)); }
__device__ __forceinline__ float siluf_(float x) { return x / (1.0f + __expf(-x)); }
__device__ __forceinline__ float gelu_tanh(float x) { const float u = 0.7978845608028654f * (x + 0.044715f * x * x * x); const float e = __expf(2.0f * u); const float t = 1.0f - 2.0f / (e + 1.0f); return 0.5f * x * (1.0f + t); }
typedef GAS unsigned gu32;
#define RLX_AGENT __ATOMIC_RELAXED, __HIP_MEMORY_SCOPE_AGENT
typedef __attribute__((address_space(3))) const char* lds_cptr;
typedef short v4i16_t __attribute__((ext_vector_type(4)));
__device__ __forceinline__ s16x4 vtr(lds_cptr p) { return __builtin_bit_cast(s16x4, __builtin_amdgcn_ds_read_tr16_b64_v4i16((__attribute__((address_space(3))) v4i16_t*)p)); }
#define MFMA16(a, b, c) __builtin_amdgcn_mfma_f32_16x16x32_bf16((a), (b), (c), 0, 0, 0)

#define XB_TMO      128
#define XB_XCNT(j)  (256  + 64 * (j))
#define XB_XSUB(j)  (1280 + 64 * (j))
#define XB_XGEN(j)  (2304 + 64 * (j))
#define XB_TOP      3328
#define XB_TOPGEN   3392
#define XCD_BAR_WORDS 3456
#define XB_SPIN_CAP (1u << 18)

__device__ __forceinline__ unsigned xb_ld(unsigned* p)              { return __hip_atomic_load(p, __ATOMIC_RELAXED, __HIP_MEMORY_SCOPE_AGENT); }
__device__ __forceinline__ unsigned xb_add(unsigned* p, unsigned v) { return __hip_atomic_fetch_add(p, v, __ATOMIC_RELAXED, __HIP_MEMORY_SCOPE_AGENT); }
__device__ __forceinline__ unsigned xb_xcc_id() { return (unsigned)__builtin_amdgcn_s_getreg((3 << 11) | 20) & 0xFu; }
#define XB_SPIN(cond, bar) do { unsigned _sp = 0; while (cond) { __builtin_amdgcn_s_sleep(1); \
    if ((++_sp & 255u) == 0u) { if (xb_ld(&(bar)[XB_TMO])) break; if (_sp > XB_SPIN_CAP) { atomicAdd(&(bar)[XB_TMO], 1u); break; } } } } while (0)

struct XcdBarrier {
    unsigned* bar; unsigned x;
    volatile LAS unsigned* st;
};

__device__ __forceinline__ XcdBarrier xcd_barrier_post(unsigned* bar, volatile LAS unsigned* st) {
    XcdBarrier b; b.bar = bar; b.x = xb_xcc_id(); b.st = st;
    if (threadIdx.x == 0) (void)xb_add(&bar[XB_XCNT(b.x)], 1u);
    return b;
}
__device__ __forceinline__ void xcd_barrier_complete(unsigned* bar, unsigned x, unsigned& nloc, unsigned& nx) {
    const unsigned G = gridDim.x * gridDim.y * gridDim.z;
    unsigned sum, cnt, mine, sp = 0u;
    for (;;) {
        sum = 0u; cnt = 0u; mine = 0u;
#pragma unroll
        for (unsigned j = 0; j < 16; ++j) { const unsigned c = xb_ld(&bar[XB_XCNT(j)]); sum += c; cnt += (c > 0u) ? 1u : 0u; mine = (j == x) ? c : mine; }
        if (sum == G) break;
        __builtin_amdgcn_s_sleep(1);
        if ((++sp & 255u) == 0u) { if (xb_ld(&bar[XB_TMO])) break; if (sp > XB_SPIN_CAP) { atomicAdd(&bar[XB_TMO], 1u); break; } }
    }
    nloc = mine > 0u ? mine : 1u; nx = cnt > 0u ? cnt : 1u;
}

__device__ __forceinline__ void xcd_barrier(const XcdBarrier& b) {
    asm volatile("s_waitcnt vmcnt(0)" ::: "memory");
    __syncthreads();
    if (threadIdx.x == 0) {
        unsigned* bar = b.bar;
        __builtin_amdgcn_s_waitcnt(0);
        unsigned nloc = b.st[0], nx = b.st[1];
        if (nloc == 0u) { xcd_barrier_complete(bar, b.x, nloc, nx); b.st[0] = nloc; b.st[1] = nx; }
        const unsigned old = xb_add(&bar[XB_XSUB(b.x)], 1u);
        const unsigned gen = old / nloc;
        if (old + 1u == (gen + 1u) * nloc) {
            __builtin_amdgcn_fence(__ATOMIC_RELEASE, "agent");
            asm volatile("s_waitcnt vmcnt(0)" ::: "memory");
            const unsigned og = xb_add(&bar[XB_TOP], 1u);
            const unsigned tg = og / nx;
            if (og + 1u == (tg + 1u) * nx) xb_add(&bar[XB_TOPGEN], 1u);
            else XB_SPIN(xb_ld(&bar[XB_TOPGEN]) == tg, bar);
            __builtin_amdgcn_fence(__ATOMIC_ACQUIRE, "agent");
            xb_add(&bar[XB_XGEN(b.x)], 1u);
            asm volatile("s_waitcnt vmcnt(0)" ::: "memory");
        } else {
            XB_SPIN(xb_ld(&bar[XB_XGEN(b.x)]) == gen, bar);
            __builtin_amdgcn_fence(__ATOMIC_ACQUIRE, "agent");
            asm volatile("s_waitcnt vmcnt(0)" ::: "memory");
        }
    }
    __syncthreads();
}
namespace pg8 {
#define PG8_LAS __attribute__((address_space(3)))
typedef unsigned short bf16_t;
typedef short bf16x8 __attribute__((ext_vector_type(8)));
typedef float f32x4 __attribute__((ext_vector_type(4)));
typedef unsigned u32x4 __attribute__((ext_vector_type(4)));
constexpr int BM = 256, BK = 64, HALF = 128, HTB = HALF * BK * 2  , STAGE_BYTES = 8 * HTB, NXCD = 8, WGM = 8;

__host__ __device__ __forceinline__ int lds_byte(int r, int c) { const int st = (r >> 4) * 2 + (c >> 5), rr = r & 15, cc = c & 31, ob = rr * 64 + cc * 2; return st * 1024 + (ob ^ (((ob >> 9) & 1) << 5)); }
__host__ __device__ __forceinline__ void stage_rc(int b, int& R, int& C) { const int st = b / 1024, sb = b % 1024, swz = sb ^ (((sb >> 9) & 1) << 5); R = (st >> 1) * 16 + swz / 64; C = (st & 1) * 32 + (swz % 64) / 2; }
__host__ __device__ __forceinline__ int perm32(int rho) { const int n = rho >> 4, i = rho & 15; return 8 * (i >> 2) + 4 * n + (i & 3); }

struct Unit { int pm, pn; };
struct Gemm { const bf16_t* A; const bf16_t* Bt; int M, N, K; };

struct StaticOrder {
    int nM, nN, nwg, G, c;
    __host__ __device__ void init(int M, int N, int G_, int c_) { nM = M / BM; nN = N / BM; nwg = nM * nN; G = G_; c = c_; }
    __host__ __device__ bool next(int i, Unit& u) const {
        const long L = (long)i * G + c; if (L >= nwg) return false;
        int wgid = (int)L; { const int q = nwg / NXCD, r = nwg % NXCD, xcd = wgid % NXCD, off = wgid / NXCD; wgid = (xcd < r ? xcd * (q + 1) : r * (q + 1) + (xcd - r) * q) + off; }
        const int nig = WGM * nN, gid = wgid / nig, fm = gid * WGM, gsz = (nM - fm) < WGM ? (nM - fm) : WGM;
        u.pm = fm + ((wgid % nig) % gsz); u.pn = (wgid % nig) / gsz; return true;
    }
    __device__ __forceinline__ void a_ready(const Unit&) const {}
    __device__ __forceinline__ void done(const Unit&) const {}
};


__device__ __forceinline__ unsigned cvt_pk_bf16(float lo, float hi) { unsigned r; asm volatile("v_cvt_pk_bf16_f32 %0, %1, %2" : "=v"(r) : "v"(lo), "v"(hi)); return r; }

template <bool HALO> struct EpiBf16 {
    static constexpr bool PERM = true, AFTER_DRAIN = false;
    bf16_t* O; int ldc; bf16_t* halo; int halo_cols;
    __device__ __forceinline__ void operator()(const f32x4 (&acc)[2][2][4][2], const Unit& u, int wr, int wc, int fr, int fq) const {
        const int row0 = u.pm * BM + wr * 64 + fr; const int col0 = u.pn * BM + wc * 32 + 8 * fq;
#pragma unroll
        for (int ai = 0; ai < 2; ++ai)
#pragma unroll
            for (int m = 0; m < 4; ++m) { const int row = row0 + ai * HALF + m * 16; bf16_t* rowp = O + (size_t)row * ldc + col0;
#pragma unroll
                for (int bj = 0; bj < 2; ++bj) { const f32x4 v0 = acc[ai][bj][m][0], v1 = acc[ai][bj][m][1];
                    u32x4 w; w.x = cvt_pk_bf16(v0[0], v0[1]); w.y = cvt_pk_bf16(v0[2], v0[3]); w.z = cvt_pk_bf16(v1[0], v1[1]); w.w = cvt_pk_bf16(v1[2], v1[3]);
                    *(u32x4*)(rowp + bj * HALF) = w;
                    if (HALO) { if (m == 3 && fr >= 13 && (col0 + bj * HALF) < halo_cols) *(u32x4*)(halo + ((size_t)(row >> 6) * 3 + (fr - 13)) * halo_cols + col0 + bj * HALF) = w; }
                } }
    }
};
struct EpiF32 {
    static constexpr bool PERM = false, AFTER_DRAIN = false;
    float* C; int ldc;
    __device__ __forceinline__ void operator()(const f32x4 (&acc)[2][2][4][2], const Unit& u, int wr, int wc, int fr, int fq) const {
        const int row0 = u.pm * BM + wr * 64 + fr, col0 = u.pn * BM + wc * 32 + 4 * fq;
#pragma unroll
        for (int ai = 0; ai < 2; ++ai)
#pragma unroll
            for (int m = 0; m < 4; ++m) { float* rowp = C + (size_t)(row0 + ai * HALF + m * 16) * ldc + col0;
#pragma unroll
                for (int bj = 0; bj < 2; ++bj)
#pragma unroll
                    for (int n = 0; n < 2; ++n) *(f32x4*)(rowp + bj * HALF + n * 16) = acc[ai][bj][m][n]; }
    }
};
struct EpiGlu {
    static constexpr bool PERM = true, AFTER_DRAIN = false;
    const bf16_t* yb; const bf16_t* z0; const float* glu_b; bf16_t* O;
    __device__ __forceinline__ void operator()(const f32x4 (&acc)[2][2][4][2], const Unit& u, int wr, int wc, int fr, int fq) const {
        const int row0 = u.pm * BM + wr * 64 + fr; const int col0 = u.pn * BM + wc * 32 + 8 * fq;
#pragma unroll
        for (int bj = 0; bj < 2; ++bj) { const int c = col0 + bj * HALF;
            const f32x4 b0 = *(const f32x4*)(glu_b + c), b1 = *(const f32x4*)(glu_b + c + 4);
#pragma unroll
            for (int ai = 0; ai < 2; ++ai)
#pragma unroll
                for (int m = 0; m < 4; ++m) { const size_t row = (size_t)(row0 + ai * HALF + m * 16);
                    const u32x4 yw = *(const u32x4*)(yb + row * 512 + c); const u32x4 gw = *(const u32x4*)(z0 + row * 3072 + 2560 + c);
                    const f32x4 v0 = acc[ai][bj][m][0] + b0, v1 = acc[ai][bj][m][1] + b1;
                    float r[8];
#pragma unroll
                    for (int j = 0; j < 4; ++j) { const unsigned ywj = yw[j], gwj = gw[j];
                        const float ylo = __builtin_bit_cast(float, ywj << 16), yhi = __builtin_bit_cast(float, ywj & 0xffff0000u);
                        const float glo = __builtin_bit_cast(float, gwj << 16), ghi = __builtin_bit_cast(float, gwj & 0xffff0000u);
                        const float a0 = (j < 2) ? v0[2 * j] : v1[2 * j - 4], a1 = (j < 2) ? v0[2 * j + 1] : v1[2 * j - 3];
                        r[2 * j] = ylo / (1.0f + __expf(-a0)) * (glo / (1.0f + __expf(-glo)));
                        r[2 * j + 1] = yhi / (1.0f + __expf(-a1)) * (ghi / (1.0f + __expf(-ghi))); }
                    u32x4 w; w.x = cvt_pk_bf16(r[0], r[1]); w.y = cvt_pk_bf16(r[2], r[3]); w.z = cvt_pk_bf16(r[4], r[5]); w.w = cvt_pk_bf16(r[6], r[7]);
                    *(u32x4*)(O + row * 1024 + 512 + c) = w; } }
    }
};
template <class Epi, class Sched, bool ALIGN_EPI = false, bool SP2 = false>
__device__ __forceinline__ void gemm_phase(PG8_LAS unsigned char* lds, const Gemm g, const Sched& S, const Epi& E) {
    const int tid = threadIdx.x, wid = __builtin_amdgcn_readfirstlane(tid >> 6), lane = tid & 63, wr = wid >> 2, wc = wid & 3, fr = lane & 15, fq = lane >> 4;
    const int K = g.K, nt = K / BK;
    unsigned voffA[2], voffB[2];
#pragma unroll
    for (int i = 0; i < 2; ++i) { int R, C; stage_rc(tid * 16 + i * 8192, R, C); const int Rb = Epi::PERM ? ((R & ~31) + perm32(R & 31)) : R;
        voffA[i] = (unsigned)(R * K + C) * 2u; voffB[i] = (unsigned)(Rb * K + C) * 2u; }
    const size_t kstep = (size_t)(BK * 2);
    const size_t hstep = (size_t)HALF * K * 2;
    const size_t tstep = 2 * hstep;
    const unsigned ldsw = (unsigned)wid * 1024u;
    const int aoff = lds_byte(wr * 64 + fr, fq * 8), boff = lds_byte(wc * 32 + fr, fq * 8);
#define PG8_SA(b, h) (((b) * 2 + (h)) * HTB)
#define PG8_SB(b, h) ((4 + (b) * 2 + (h)) * HTB)
#define PG8_STAGE(bufoff, gbase, voff) do { _Pragma("unroll") for (int _i = 0; _i < 2; ++_i) \
        __builtin_amdgcn_global_load_lds((const unsigned*)((const char*)(gbase) + (voff)[_i]), (PG8_LAS unsigned*)(lds + (bufoff) + ldsw + _i * 8192), 16, 0, 0); } while (0)
#define PG8_LDA(dst, b, h) do { _Pragma("unroll") for (int m = 0; m < 4; ++m) _Pragma("unroll") for (int k = 0; k < 2; ++k) dst[m][k] = *(const PG8_LAS bf16x8*)(lds + PG8_SA(b, h) + aoff + m * 2048 + k * 1024); } while (0)
#define PG8_LDB(dst, b, h) do { _Pragma("unroll") for (int n = 0; n < 2; ++n) _Pragma("unroll") for (int k = 0; k < 2; ++k) dst[n][k] = *(const PG8_LAS bf16x8*)(lds + PG8_SB(b, h) + boff + n * 2048 + k * 1024); } while (0)
#define PG8_MMA(ai, bj, At, Bt) do { __builtin_amdgcn_s_setprio(1); _Pragma("unroll") for (int m = 0; m < 4; ++m) _Pragma("unroll") for (int n = 0; n < 2; ++n) _Pragma("unroll") for (int k = 0; k < 2; ++k) \
        acc[ai][bj][m][n] = __builtin_amdgcn_mfma_f32_16x16x32_bf16(Bt[n][k], At[m][k], acc[ai][bj][m][n], 0, 0, 0); __builtin_amdgcn_s_setprio(0); } while (0)
#define PG8_WAIT_V(n) asm volatile("s_waitcnt vmcnt(" #n ")" ::: "memory")
#define PG8_WAIT_L(n) asm volatile("s_waitcnt lgkmcnt(" #n ")" ::: "memory")
#define PG8_BAR __builtin_amdgcn_s_barrier()
#define PG8_SCHED __builtin_amdgcn_sched_barrier(0)
    Unit cur, nxt; int ui = 0;
    if (!S.next(0, cur)) return;
    f32x4 acc[2][2][4][2];
#pragma unroll
    for (int a = 0; a < 2; ++a)
#pragma unroll
        for (int b = 0; b < 2; ++b)
#pragma unroll
            for (int m = 0; m < 4; ++m)
#pragma unroll
                for (int n = 0; n < 2; ++n) acc[a][b][m][n] = (f32x4){0.f, 0.f, 0.f, 0.f};
    bf16x8 At[4][2], B0[2][2], B1[2][2];
    const char* cA = (const char*)g.A + (size_t)cur.pm * tstep; const char* cB = (const char*)g.Bt + (size_t)cur.pn * tstep;
    S.a_ready(cur);
    if constexpr (SP2) {
        PG8_STAGE(PG8_SB(0, 0), cB, voffB); PG8_STAGE(PG8_SB(0, 1), cB + hstep, voffB); PG8_STAGE(PG8_SA(0, 0), cA, voffA); PG8_STAGE(PG8_SA(0, 1), cA + hstep, voffA);
        if (wr == 1) PG8_BAR;
        PG8_WAIT_V(2); PG8_BAR;
        PG8_STAGE(PG8_SB(1, 0), cB + kstep, voffB); PG8_STAGE(PG8_SA(1, 0), cA + kstep, voffA); PG8_STAGE(PG8_SB(1, 1), cB + hstep + kstep, voffB);
        PG8_WAIT_V(6); PG8_BAR;
    } else {
        PG8_STAGE(PG8_SB(0, 0), cB, voffB); PG8_STAGE(PG8_SA(0, 0), cA, voffA); PG8_STAGE(PG8_SB(0, 1), cB + hstep, voffB); PG8_STAGE(PG8_SA(0, 1), cA + hstep, voffA);
        if (wr == 1) PG8_BAR;
        PG8_WAIT_V(4); PG8_BAR;
        PG8_STAGE(PG8_SB(1, 0), cB + kstep, voffB); PG8_STAGE(PG8_SA(1, 0), cA + kstep, voffA); PG8_STAGE(PG8_SB(1, 1), cB + hstep + kstep, voffB);
        PG8_WAIT_V(6); PG8_BAR;
    }
    for (;;) {
        const bool has_next = S.next(ui + 1, nxt);
        const char* nA = has_next ? (const char*)g.A + (size_t)nxt.pm * tstep : cA; const char* nB = has_next ? (const char*)g.Bt + (size_t)nxt.pn * tstep : cB;
        for (int t = 0; t < nt; t += 2) {
            const bool last = (t == nt - 2);
            const char* a1 = cA + (size_t)(t + 1) * kstep;
            const char* a2 = last ? nA : cA + (size_t)(t + 2) * kstep; const char* b2 = last ? nB : cB + (size_t)(t + 2) * kstep;
            const char* a3 = a2 + kstep; const char* b3 = b2 + kstep;
            if (last && has_next) S.a_ready(nxt);
            if constexpr (SP2) {
            PG8_LDB(B0, 0, 0); PG8_LDB(B1, 0, 1); PG8_SCHED; PG8_LDA(At, 0, 0); PG8_STAGE(PG8_SA(1, 1), a1 + hstep, voffA);
            PG8_WAIT_V(8); PG8_WAIT_L(0); PG8_BAR; PG8_MMA(0, 0, At, B0); PG8_MMA(0, 1, At, B1); PG8_BAR; PG8_SCHED;
            PG8_LDA(At, 0, 1); PG8_STAGE(PG8_SB(0, 0), b2, voffB); PG8_STAGE(PG8_SB(0, 1), b2 + hstep, voffB); PG8_STAGE(PG8_SA(0, 0), a2, voffA);
            PG8_WAIT_V(8); PG8_WAIT_L(0); PG8_BAR; PG8_MMA(1, 0, At, B0); PG8_MMA(1, 1, At, B1); PG8_BAR; PG8_SCHED;
            PG8_LDB(B0, 1, 0); PG8_LDB(B1, 1, 1); PG8_SCHED; PG8_LDA(At, 1, 0); PG8_STAGE(PG8_SA(0, 1), a2 + hstep, voffA);
            PG8_WAIT_V(8); PG8_WAIT_L(0); PG8_BAR; PG8_MMA(0, 0, At, B0); PG8_MMA(0, 1, At, B1); PG8_BAR; PG8_SCHED;
            PG8_LDA(At, 1, 1); PG8_STAGE(PG8_SB(1, 0), b3, voffB); PG8_STAGE(PG8_SB(1, 1), b3 + hstep, voffB); PG8_STAGE(PG8_SA(1, 0), a3, voffA);
            PG8_WAIT_V(8); PG8_WAIT_L(0); PG8_BAR; PG8_MMA(1, 0, At, B0); PG8_MMA(1, 1, At, B1); PG8_BAR; PG8_SCHED;
            } else {
            PG8_LDB(B0, 0, 0); PG8_SCHED; PG8_LDA(At, 0, 0); PG8_STAGE(PG8_SA(1, 1), a1 + hstep, voffA);
            PG8_WAIT_L(8); PG8_BAR; PG8_WAIT_L(0); PG8_MMA(0, 0, At, B0); PG8_BAR; PG8_SCHED;
            PG8_LDB(B1, 0, 1); PG8_STAGE(PG8_SB(0, 0), b2, voffB);
            PG8_BAR; PG8_WAIT_L(0); PG8_MMA(0, 1, At, B1); PG8_BAR;
            PG8_LDA(At, 0, 1); PG8_STAGE(PG8_SA(0, 0), a2, voffA);
            PG8_BAR; PG8_WAIT_L(0); PG8_MMA(1, 0, At, B0); PG8_BAR; PG8_SCHED;
            PG8_STAGE(PG8_SB(0, 1), b2 + hstep, voffB);
            PG8_WAIT_V(6); PG8_BAR; PG8_MMA(1, 1, At, B1); PG8_BAR;
            PG8_LDB(B0, 1, 0); PG8_SCHED; PG8_LDA(At, 1, 0); PG8_STAGE(PG8_SA(0, 1), a2 + hstep, voffA);
            PG8_WAIT_L(8); PG8_BAR; PG8_WAIT_L(0); PG8_MMA(0, 0, At, B0); PG8_BAR; PG8_SCHED;
            PG8_LDB(B1, 1, 1); PG8_STAGE(PG8_SB(1, 0), b3, voffB);
            PG8_BAR; PG8_WAIT_L(0); PG8_MMA(0, 1, At, B1); PG8_BAR;
            PG8_LDA(At, 1, 1); PG8_STAGE(PG8_SA(1, 0), a3, voffA);
            PG8_BAR; PG8_WAIT_L(0); PG8_MMA(1, 0, At, B0); PG8_BAR; PG8_SCHED;
            PG8_STAGE(PG8_SB(1, 1), b3 + hstep, voffB);
            PG8_WAIT_V(6); PG8_BAR; PG8_MMA(1, 1, At, B1); PG8_BAR;
            }
        }
        if constexpr (ALIGN_EPI) { if (wr == 0) PG8_BAR; }
        if constexpr (!Epi::AFTER_DRAIN) { E(acc, cur, wr, wc, fr, fq); S.done(cur); }
        if (!has_next) break;
#pragma unroll
        for (int a = 0; a < 2; ++a)
#pragma unroll
            for (int b = 0; b < 2; ++b)
#pragma unroll
                for (int m = 0; m < 4; ++m)
#pragma unroll
                    for (int n = 0; n < 2; ++n) acc[a][b][m][n] = (f32x4){0.f, 0.f, 0.f, 0.f};
        cur = nxt; cA = nA; cB = nB; ++ui;
        if constexpr (ALIGN_EPI) { if (wr == 1) PG8_BAR; }
    }
    PG8_WAIT_V(0);
    if constexpr (!ALIGN_EPI) { if (wr == 0) PG8_BAR; }
    PG8_BAR;
    if constexpr (Epi::AFTER_DRAIN) { E.fused(acc, cur, wr, wc, fr, fq, lds, wid, lane); S.done(cur); }
#undef PG8_SA
#undef PG8_SB
#undef PG8_STAGE
#undef PG8_LDA
#undef PG8_LDB
#undef PG8_MMA
#undef PG8_WAIT_V
#undef PG8_WAIT_L
#undef PG8_BAR
#undef PG8_SCHED
}
}

struct Frame {
    LAS unsigned char* lds;
    int tid, lane, wave, G, bid;
    const float* in[N_IN];
    float* out;
    unsigned char* ws;
};

__device__ __forceinline__ void p0_transpose_item(const float* W, int K, int N, int ldn, bf16* WT, LAS float* scr, int item, int lane) {
    const int nblk = N / 32, kb = item / nblk, nb = item % nblk, k0 = 64 * kb, n0 = 32 * nb;
#pragma unroll 8
    for (int i = 0; i < 32; ++i) { const int kk = 2 * i + (lane >> 5); scr[kk * 33 + (lane & 31)] = W[(size_t)(k0 + kk) * ldn + n0 + (lane & 31)]; }
    LDS_WAIT(); asm volatile("" ::: "memory");
    const int c = lane & 7;
#pragma unroll
    for (int j = 0; j < 4; ++j) { const int n = (lane >> 3) + 8 * j; const LAS float* s = scr + (8 * c) * 33 + n;
        v4u o; o.x = pk2(s[0 * 33], s[1 * 33]); o.y = pk2(s[2 * 33], s[3 * 33]); o.z = pk2(s[4 * 33], s[5 * 33]); o.w = pk2(s[6 * 33], s[7 * 33]);
        *(GAS v4u*)(WT + (size_t)(n0 + n) * K + k0 + 8 * c) = o; }
    LDS_WAIT(); asm volatile("" ::: "memory");
}

__device__ __forceinline__ void p0_mod_item(Frame& F, int item) {
    LAS float* sc = (LAS float*)(F.lds);
    LAS float* red = (LAS float*)(F.lds + 16384);
    const float* c = F.in[I_C];
    for (int i = F.tid; i < 4096; i += 512) sc[i] = siluf_(c[i]);
    __syncthreads();
    const int l = item / 96, nb = item % 96, n = nb * 32 + (F.lane & 31), kh = F.lane >> 5;
    const float* W = F.in[I_ADAW] + (size_t)l * 1024 * 3072;
    float a0 = 0.f, a1 = 0.f, a2 = 0.f, a3 = 0.f;
    const int kbase = F.wave * 128;
#pragma unroll 8
    for (int i = 0; i < 64; ++i) { const int k = kbase + 2 * i + kh; const float w = W[(size_t)k * 3072 + n];
        a0 += sc[k] * w; a1 += sc[1024 + k] * w; a2 += sc[2048 + k] * w; a3 += sc[3072 + k] * w; }
    a0 += __shfl_xor(a0, 32); a1 += __shfl_xor(a1, 32); a2 += __shfl_xor(a2, 32); a3 += __shfl_xor(a3, 32);
    if (F.lane < 32) { red[(F.wave * 4 + 0) * 32 + F.lane] = a0; red[(F.wave * 4 + 1) * 32 + F.lane] = a1; red[(F.wave * 4 + 2) * 32 + F.lane] = a2; red[(F.wave * 4 + 3) * 32 + F.lane] = a3; }
    __syncthreads();
    if (F.tid < 128) { const int b = F.tid >> 5, nn = F.tid & 31; float s = 0.f;
#pragma unroll
        for (int w = 0; w < 8; ++w) s += red[(w * 4 + b) * 32 + nn];
        float* mod = (float*)(F.ws + WS_MOD);
        mod[(size_t)(l * 4 + b) * 3072 + nb * 32 + nn] = s + F.in[I_ADAB][l * 3072 + nb * 32 + nn]; }
    __syncthreads();
}

__device__ __forceinline__ void p0_s5_tables(Frame& F, int g) {
    LAS float* pw = (LAS float*)(F.lds);
    LAS float* bb = (LAS float*)(F.lds + 34816);
    LAS float* cc = (LAS float*)(F.lds + 34816 + 8192);
    const float dt = __expf(F.in[I_S5LOGDT][g]);
    for (int i = F.tid; i < 65 * 64; i += 512) { const int tau = i >> 6, p = i & 63;
        const float ar = F.in[I_S5ARE][g * 64 + p], ai = F.in[I_S5AIM][g * 64 + p];
        const float mag = expf((float)tau * (dt * ar)); float sn, cs; sincosf((float)tau * (dt * ai), &sn, &cs);
        pw[2 * i] = mag * cs; pw[2 * i + 1] = mag * sn; }
    for (int i = F.tid; i < 64 * 16; i += 512) { const int p = i >> 4, m = i & 15;
        const float ar = F.in[I_S5ARE][g * 64 + p], ai = F.in[I_S5AIM][g * 64 + p];
        const float mag = expf(dt * ar); float sn, cs; sincosf(dt * ai, &sn, &cs);
        const float abr = mag * cs, abi = mag * sn, den = ar * ar + ai * ai;
        const float fr = ((abr - 1.0f) * ar + abi * ai) / den, fi = (abi * ar - (abr - 1.0f) * ai) / den;
        const float br = F.in[I_S5BRE][(size_t)(g * 64 + p) * 16 + m], bi = F.in[I_S5BIM][(size_t)(g * 64 + p) * 16 + m];
        bb[2 * i] = fr * br - fi * bi; bb[2 * i + 1] = fr * bi + fi * br; }
    for (int i = F.tid; i < 16 * 64; i += 512) { cc[2 * i] = F.in[I_S5CRE][(size_t)g * 1024 + i]; cc[2 * i + 1] = F.in[I_S5CIM][(size_t)g * 1024 + i]; }
    __syncthreads();
    if (F.tid < 64) { float* lam = (float*)(F.ws + WS_LAM); lam[(g * 64 + F.tid) * 2] = pw[2 * (64 * 64 + F.tid)]; lam[(g * 64 + F.tid) * 2 + 1] = pw[2 * (64 * 64 + F.tid) + 1]; }
    { const int tau = F.tid >> 3, m0 = (F.tid & 7) * 2;
      float acc[2][16];
#pragma unroll
      for (int a = 0; a < 2; ++a)
#pragma unroll
          for (int b = 0; b < 16; ++b) acc[a][b] = 0.f;
      for (int p = 0; p < 64; ++p) { const float wr_ = pw[2 * (tau * 64 + p)], wi_ = pw[2 * (tau * 64 + p) + 1];
#pragma unroll
          for (int a = 0; a < 2; ++a) { const float cr = cc[2 * ((m0 + a) * 64 + p)], ci = cc[2 * ((m0 + a) * 64 + p) + 1];
              const float hr = cr * wr_ - ci * wi_, hi = cr * wi_ + ci * wr_;
#pragma unroll
              for (int b = 0; b < 16; ++b) acc[a][b] += hr * bb[2 * (p * 16 + b)] - hi * bb[2 * (p * 16 + b) + 1]; } }
      bf16* Kt = (bf16*)(F.ws + WS_KT) + (size_t)g * 64 * 256;
#pragma unroll
      for (int a = 0; a < 2; ++a) { unsigned* dst = (unsigned*)(Kt + (size_t)tau * 256 + (m0 + a) * 16);
#pragma unroll
          for (int b = 0; b < 8; ++b) dst[b] = pk2(acc[a][2 * b], acc[a][2 * b + 1]); } }
    { unsigned* Et = (unsigned*)((bf16*)(F.ws + WS_ET) + (size_t)g * 128 * 1024);
      for (int i = F.tid; i < 128 * 512; i += 512) { const int row = i >> 9, k = (i & 511) * 2, part = row >> 6, p = row & 63, t = k >> 4, m = k & 15;
          const float wr_ = pw[2 * ((63 - t) * 64 + p)], wi_ = pw[2 * ((63 - t) * 64 + p) + 1];
          const float b0r = bb[2 * (p * 16 + m)], b0i = bb[2 * (p * 16 + m) + 1], b1r = bb[2 * (p * 16 + m + 1)], b1i = bb[2 * (p * 16 + m + 1) + 1];
          const float v0 = part ? (wr_ * b0i + wi_ * b0r) : (wr_ * b0r - wi_ * b0i), v1 = part ? (wr_ * b1i + wi_ * b1r) : (wr_ * b1r - wi_ * b1i);
          Et[i] = pk2(v0, v1); } }
    { unsigned* Ft = (unsigned*)((bf16*)(F.ws + WS_FT) + (size_t)g * 1024 * 128);
      for (int i = F.tid; i < 1024 * 64; i += 512) { const int row = i >> 6, pk = (i & 63) * 2, ti = row >> 4, m = row & 15, part = pk >> 6, p = pk & 63;
          float v[2];
#pragma unroll
          for (int e = 0; e < 2; ++e) { const float wr_ = pw[2 * ((ti + 1) * 64 + p + e)], wi_ = pw[2 * ((ti + 1) * 64 + p + e) + 1];
              const float cr = cc[2 * (m * 64 + p + e)], ci = cc[2 * (m * 64 + p + e) + 1];
              v[e] = part ? -(cr * wi_ + ci * wr_) : (cr * wr_ - ci * wi_); }
          Ft[i] = pk2(v[0], v[1]); } }
    __syncthreads();
}

__device__ __forceinline__ void p0_prologue(Frame& F) {
    if (F.bid < 192) p0_mod_item(F, F.bid);
    else if (F.bid < 224) p0_s5_tables(F, F.bid - 192);
    __syncthreads();
    LAS float* scr = (LAS float*)(F.lds + F.wave * 16384);
    const int gw = F.bid * 8 + F.wave, NGW = F.G * 8;
    constexpr int I_A = 16 * 96, I_B = 16 * 32, I_C2 = 8 * 16, I_D = 16 * 128, I_E = 16 * 32;
    constexpr int NITEMS = I_A + I_B + I_C2 + I_D + I_E;
    for (int it = gw; it < NITEMS; it += NGW) {
        int r = it;
        if (r < I_A) { p0_transpose_item(F.in[I_ABWIN], 1024, 3072, 3072, (bf16*)(F.ws + WS_WIN0), scr, r, F.lane); continue; } r -= I_A;
        if (r < I_B) { p0_transpose_item(F.in[I_ABWOUT], 1024, 1024, 1024, (bf16*)(F.ws + WS_WOUT0), scr, r, F.lane); continue; } r -= I_B;
        if (r < I_C2) { p0_transpose_item(F.in[I_S5GLUW], 512, 512, 512, (bf16*)(F.ws + WS_WGLU), scr, r, F.lane); continue; } r -= I_C2;
        if (r < I_D) { p0_transpose_item(F.in[I_GDNWIN], 1024, 4096, C_IN, (bf16*)(F.ws + WS_WIN1), scr, r, F.lane); continue; } r -= I_D;
        p0_transpose_item(F.in[I_GDNWOUT], 1024, 1024, 1024, (bf16*)(F.ws + WS_WOUT1), scr, r, F.lane);
    }
    { bf16* we = (bf16*)(F.ws + WS_WEXT); const float* W = F.in[I_GDNWIN];
      for (int i = F.bid * 512 + F.tid; i < 16 * 1024; i += F.G * 512) { const int j = i >> 10, k = i & 1023; we[i] = (bf16)f2bf(W[(size_t)k * C_IN + 4096 + j]); } }
}

__device__ __forceinline__ void modnorm_row(const f32x4 (&v)[4], int lane, const float* g, const float* shift, const float* scale, bf16* orow) {
    float s = 0.f;
#pragma unroll
    for (int j = 0; j < 4; ++j) s += (v[j].x * v[j].x + v[j].y * v[j].y) + (v[j].z * v[j].z + v[j].w * v[j].w);
    const float r = rsqrtf(wave_sum(s) * (1.f / D) + EPS);
    GAS unsigned long long* o8 = (GAS unsigned long long*)orow + lane;
#pragma unroll
    for (int j = 0; j < 4; ++j) { const int c = 4 * lane + 256 * j;
        const f32x4 gg = *(const f32x4*)(g + c), sh = *(const f32x4*)(shift + c), sc = *(const f32x4*)(scale + c);
        const float h0 = v[j].x * r * gg.x * (1.f + sc.x) + sh.x, h1 = v[j].y * r * gg.y * (1.f + sc.y) + sh.y;
        const float h2 = v[j].z * r * gg.z * (1.f + sc.z) + sh.z, h3 = v[j].w * r * gg.w * (1.f + sc.w) + sh.w;
        o8[64 * j] = (unsigned long long)pk2(h0, h1) | ((unsigned long long)pk2(h2, h3) << 32); }
}
__device__ __forceinline__ void p1_modnorm(Frame& F, const float* x, int layer) {
    const int gw = F.bid * 8 + F.wave, NGW = F.G * 8;
    const float* mod = (const float*)(F.ws + WS_MOD) + (size_t)layer * 4 * 3072;
    bf16* H = (bf16*)(F.ws + WS_RA);
    for (int m = gw; m < M; m += NGW) { const int b = m >> 12;
        const GAS f32x4* xr = (const GAS f32x4*)(x + (size_t)m * D) + F.lane;
        f32x4 v[4];
#pragma unroll
        for (int j = 0; j < 4; ++j) v[j] = xr[64 * j];
        modnorm_row(v, F.lane, F.in[I_PREG] + layer * 1024, mod + b * 3072, mod + b * 3072 + 1024, H + (size_t)m * D); }
}
template <bool NEXT> __device__ __forceinline__ void p_residual(Frame& F, const float* xin, const float* y, float* xout, int layer) {
    const int gw = F.bid * 8 + F.wave, NGW = F.G * 8;
    const float* mod = (const float*)(F.ws + WS_MOD) + (size_t)layer * 4 * 3072;
    const float* modn = (const float*)(F.ws + WS_MOD) + (size_t)(layer + 1) * 4 * 3072;
    const float* pg = F.in[I_POSTG] + layer * 1024;
    bf16* H = (bf16*)(F.ws + WS_RA);
    for (int m = gw; m < M; m += NGW) { const int b = m >> 12;
        const GAS f32x4* yr = (const GAS f32x4*)(y + (size_t)m * D) + F.lane; const GAS f32x4* xr = (const GAS f32x4*)(xin + (size_t)m * D) + F.lane;
        f32x4 v[4], xv[4]; float s = 0.f;
#pragma unroll
        for (int j = 0; j < 4; ++j) { v[j] = yr[64 * j]; xv[j] = xr[64 * j]; s += (v[j].x * v[j].x + v[j].y * v[j].y) + (v[j].z * v[j].z + v[j].w * v[j].w); }
        const float r = rsqrtf(wave_sum(s) * (1.f / D) + EPS);
        GAS f32x4* orow = (GAS f32x4*)(xout + (size_t)m * D) + F.lane;
#pragma unroll
        for (int j = 0; j < 4; ++j) { const int c = 4 * F.lane + 256 * j;
            const f32x4 gg = *(const f32x4*)(pg + c), gt = *(const f32x4*)(mod + b * 3072 + 2048 + c);
            xv[j].x += gt.x * (v[j].x * r * gg.x); xv[j].y += gt.y * (v[j].y * r * gg.y); xv[j].z += gt.z * (v[j].z * r * gg.z); xv[j].w += gt.w * (v[j].w * r * gg.w);
            orow[64 * j] = xv[j]; }
        if (NEXT) modnorm_row(xv, F.lane, F.in[I_PREG] + (layer + 1) * 1024, modn + b * 3072, modn + b * 3072 + 1024, H + (size_t)m * D);
    }
}

__constant__ unsigned char T5B[3][132] = {
{0,1,2,3,4,5,6,7,8,9,10,11,12,13,14,15,16,16,16,16,16,16,17,17,17,17,17,17,17,17,18,18,18,18,18,18,18,18,18,18,19,19,19,19,19,19,19,19,19,19,19,19,19,19,20,20,20,20,20,20,20,20,20,20,20,20,20,20,20,20,20,20,20,21,21,21,21,21,21,21,21,21,21,21,21,21,21,21,21,21,21,21,21,21,21,21,21,21,21,22,22,22,22,22,22,22,22,22,22,22,22,22,22,22,22,22,22,22,22,22,22,22,22,22,22,22,22,22,22,0,0,0},
{0,4,8,12,16,16,17,17,18,18,19,19,19,19,20,20,20,20,20,21,21,21,21,21,21,22,22,22,22,22,22,22,22,22,23,23,23,23,23,23,23,23,23,23,23,23,24,24,24,24,24,24,24,24,24,24,24,24,24,24,24,24,25,25,25,25,25,25,25,25,25,25,25,25,25,25,25,25,25,25,25,25,25,26,26,26,26,26,26,26,26,26,26,26,26,26,26,26,26,26,26,26,26,26,26,26,26,26,26,26,26,26,26,27,27,27,27,27,27,27,27,27,27,27,27,27,27,27,27,0,0,0},
{0,16,18,19,20,21,21,22,22,23,23,23,24,24,24,24,25,25,25,25,25,26,26,26,26,26,26,26,26,27,27,27,27,27,27,27,27,27,27,28,28,28,28,28,28,28,28,28,28,28,28,28,29,29,29,29,29,29,29,29,29,29,29,29,29,29,29,29,29,29,30,30,30,30,30,30,30,30,30,30,30,30,30,30,30,30,30,30,30,30,30,30,30,30,30,31,31,31,31,31,31,31,31,31,31,31,31,31,31,31,31,31,31,31,31,31,31,31,31,31,31,31,31,31,31,31,31,31,31,0,0,0}};

constexpr int ATT_VB_OFF = 2048, ATT_VB_WAVE = 4608;
struct AttLd { bf16x8 kf[2][2]; v4u vv[4]; };
__device__ __forceinline__ void att_step_geom(int st, int P0r, int& ci, int& sh, int& q0, int& qs, int& kbase) {
    ci = st >= 18 ? 2 : (st >= 12 ? 1 : 0); const int kt = st - (ci == 0 ? 0 : (ci == 1 ? 12 : 18));
    sh = 2 * ci; q0 = P0r >> sh; qs = 16 >> sh; kbase = q0 - 128 + 32 * kt;
}
__device__ __forceinline__ void att_load(AttLd& L, const bf16* zb, int st, int P0r, int h, int lane) {
    int ci, sh, q0, qs, kbase; att_step_geom(st, P0r, ci, sh, q0, qs, kbase);
    const int res = P0r & ((1 << sh) - 1), jq = lane & 15, g = lane >> 4;
#pragma unroll
    for (int tt = 0; tt < 2; ++tt) { int kidx = kbase + 16 * tt + jq; kidx = kidx < 0 ? 0 : kidx; const int kpos = (kidx << sh) + res;
        const bf16* kp = zb + (size_t)kpos * 3072 + 512 + h * 64 + 8 * g;
        L.kf[tt][0] = *(const bf16x8*)kp; L.kf[tt][1] = *(const bf16x8*)(kp + 32); }
#pragma unroll
    for (int i = 0; i < 4; ++i) { int kidx = kbase + (lane >> 3) + 8 * i; kidx = kidx < 0 ? 0 : kidx; const int kpos = (kidx << sh) + res;
        L.vv[i] = *(const v4u*)(zb + (size_t)kpos * 3072 + 1024 + h * 64 + 8 * (lane & 7)); }
}
__device__ __forceinline__ void attn_task(Frame& F, int task) {
    const int b = task >> 7, h = (task >> 4) & 7, span = task & 15, lane = F.lane;
    LAS float* biasT = (LAS float*)(F.lds);
    LAS unsigned char* vbuf = F.lds + ATT_VB_OFF + F.wave * ATT_VB_WAVE;
    __syncthreads();
    for (int i = F.tid; i < 3 * 132; i += 512) { const int ci = i / 132, rel = i % 132; biasT[i] = F.in[I_RELB][T5B[ci][rel] * 8 + h] * LOG2E; }
    __syncthreads();
    const bf16* zb = (const bf16*)(F.ws + WS_RZ) + (size_t)b * SEQ * 3072;
    bf16* O = (bf16*)(F.ws + WS_RA) + (size_t)b * SEQ * 1024;
    const int jq = lane & 15, g = lane >> 4;
    for (int it = 0; it < 2; ++it) {
        const int P0r = span * 256 + F.wave + 8 * it;
        const int qpos = P0r + 16 * jq;
        bf16x8 qf[2];
        { const bf16* qp = zb + (size_t)qpos * 3072 + h * 64 + 8 * g; qf[0] = *(const bf16x8*)qp; qf[1] = *(const bf16x8*)(qp + 32); }
        float mrun = -1e30f, lrun = 0.f; f32x4 o[4];
#pragma unroll
        for (int hb = 0; hb < 4; ++hb) o[hb] = (f32x4){0.f, 0.f, 0.f, 0.f};
        AttLd cur, nxt; att_load(cur, zb, 0, P0r, h, lane);
        for (int st = 0; st < 23; ++st) {
            if (st + 1 < 23) att_load(nxt, zb, st + 1, P0r, h, lane);
            int ci, sh, q0, qs, kbase; att_step_geom(st, P0r, ci, sh, q0, qs, kbase);
            const int qidx = q0 + qs * jq;
            f32x4 s0 = (f32x4){0.f, 0.f, 0.f, 0.f}, s1 = s0;
            s0 = MFMA16(cur.kf[0][0], qf[0], s0); s0 = MFMA16(cur.kf[0][1], qf[1], s0);
            s1 = MFMA16(cur.kf[1][0], qf[0], s1); s1 = MFMA16(cur.kf[1][1], qf[1], s1);
            float sv[8]; float tm = -1e30f;
#pragma unroll
            for (int e = 0; e < 8; ++e) { const int tt = e >> 2, rr = e & 3; const int kidx = kbase + 16 * tt + 4 * g + rr, rel = qidx - kidx;
                const bool ok = (rel >= 0) && (rel <= 128) && (kidx >= 0); const int relc = rel < 0 ? 0 : (rel > 128 ? 128 : rel);
                const float sc = (tt ? s1[rr] : s0[rr]) * (0.125f * LOG2E) + biasT[ci * 132 + relc];
                sv[e] = ok ? sc : -1e30f; tm = fmaxf(tm, sv[e]); }
            tm = fmaxf(tm, __shfl_xor(tm, 16)); tm = fmaxf(tm, __shfl_xor(tm, 32));
            const float mnew = fmaxf(mrun, tm), alpha = exp2f(mrun - mnew); mrun = mnew;
            float ps = 0.f;
#pragma unroll
            for (int e = 0; e < 8; ++e) { sv[e] = exp2f(sv[e] - mnew); ps += sv[e]; }
            lrun = lrun * alpha + ps;
#pragma unroll
            for (int hb = 0; hb < 4; ++hb) o[hb] = o[hb] * alpha;
            v4u pw; pw.x = pk2(sv[0], sv[1]); pw.y = pk2(sv[2], sv[3]); pw.z = pk2(sv[4], sv[5]); pw.w = pk2(sv[6], sv[7]);
            const bf16x8 pf = __builtin_bit_cast(bf16x8, pw);
            asm volatile("" ::: "memory");
#pragma unroll
            for (int i = 0; i < 4; ++i) *(LAS v4u*)(vbuf + ((lane >> 3) + 8 * i) * 144 + (lane & 7) * 16) = cur.vv[i];
            asm volatile("" ::: "memory");
            const lds_cptr va = (lds_cptr)vbuf + (4 * g + (jq >> 2)) * 144 + 8 * (jq & 3);
#pragma unroll
            for (int hb = 0; hb < 4; ++hb) { const s16x4 lo4 = vtr(va + 32 * hb), hi4 = vtr(va + 32 * hb + 16 * 144);
                const bf16x8 vf = (bf16x8){lo4[0], lo4[1], lo4[2], lo4[3], hi4[0], hi4[1], hi4[2], hi4[3]};
                o[hb] = MFMA16(vf, pf, o[hb]); }
            asm volatile("" ::: "memory");
            cur = nxt;
        }
        float lt = lrun + __shfl_xor(lrun, 16); lt += __shfl_xor(lt, 32);
        const float inv = 1.0f / lt;
#pragma unroll
        for (int hb = 0; hb < 4; ++hb) { const int col = h * 64 + 16 * hb + 4 * g;
            const v2u gw = *(const v2u*)(zb + (size_t)qpos * 3072 + 2048 + col);
            const float g0 = bflo(gw.x), g1 = bfhi(gw.x), g2 = bflo(gw.y), g3 = bfhi(gw.y);
            v2u w; w.x = pk2(o[hb][0] * inv * siluf_(g0), o[hb][1] * inv * siluf_(g1)); w.y = pk2(o[hb][2] * inv * siluf_(g2), o[hb][3] * inv * siluf_(g3));
            *(v2u*)(O + (size_t)qpos * 1024 + col) = w; }
    }
}

__device__ __forceinline__ void s5_pass1(Frame& F, int task) {
    const int g = task >> 4, ct = task & 15, n = F.lane & 15, gq = F.lane >> 4;
    const int cgi = ct * 16 + n, b = cgi >> 6, c = cgi & 63;
    const bf16* Et = (const bf16*)(F.ws + WS_ET) + (size_t)g * 128 * 1024 + (size_t)n * 1024 + 8 * gq;
    const bf16* ub = (const bf16*)(F.ws + WS_RZ) + (size_t)(b * SEQ + c * 64) * 3072 + 1536 + g * 16 + 8 * (gq & 1);
    f32x4 acc[8];
#pragma unroll
    for (int st = 0; st < 8; ++st) acc[st] = (f32x4){0.f, 0.f, 0.f, 0.f};
    for (int s = 0; s < 32; ++s) { const int tok = 2 * s + (gq >> 1);
        const bf16x8 bfr = *(const bf16x8*)(ub + (size_t)tok * 3072);
#pragma unroll
        for (int st = 0; st < 8; ++st) { const bf16x8 afr = *(const bf16x8*)(Et + (size_t)st * 16 * 1024 + 32 * s); acc[st] = MFMA16(afr, bfr, acc[st]); } }
    float* SC = (float*)(F.ws + WS_SC) + (size_t)((b * 32 + g) * 64 + c) * 128 + 4 * gq;
#pragma unroll
    for (int st = 0; st < 8; ++st) *(f32x4*)(SC + 16 * st) = acc[st];
}
__device__ __forceinline__ void s5_carry(Frame& F) {
    const int idx = F.bid * 512 + F.tid; if (idx >= NB * 32 * 64) return;
    const int b = idx >> 11, g = (idx >> 6) & 31, p = idx & 63;
    const float* lam = (const float*)(F.ws + WS_LAM); const float lr = lam[(g * 64 + p) * 2], li = lam[(g * 64 + p) * 2 + 1];
    const float* sc = (const float*)(F.ws + WS_SC) + (size_t)((b * 32 + g) * 64) * 128 + p;
    float* xs = (float*)(F.ws + WS_XS) + (size_t)((b * 32 + g) * 64) * 128 + p;
    float xr = 0.f, xi = 0.f;
#pragma unroll 8
    for (int c = 0; c < 64; ++c) { xs[c * 128] = xr; xs[c * 128 + 64] = xi; const float sr = sc[c * 128], si = sc[c * 128 + 64];
        const float nr = lr * xr - li * xi + sr, ni = lr * xi + li * xr + si; xr = nr; xi = ni; }
}
__device__ __forceinline__ void s5_pass2(Frame& F, int task) {
    const int g = task >> 6, ct = (task >> 2) & 15, q = task & 3, n = F.lane & 15, gq = F.lane >> 4;
    const int cgi = ct * 16 + n, b = cgi >> 6, c = cgi & 63;
    const bf16* Kt = (const bf16*)(F.ws + WS_KT) + (size_t)g * 64 * 256 + n * 16 + 8 * (gq & 1);
    const bf16* Ft = (const bf16*)(F.ws + WS_FT) + (size_t)g * 1024 * 128 + (size_t)n * 128 + 8 * gq;
    const float* XS = (const float*)(F.ws + WS_XS) + (size_t)((b * 32 + g) * 64 + c) * 128 + 8 * gq;
    const bf16* zrow = (const bf16*)(F.ws + WS_RZ) + (size_t)(b * SEQ + c * 64) * 3072 + 1536 + g * 16;
    f32x4 acc[16];
#pragma unroll
    for (int ii = 0; ii < 16; ++ii) acc[ii] = (f32x4){0.f, 0.f, 0.f, 0.f};
    for (int sp = 0; sp < 4; ++sp) { const f32x4 x0 = *(const f32x4*)(XS + 32 * sp), x1 = *(const f32x4*)(XS + 32 * sp + 4);
        v4u xw; xw.x = pk2(x0.x, x0.y); xw.y = pk2(x0.z, x0.w); xw.z = pk2(x1.x, x1.y); xw.w = pk2(x1.z, x1.w); const bf16x8 xf = __builtin_bit_cast(bf16x8, xw);
#pragma unroll
        for (int ii = 0; ii < 16; ++ii) { const int i = q + 4 * ii; const bf16x8 afr = *(const bf16x8*)(Ft + (size_t)i * 16 * 128 + 32 * sp); acc[ii] = MFMA16(afr, xf, acc[ii]); } }
    for (int s = 0; s < 32; ++s) { const int tok = 2 * s + (gq >> 1);
        const bf16x8 bfr = *(const bf16x8*)(zrow + (size_t)tok * 3072 + 8 * (gq & 1));
#pragma unroll
        for (int ii = 0; ii < 16; ++ii) { const int i = q + 4 * ii;
            if ((i >> 1) >= s) { const int tau = i - tok; const bf16x8 ld = *(const bf16x8*)(Kt + (size_t)(tau < 0 ? 0 : tau) * 256);
                const bf16x8 afr = tau < 0 ? (bf16x8){0, 0, 0, 0, 0, 0, 0, 0} : ld; acc[ii] = MFMA16(afr, bfr, acc[ii]); } } }
    const f32x4 dsk = *(const f32x4*)(F.in[I_S5D] + g * 16 + 4 * gq);
    bf16* YB = (bf16*)(F.ws + WS_YB) + (size_t)(b * SEQ + c * 64) * 512 + g * 16 + 4 * gq;
#pragma unroll
    for (int ii = 0; ii < 16; ++ii) { const int i = q + 4 * ii; const v2u uw = *(const v2u*)(zrow + (size_t)i * 3072 + 4 * gq);
        const float y0 = gelu_tanh(acc[ii][0] + dsk.x * bflo(uw.x)), y1 = gelu_tanh(acc[ii][1] + dsk.y * bfhi(uw.x));
        const float y2 = gelu_tanh(acc[ii][2] + dsk.z * bflo(uw.y)), y3 = gelu_tanh(acc[ii][3] + dsk.w * bfhi(uw.y));
        v2u w; w.x = pk2(y0, y1); w.y = pk2(y2, y3); *(v2u*)(YB + (size_t)i * 512) = w; }
}

__device__ __forceinline__ int perm_pos(int o) { return (o & ~31) | (((o >> 2) & 3) << 3) | (((o >> 4) & 1) << 2) | (o & 3); }

__device__ __forceinline__ void gdn_extras_item(Frame& F, int item) {
    if (F.wave >= 4) return;
    const int n = F.lane & 15, g = F.lane >> 4, row0 = item * 64 + F.wave * 16;
    const bf16* A = (const bf16*)(F.ws + WS_RA) + (size_t)(row0 + n) * 1024 + 8 * g;
    const bf16* B = (const bf16*)(F.ws + WS_WEXT) + (size_t)n * 1024 + 8 * g;
    f32x4 acc0 = (f32x4){0.f, 0.f, 0.f, 0.f}, acc1 = acc0;
#pragma unroll 4
    for (int s = 0; s < 32; s += 2) { acc0 = MFMA16(*(const bf16x8*)(A + 32 * s), *(const bf16x8*)(B + 32 * s), acc0); acc1 = MFMA16(*(const bf16x8*)(A + 32 * s + 32), *(const bf16x8*)(B + 32 * s + 32), acc1); }
    float* ex = (float*)(F.ws + WS_EXTRA);
#pragma unroll
    for (int e = 0; e < 4; ++e) ex[(size_t)(row0 + 4 * g + e) * 16 + n] = acc0[e] + acc1[e];
}

constexpr int GP_QS = 0, GP_KS = 17408, GP_VS = 34816, GP_LS = 52224, GP_TB = 69632, GP_TW = 78848, GP_SM = 88064;
__device__ __forceinline__ void gdn_prep_task(Frame& F, int task) {
    const int b = task >> 9, h = (task >> 6) & 7, c = task & 63, tid = F.tid, lane = F.lane, wave = F.wave;
    LAS unsigned char* L = F.lds;
    LAS float* bet = (LAS float*)(L + GP_SM); LAS float* gg = bet + 64; LAS float* gcs = bet + 128;
    bf16* z1 = (bf16*)(F.ws + WS_RZ);
    const size_t row0 = (size_t)b * SEQ + c * 64;
    __syncthreads();
    { const int t = tid >> 3, seg = tid & 7;
      const bf16* halo = (const bf16*)(F.ws + WS_HALO) + (size_t)(b * 64 + c - 1) * 3 * 3072;
#pragma unroll 1
      for (int w3 = 0; w3 < 3; ++w3) { const int ch = w3 * 1024 + h * 128 + seg * 16;
          float a[16];
#pragma unroll
          for (int e = 0; e < 16; ++e) a[e] = 0.f;
#pragma unroll
          for (int j = 0; j < 4; ++j) { const int tl = t - 3 + j;
              v4u r0 = (v4u){0u, 0u, 0u, 0u}, r1 = r0;
              if (tl >= 0) { const bf16* p = z1 + (row0 + tl) * 4096 + ch; r0 = *(const v4u*)p; r1 = *(const v4u*)(p + 8); }
              else if (c > 0) { const bf16* p = halo + (size_t)(tl + 3) * 3072 + ch; r0 = *(const v4u*)p; r1 = *(const v4u*)(p + 8); }
              const float* cw = F.in[I_GDNCONV] + j * 3072 + ch;
              const f32x4 w0 = *(const f32x4*)cw, w1 = *(const f32x4*)(cw + 4), w2 = *(const f32x4*)(cw + 8), w3v = *(const f32x4*)(cw + 12);
              a[0] += w0.x * bflo(r0.x); a[1] += w0.y * bfhi(r0.x); a[2] += w0.z * bflo(r0.y); a[3] += w0.w * bfhi(r0.y);
              a[4] += w1.x * bflo(r0.z); a[5] += w1.y * bfhi(r0.z); a[6] += w1.z * bflo(r0.w); a[7] += w1.w * bfhi(r0.w);
              a[8] += w2.x * bflo(r1.x); a[9] += w2.y * bfhi(r1.x); a[10] += w2.z * bflo(r1.y); a[11] += w2.w * bfhi(r1.y);
              a[12] += w3v.x * bflo(r1.z); a[13] += w3v.y * bfhi(r1.z); a[14] += w3v.z * bflo(r1.w); a[15] += w3v.w * bfhi(r1.w); }
          float s = 0.f;
#pragma unroll
          for (int e = 0; e < 16; ++e) { a[e] = siluf_(a[e]); s += a[e] * a[e]; }
          s += __shfl_xor(s, 1); s += __shfl_xor(s, 2); s += __shfl_xor(s, 4);
          const float r = (w3 == 2) ? 1.0f : rsqrtf(s + EPS) * (w3 == 0 ? 0.08838834764831845f : 1.0f);
#pragma unroll
          for (int e = 0; e < 16; ++e) a[e] *= r;
          LAS unsigned char* dst = L + w3 * 17408 + t * 272 + seg * 32;
          v4u o0, o1; o0.x = pk2(a[0], a[1]); o0.y = pk2(a[2], a[3]); o0.z = pk2(a[4], a[5]); o0.w = pk2(a[6], a[7]);
          o1.x = pk2(a[8], a[9]); o1.y = pk2(a[10], a[11]); o1.z = pk2(a[12], a[13]); o1.w = pk2(a[14], a[15]);
          *(LAS v4u*)dst = o0; *(LAS v4u*)(dst + 16) = o1; }
      if (seg == 0) { const float* ex = (const float*)(F.ws + WS_EXTRA) + (row0 + t) * 16;
          const float braw = ex[h], araw = ex[8 + h] + F.in[I_GDNDTB][h];
          const float sp = araw > 20.f ? araw : log1pf(expf(araw));
          bet[t] = 1.0f / (1.0f + expf(-braw)); gg[t] = -expf(F.in[I_GDNALOG][h]) * sp; } }
    __syncthreads();
    if (wave == 0) { float v = gg[lane];
#pragma unroll
        for (int o = 1; o < 64; o <<= 1) { const float u = __shfl_up(v, o); if (lane >= o) v += u; }
        const float glast = __shfl(v, 63);
        gcs[lane] = v;
        float* egc = (float*)(F.ws + WS_EGC); egc[(row0 + lane) * 8 + h] = expf(v); egc[(size_t)M * 8 + (row0 + lane) * 8 + h] = expf(glast - v);
        if (lane == 0) ((float*)(F.ws + WS_DEC))[(b * 8 + h) * 64 + c] = expf(glast); }
    __syncthreads();
    { const int n = lane & 15, g = lane >> 4;
#pragma unroll
      for (int x = 0; x < 2; ++x) { const int tl = wave + 8 * x, it = tl >> 2, jt = tl & 3;
          const int i = 16 * it + n, j0 = 16 * jt + 4 * g;
          bf16* aq = z1 + (row0 + i) * 4096 + 1024 + h * 128 + ((jt >> 1) * 32 + 8 * g + 4 * (jt & 1));
          if (jt > it) { *(v2u*)aq = (v2u){0u, 0u}; *(LAS f32x4*)(L + GP_LS + i * 272 + j0 * 4) = (f32x4){0.f, 0.f, 0.f, 0.f}; continue; }
          f32x4 kk = (f32x4){0.f, 0.f, 0.f, 0.f}, qk = kk;
#pragma unroll
          for (int s = 0; s < 4; ++s) { const bf16x8 af = *(const LAS bf16x8*)(L + GP_KS + (16 * jt + n) * 272 + 64 * s + 16 * g);
              const bf16x8 bk = *(const LAS bf16x8*)(L + GP_KS + (16 * it + n) * 272 + 64 * s + 16 * g);
              const bf16x8 bq = *(const LAS bf16x8*)(L + GP_QS + (16 * it + n) * 272 + 64 * s + 16 * g);
              kk = MFMA16(af, bk, kk); qk = MFMA16(af, bq, qk); }
          const float gi = gcs[i], bi = bet[i]; f32x4 lv; float av[4];
#pragma unroll
          for (int e = 0; e < 4; ++e) { const int j = j0 + e; const float dcy = expf(gi - gcs[j]);
              lv[e] = (j < i) ? bi * kk[e] * dcy : 0.f; av[e] = (j <= i) ? qk[e] * dcy : 0.f; }
          *(LAS f32x4*)(L + GP_LS + i * 272 + j0 * 4) = lv;
          v2u w; w.x = pk2(av[0], av[1]); w.y = pk2(av[2], av[3]); *(v2u*)aq = w; } }
    __syncthreads();
    if (wave == 0) {
        float t[64];
#pragma unroll
        for (int i = 0; i < 64; ++i) { float a0 = (i == lane) ? 1.f : 0.f, a1 = 0.f;
#pragma unroll
            for (int j4 = 0; j4 < (i + 3) / 4; ++j4) { const f32x4 lr = *(const LAS f32x4*)(L + GP_LS + i * 272 + j4 * 16);
                if (4 * j4 + 0 < i) a0 -= lr.x * t[4 * j4 + 0];
                if (4 * j4 + 1 < i) a1 -= lr.y * t[4 * j4 + 1];
                if (4 * j4 + 2 < i) a0 -= lr.z * t[4 * j4 + 2];
                if (4 * j4 + 3 < i) a1 -= lr.w * t[4 * j4 + 3]; }
            t[i] = a0 + a1; asm volatile("" ::: "memory"); }
        const float bc = bet[lane], bw = bc * expf(gcs[lane]);
#pragma unroll
        for (int i = 0; i < 64; ++i) { *(LAS bf16*)(L + GP_TB + i * 144 + lane * 2) = (bf16)f2bf(t[i] * bc); *(LAS bf16*)(L + GP_TW + i * 144 + lane * 2) = (bf16)f2bf(t[i] * bw); }
    } else {
        const int lt = tid - 64;
        for (int q = lt; q < 1024; q += 448) { const int t = q >> 4, ck = q & 15, J = ck >> 2, g = ck & 3;
            const v2u lo = *(const LAS v2u*)(L + GP_QS + t * 272 + (32 * J + 4 * g) * 2), hi = *(const LAS v2u*)(L + GP_QS + t * 272 + (32 * J + 16 + 4 * g) * 2);
            *(v4u*)(z1 + (row0 + t) * 4096 + h * 128 + 32 * J + 8 * g) = (v4u){lo.x, lo.y, hi.x, hi.y}; }
        bf16* kT = (bf16*)(F.ws + WS_KTP) + (size_t)((b * 8 + h) * 64 + c) * 8192;
        const int n = lane & 15, g = lane >> 4;
        for (int op = wave - 1; op < 16; op += 7) { const int db = op >> 1, J = op & 1;
            const lds_cptr a = (lds_cptr)(L + GP_KS) + (32 * J + 4 * g + (n >> 2)) * 272 + (16 * db + 4 * (n & 3)) * 2;
            const s16x4 lo4 = vtr(a), hi4 = vtr(a + 16 * 272);
            *(v4u*)(kT + (size_t)(16 * db + n) * 64 + 32 * J + 8 * g) = __builtin_bit_cast(v4u, (bf16x8){lo4[0], lo4[1], lo4[2], lo4[3], hi4[0], hi4[1], hi4[2], hi4[3]}); }
    }
    __syncthreads();
    { const int n = lane & 15, g = lane >> 4;
      bf16x8 vfr[2], kfr[2];
#pragma unroll
      for (int s = 0; s < 2; ++s) { const int roff = (32 * s + 8 * g + (n >> 2)) * 272 + (16 * wave + 4 * (n & 3)) * 2;
          const s16x4 v0 = vtr((lds_cptr)(L + GP_VS) + roff), v1 = vtr((lds_cptr)(L + GP_VS) + roff + 4 * 272);
          const s16x4 k0 = vtr((lds_cptr)(L + GP_KS) + roff), k1 = vtr((lds_cptr)(L + GP_KS) + roff + 4 * 272);
          vfr[s] = (bf16x8){v0[0], v0[1], v0[2], v0[3], v1[0], v1[1], v1[2], v1[3]}; kfr[s] = (bf16x8){k0[0], k0[1], k0[2], k0[3], k1[0], k1[1], k1[2], k1[3]}; }
      bf16* uT = (bf16*)(F.ws + WS_RA) + (size_t)((b * 8 + h) * 64 + c) * 8192 + (size_t)(16 * wave + n) * 64;
      bf16* wn = (bf16*)(F.ws + WS_WNEG) + h * 128 + ((wave >> 1) * 32 + 8 * g + 4 * (wave & 1));
#pragma unroll
      for (int it = 0; it < 4; ++it) { f32x4 ua = (f32x4){0.f, 0.f, 0.f, 0.f}, wa = ua;
#pragma unroll
          for (int s = 0; s < 2; ++s) { if (s == 1 && it < 2) continue;
              const bf16x8 tb = *(const LAS bf16x8*)(L + GP_TB + (16 * it + n) * 144 + 64 * s + 16 * g), tw = *(const LAS bf16x8*)(L + GP_TW + (16 * it + n) * 144 + 64 * s + 16 * g);
              ua = MFMA16(tb, vfr[s], ua);
              wa = MFMA16(kfr[s], tw, wa); }
          v2u uw; uw.x = pk2(ua[0], ua[1]); uw.y = pk2(ua[2], ua[3]); *(v2u*)(uT + 16 * it + 4 * g) = uw;
          v2u ww; ww.x = pk2(-wa[0], -wa[1]); ww.y = pk2(-wa[2], -wa[3]); *(v2u*)(wn + (row0 + 16 * it + n) * 1024) = ww; } }
}

constexpr int GS_W = 0, GS_Q = 17408, GS_K = 34816, GS_A = 53248, GS_U = 62464, GS_E = 64768, GS_BUF = 65536;
__device__ __forceinline__ void gdn_scan_stage(Frame& F, LAS unsigned char* buf, int b, int h, int c, int dv0, int lt) {
    const size_t row0 = (size_t)b * SEQ + c * 64;
    const bf16* z1 = (const bf16*)(F.ws + WS_RZ); const bf16* wn = (const bf16*)(F.ws + WS_WNEG);
    const bf16* kT = (const bf16*)(F.ws + WS_KTP) + (size_t)((b * 8 + h) * 64 + c) * 8192;
    const bf16* uT = (const bf16*)(F.ws + WS_RA) + (size_t)((b * 8 + h) * 64 + c) * 8192 + (size_t)dv0 * 64;
    for (int q = lt; q < 3712; q += 448) {
        v4u v; LAS unsigned char* dst;
        if (q < 1024) { const int r = q >> 4, ck = q & 15; v = *(const v4u*)(wn + (row0 + r) * 1024 + h * 128 + ck * 8); dst = buf + GS_W + r * 272 + ck * 16; }
        else if (q < 2048) { const int r = (q - 1024) >> 4, ck = q & 15; v = *(const v4u*)(z1 + (row0 + r) * 4096 + h * 128 + ck * 8); dst = buf + GS_Q + r * 272 + ck * 16; }
        else if (q < 3072) { const int r = (q - 2048) >> 3, ck = q & 7; v = *(const v4u*)(kT + r * 64 + ck * 8); dst = buf + GS_K + r * 144 + ck * 16; }
        else if (q < 3584) { const int r = (q - 3072) >> 3, ck = q & 7; v = *(const v4u*)(z1 + (row0 + r) * 4096 + 1024 + h * 128 + ck * 8); dst = buf + GS_A + r * 144 + ck * 16; }
        else { const int r = (q - 3584) >> 3, ck = q & 7; v = *(const v4u*)(uT + r * 64 + ck * 8); dst = buf + GS_U + r * 144 + ck * 16; }
        *(LAS v4u*)dst = v; }
    if (lt < 128) { const float* egc = (const float*)(F.ws + WS_EGC) + (size_t)(lt >> 6) * M * 8; ((LAS float*)(buf + GS_E))[lt] = egc[(row0 + (lt & 63)) * 8 + h]; }
}
__device__ __forceinline__ void gdn_scan_task(Frame& F, int task) {
    const int b = task >> 6, h = (task >> 3) & 7, dv0 = (task & 7) * 16, lane = F.lane, n = lane & 15, g = lane >> 4;
    __syncthreads();
    if (F.wave != 0) gdn_scan_stage(F, F.lds, b, h, 0, dv0, F.tid - 64);
    __syncthreads();
    f32x4 S[8];
#pragma unroll
    for (int d = 0; d < 8; ++d) S[d] = (f32x4){0.f, 0.f, 0.f, 0.f};
    bf16* z1 = (bf16*)(F.ws + WS_RZ);
    const float* decp = (const float*)(F.ws + WS_DEC) + (b * 8 + h) * 64;
    for (int c = 0; c < 64; ++c) {
        LAS unsigned char* buf = F.lds + (c & 1) * GS_BUF;
        if (F.wave != 0) { if (c + 1 < 64) gdn_scan_stage(F, F.lds + ((c + 1) & 1) * GS_BUF, b, h, c + 1, dv0, F.tid - 64); }
        else {
            const float dec = decp[c];
            bf16x8 Sb[4];
#pragma unroll
            for (int kq = 0; kq < 4; ++kq) { v4u w; w.x = pk2(S[2 * kq][0], S[2 * kq][1]); w.y = pk2(S[2 * kq][2], S[2 * kq][3]); w.z = pk2(S[2 * kq + 1][0], S[2 * kq + 1][1]); w.w = pk2(S[2 * kq + 1][2], S[2 * kq + 1][3]); Sb[kq] = __builtin_bit_cast(bf16x8, w); }
            f32x4 vn[4];
#pragma unroll
            for (int it = 0; it < 4; ++it) { const v2u uw = *(const LAS v2u*)(buf + GS_U + n * 144 + (16 * it + 4 * g) * 2);
                f32x4 a = (f32x4){bflo(uw.x), bfhi(uw.x), bflo(uw.y), bfhi(uw.y)};
#pragma unroll
                for (int kq = 0; kq < 4; ++kq) a = MFMA16(*(const LAS bf16x8*)(buf + GS_W + (16 * it + n) * 272 + 64 * kq + 16 * g), Sb[kq], a);
                vn[it] = a; }
            bf16x8 Vb[2], Vs[2];
            const LAS float* eg = (const LAS float*)(buf + GS_E);
#pragma unroll
            for (int J = 0; J < 2; ++J) { const f32x4 a = vn[2 * J], c2 = vn[2 * J + 1];
                v4u w; w.x = pk2(a[0], a[1]); w.y = pk2(a[2], a[3]); w.z = pk2(c2[0], c2[1]); w.w = pk2(c2[2], c2[3]); Vb[J] = __builtin_bit_cast(bf16x8, w);
                const f32x4 e0 = *(const LAS f32x4*)(eg + 64 + 32 * J + 4 * g), e1 = *(const LAS f32x4*)(eg + 64 + 32 * J + 16 + 4 * g);
                v4u s; s.x = pk2(a[0] * e0.x, a[1] * e0.y); s.y = pk2(a[2] * e0.z, a[3] * e0.w); s.z = pk2(c2[0] * e1.x, c2[1] * e1.y); s.w = pk2(c2[2] * e1.z, c2[3] * e1.w); Vs[J] = __builtin_bit_cast(bf16x8, s); }
#pragma unroll
            for (int it = 0; it < 4; ++it) { f32x4 qo = (f32x4){0.f, 0.f, 0.f, 0.f};
#pragma unroll
                for (int kq = 0; kq < 4; ++kq) qo = MFMA16(Sb[kq], *(const LAS bf16x8*)(buf + GS_Q + (16 * it + n) * 272 + 64 * kq + 16 * g), qo);
                qo = qo * eg[16 * it + n];
#pragma unroll
                for (int J = 0; J < 2; ++J) { if (J == 1 && it < 2) continue; qo = MFMA16(Vb[J], *(const LAS bf16x8*)(buf + GS_A + (16 * it + n) * 144 + 64 * J + 16 * g), qo); }
                v2u w; w.x = pk2(qo[0], qo[1]); w.y = pk2(qo[2], qo[3]);
                *(v2u*)(z1 + ((size_t)b * SEQ + c * 64 + 16 * it + n) * 4096 + 2048 + h * 128 + dv0 + 4 * g) = w; }
#pragma unroll
            for (int d = 0; d < 8; ++d) { f32x4 a = S[d] * dec;
#pragma unroll
                for (int J = 0; J < 2; ++J) a = MFMA16(*(const LAS bf16x8*)(buf + GS_K + (16 * d + n) * 144 + 64 * J + 16 * g), Vs[J], a);
                S[d] = a; }
        }
        __syncthreads();
    }
}

__device__ __forceinline__ void gdn_outnorm(Frame& F) {
    const int gw = F.bid * 8 + F.wave, NGW = F.G * 8, lane = F.lane;
    const bf16* z1 = (const bf16*)(F.ws + WS_RZ); bf16* og = (bf16*)(F.ws + WS_RA);
    const float* ng = F.in[I_GDNNORMG] + (lane & 7) * 16;
    for (int m = gw; m < M; m += NGW) {
        const v4u o0 = *(const v4u*)(z1 + (size_t)m * 4096 + 2048 + lane * 16), o1 = *(const v4u*)(z1 + (size_t)m * 4096 + 2048 + lane * 16 + 8);
        const v4u g0 = *(const v4u*)(z1 + (size_t)m * 4096 + 3072 + lane * 16), g1 = *(const v4u*)(z1 + (size_t)m * 4096 + 3072 + lane * 16 + 8);
        float ov[16], gv[16];
#pragma unroll
        for (int e = 0; e < 4; ++e) { ov[2 * e] = bflo(o0[e]); ov[2 * e + 1] = bfhi(o0[e]); ov[8 + 2 * e] = bflo(o1[e]); ov[8 + 2 * e + 1] = bfhi(o1[e]);
            gv[2 * e] = bflo(g0[e]); gv[2 * e + 1] = bfhi(g0[e]); gv[8 + 2 * e] = bflo(g1[e]); gv[8 + 2 * e + 1] = bfhi(g1[e]); }
        float s = 0.f;
#pragma unroll
        for (int e = 0; e < 16; ++e) s += ov[e] * ov[e];
        s += __shfl_xor(s, 1); s += __shfl_xor(s, 2); s += __shfl_xor(s, 4);
        const float r = rsqrtf(s * (1.f / 128.f) + EPS);
        float rv[16];
#pragma unroll
        for (int e = 0; e < 16; ++e) rv[e] = ov[e] * r * ng[e] * siluf_(gv[e]);
        v4u w0, w1; w0.x = pk2(rv[0], rv[1]); w0.y = pk2(rv[2], rv[3]); w0.z = pk2(rv[4], rv[5]); w0.w = pk2(rv[6], rv[7]);
        w1.x = pk2(rv[8], rv[9]); w1.y = pk2(rv[10], rv[11]); w1.z = pk2(rv[12], rv[13]); w1.w = pk2(rv[14], rv[15]);
        *(v4u*)(og + (size_t)m * 1024 + lane * 16) = w0; *(v4u*)(og + (size_t)m * 1024 + lane * 16 + 8) = w1; }
}

struct Args { const float* in[N_IN]; float* out; unsigned char* ws; int ph_lo, ph_hi; };
constexpr int NPH = 16;

__global__ void __launch_bounds__(512, 2) mega(Args args) {
    extern __shared__ __attribute__((aligned(16))) unsigned char lds[];
    cg::grid_group grid = cg::this_grid();
    Frame F;
    F.lds = (LAS unsigned char*)lds;
    F.tid = threadIdx.x; F.lane = F.tid & 63; F.wave = __builtin_amdgcn_readfirstlane(F.tid >> 6);
    F.G = gridDim.x; F.bid = blockIdx.x;
#pragma unroll
    for (int i = 0; i < N_IN; ++i) F.in[i] = args.in[i];
    F.out = args.out; F.ws = args.ws;
    const int lo = args.ph_lo, hi = args.ph_hi;
#ifdef PH_ONLY
#define IN(k) ((k) == PH_ONLY && lo <= (k) && (k) < hi)
#else
#define IN(k) (lo <= (k) && (k) < hi)
#endif
#define SEAM(k) do { if (IN(k) && IN((k) + 1)) xcd_barrier(bar); } while (0)
    volatile LAS unsigned* MISC = (volatile LAS unsigned*)(F.lds + LDS_BYTES - 256);
    if (F.tid < 64) MISC[F.tid] = 0u;
    __syncthreads();
    XcdBarrier bar = xcd_barrier_post((unsigned*)(F.ws + WS_CTL) + 4096, MISC + 8);
    if (lo < 0) grid.sync();
    const int gw = F.bid * 8 + F.wave, NGW = F.G * 8;

    if (IN(0)) { p0_prologue(F); } SEAM(0);
    if (IN(1)) { p1_modnorm(F, F.in[I_X], 0); } SEAM(1);
    if (IN(2)) { pg8::Gemm g{(const bf16*)(F.ws + WS_RA), (const bf16*)(F.ws + WS_WIN0), M, AB_IN, D}; pg8::StaticOrder S; S.init(M, AB_IN, F.G, F.bid);
        pg8::EpiBf16<false> E{(bf16*)(F.ws + WS_RZ), AB_IN, nullptr, 0};
        pg8::gemm_phase<pg8::EpiBf16<false>, pg8::StaticOrder, true, true>(F.lds, g, S, E); } SEAM(2);
    if (IN(3)) { if (F.wave < 2) { for (int t = F.bid * 2 + F.wave; t < 512; t += F.G * 2) s5_pass1(F, t); }
        for (int t = F.bid; t < 512; t += F.G) attn_task(F, t); } SEAM(3);
    if (IN(4)) { s5_carry(F); } SEAM(4);
    if (IN(5)) { for (int t = gw; t < 2048; t += NGW) s5_pass2(F, t); } SEAM(5);
    if (IN(6)) { pg8::Gemm g{(const bf16*)(F.ws + WS_YB), (const bf16*)(F.ws + WS_WGLU), M, 512, 512}; pg8::StaticOrder S; S.init(M, 512, F.G, F.bid);
        pg8::EpiGlu E{(const bf16*)(F.ws + WS_YB), (const bf16*)(F.ws + WS_RZ), F.in[I_S5GLUB], (bf16*)(F.ws + WS_RA)};
        pg8::gemm_phase<pg8::EpiGlu, pg8::StaticOrder, true, true>(F.lds, g, S, E); } SEAM(6);
    if (IN(7)) { pg8::Gemm g{(const bf16*)(F.ws + WS_RA), (const bf16*)(F.ws + WS_WOUT0), M, D, D}; pg8::StaticOrder S; S.init(M, D, F.G, F.bid);
        pg8::EpiF32 E{(float*)(F.ws + WS_RZ), D};
        pg8::gemm_phase<pg8::EpiF32, pg8::StaticOrder, true, true>(F.lds, g, S, E); } SEAM(7);
    if (IN(8)) { p_residual<true>(F, F.in[I_X], (const float*)(F.ws + WS_RZ), F.out, 0); } SEAM(8);
    if (IN(9)) { for (int t = F.bid; t < 256; t += F.G) gdn_extras_item(F, t);
        pg8::Gemm g{(const bf16*)(F.ws + WS_RA), (const bf16*)(F.ws + WS_WIN1), M, 4096, D}; pg8::StaticOrder S; S.init(M, 4096, F.G, F.bid);
        pg8::EpiBf16<true> E{(bf16*)(F.ws + WS_RZ), 4096, (bf16*)(F.ws + WS_HALO), 3072};
        pg8::gemm_phase<pg8::EpiBf16<true>, pg8::StaticOrder, true, true>(F.lds, g, S, E); } SEAM(9);
    if (IN(10)) { for (int t = F.bid; t < 2048; t += F.G) gdn_prep_task(F, t); } SEAM(10);
    if (IN(11)) { for (int t = F.bid; t < 256; t += F.G) gdn_scan_task(F, t); } SEAM(11);
    if (IN(12)) { gdn_outnorm(F); } SEAM(12);
    if (IN(13)) { pg8::Gemm g{(const bf16*)(F.ws + WS_RA), (const bf16*)(F.ws + WS_WOUT1), M, D, D}; pg8::StaticOrder S; S.init(M, D, F.G, F.bid);
        pg8::EpiF32 E{(float*)(F.ws + WS_RZ), D};
        pg8::gemm_phase<pg8::EpiF32, pg8::StaticOrder, true, true>(F.lds, g, S, E); } SEAM(13);
    if (IN(14)) { p_residual<false>(F, F.out, (const float*)(F.ws + WS_RZ), F.out, 1); }
#undef IN
#undef SEAM
}

extern "C" void kernel_launch(void* const* d_in, const int* in_sizes, int n_in, void* d_out, int out_size, void* d_ws, size_t ws_size, hipStream_t stream) {
    static int grid = 0;
    if (grid == 0) {
        if (n_in != N_IN || out_size != M * D || ws_size < WS_END) { fprintf(stderr, "kernel_launch: unexpected shapes n_in %d out %d ws %zu\n", n_in, out_size, ws_size); grid = -1; return; }
        int dev = 0, cus = 0, per_cu = 0;
        if (hipGetDevice(&dev) != hipSuccess || hipDeviceGetAttribute(&cus, hipDeviceAttributeMultiprocessorCount, dev) != hipSuccess) { grid = -1; return; }
        if (hipFuncSetAttribute((const void*)mega, hipFuncAttributeMaxDynamicSharedMemorySize, LDS_BYTES) != hipSuccess) { fprintf(stderr, "hipFuncSetAttribute failed\n"); grid = -1; return; }
        if (hipOccupancyMaxActiveBlocksPerMultiprocessor(&per_cu, (const void*)mega, 512, LDS_BYTES) != hipSuccess || per_cu < 1) { fprintf(stderr, "occupancy query: %d\n", per_cu); per_cu = 1; }
        (void)hipGetLastError();
        grid = cus;
        fprintf(stderr, "kernel_launch: grid %d (per_cu %d)\n", grid, per_cu);
    }
    if (grid < 0) return;
    if (hipMemsetAsync((char*)d_ws + WS_CTL, 0, 65536, stream) != hipSuccess) { fprintf(stderr, "memset failed\n"); return; }
    Args a{};
    for (int i = 0; i < N_IN; ++i) a.in[i] = (const float*)d_in[i];
    a.out = (float*)d_out; a.ws = (unsigned char*)d_ws;
#ifdef MULTI_LAUNCH
    for (int p = 0; p < NPH; ++p) { a.ph_lo = p; a.ph_hi = p + 1; void* kargs[] = {&a};
        hipError_t e = hipLaunchCooperativeKernel((const void*)mega, dim3(grid), dim3(512), kargs, LDS_BYTES, stream);
        if (e != hipSuccess) { fprintf(stderr, "launch %d failed: %s\n", p, hipGetErrorString(e)); break; } }
#else
    a.ph_lo = 0; a.ph_hi = NPH; void* kargs[] = {&a};
    hipError_t e = hipLaunchCooperativeKernel((const void*)mega, dim3(grid), dim3(512), kargs, LDS_BYTES, stream);
    if (e != hipSuccess) fprintf(stderr, "cooperative launch failed: %s (grid %d)\n", hipGetErrorString(e), grid);
#endif
}
```

```cpp
#include <hip/hip_runtime.h>
#include <hip/hip_cooperative_groups.h>
#include <cstdio>
#include <cstdint>
namespace cg = cooperative_groups;

constexpr int NB = 4, SEQ = 4096, M = NB * SEQ, D = 1024;
constexpr int AB_IN = 3072, C_IN = 4112;
constexpr float EPS = 1e-6f;
constexpr float LOG2E = 1.4426950408889634f;

enum { I_X = 0, I_C, I_ADAW, I_ADAB, I_PREG, I_POSTG, I_RELB, I_ABWIN, I_ABWOUT, I_S5ARE, I_S5AIM, I_S5LOGDT, I_S5BRE, I_S5BIM, I_S5CRE, I_S5CIM,
       I_S5D, I_S5GLUW, I_S5GLUB, I_GDNWIN, I_GDNCONV, I_GDNALOG, I_GDNDTB, I_GDNNORMG, I_GDNWOUT, N_IN };

constexpr size_t MiB = 1u << 20;
constexpr size_t WS_CTL = 0;
constexpr size_t WS_MOD = 1 * MiB;
constexpr size_t WS_LAM = WS_MOD + 128 * 1024;
constexpr size_t WS_DEC = WS_MOD + 256 * 1024;
constexpr size_t WS_WIN0 = 2 * MiB, WS_WOUT0 = 8 * MiB, WS_WGLU = 10 * MiB, WS_WIN1 = 11 * MiB, WS_WEXT = 19 * MiB, WS_WOUT1 = 20 * MiB;
constexpr size_t WS_EXTRA = 22 * MiB;
constexpr size_t WS_EGC = 23 * MiB;
constexpr size_t WS_RA = 24 * MiB;
constexpr size_t WS_RZ = 56 * MiB;
constexpr size_t WS_RB = 184 * MiB;
constexpr size_t WS_SC = WS_RB, WS_XS = WS_RB + 4 * MiB, WS_YB = WS_RB + 8 * MiB, WS_KT = WS_RB + 24 * MiB, WS_ET = WS_RB + 25 * MiB, WS_FT = WS_RB + 33 * MiB;
constexpr size_t WS_WNEG = WS_RB, WS_KTP = WS_RB + 32 * MiB, WS_HALO = WS_RB + 64 * MiB;
constexpr size_t WS_END = 256 * MiB;

constexpr int LDS_BYTES = 147456;

#define GAS __attribute__((address_space(1)))
#define LAS __attribute__((address_space(3)))
typedef unsigned short bf16;
typedef unsigned v4u __attribute__((ext_vector_type(4)));
typedef unsigned v2u __attribute__((ext_vector_type(2)));
typedef float f32x4 __attribute__((ext_vector_type(4)));
typedef float f32x2 __attribute__((ext_vector_type(2)));
typedef short bf16x8 __attribute__((ext_vector_type(8)));
typedef short s16x4 __attribute__((ext_vector_type(4)));
#define LDS_WAIT() asm volatile("s_waitcnt lgkmcnt(0)" ::: "memory")
#define VM_WAIT() asm volatile("s_waitcnt vmcnt(0)" ::: "memory")
__device__ __forceinline__ unsigned f2bf(float f) { unsigned u = __builtin_bit_cast(unsigned, f); return (u + 0x7fffu + ((u >> 16) & 1u)) >> 16; }
typedef __bf16 bf16x2_t __attribute__((ext_vector_type(2)));
__device__ __forceinline__ unsigned pk2(float lo, float hi) { f32x2 v = {lo, hi}; bf16x2_t b = __builtin_convertvector(v, bf16x2_t); return __builtin_bit_cast(unsigned, b); }
__device__ __forceinline__ float bflo(unsigned w) { return __builtin_bit_cast(float, w << 16); }
__device__ __forceinline__ float bfhi(unsigned w) { return __builtin_bit_cast(float, w & 0xffff0000u); }
__device__ __forceinline__ float bf2f(bf16 b) { return __builtin_bit_cast(float, ((unsigned)b) << 16); }
__device__ __forceinline__ float wave_sum(float v) {
#pragma unroll
    for (int o = 1; o < 64; o <<= 1) v += __shfl_xor(v, o);
    return v;
}
__device__ __forceinline__ float sigmoidf_(float x) { return 1.0f / (1.0f + __expf(-x)); }
__device__ __forceinline__ float siluf_(float x) { return x / (1.0f + __expf(-x)); }
__device__ __forceinline__ float gelu_tanh(float x) { const float u = 0.7978845608028654f * (x + 0.044715f * x * x * x); const float e = __expf(2.0f * u); const float t = 1.0f - 2.0f / (e + 1.0f); return 0.5f * x * (1.0f + t); }
typedef GAS unsigned gu32;
#define RLX_AGENT __ATOMIC_RELAXED, __HIP_MEMORY_SCOPE_AGENT
typedef __attribute__((address_space(3))) const char* lds_cptr;
typedef short v4i16_t __attribute__((ext_vector_type(4)));
__device__ __forceinline__ s16x4 vtr(lds_cptr p) { return __builtin_bit_cast(s16x4, __builtin_amdgcn_ds_read_tr16_b64_v4i16((__attribute__((address_space(3))) v4i16_t*)p)); }
#define MFMA16(a, b, c) __builtin_amdgcn_mfma_f32_16x16x32_bf16((a), (b), (c), 0, 0, 0)

#define XB_TMO      128
#define XB_XCNT(j)  (256  + 64 * (j))
#define XB_XSUB(j)  (1280 + 64 * (j))
#define XB_XGEN(j)  (2304 + 64 * (j))
#define XB_TOP      3328
#define XB_TOPGEN   3392
#define XCD_BAR_WORDS 3456
#define XB_SPIN_CAP (1u << 18)

__device__ __forceinline__ unsigned xb_ld(unsigned* p)              { return __hip_atomic_load(p, __ATOMIC_RELAXED, __HIP_MEMORY_SCOPE_AGENT); }
__device__ __forceinline__ unsigned xb_add(unsigned* p, unsigned v) { return __hip_atomic_fetch_add(p, v, __ATOMIC_RELAXED, __HIP_MEMORY_SCOPE_AGENT); }
__device__ __forceinline__ unsigned xb_xcc_id() { return (unsigned)__builtin_amdgcn_s_getreg((3 << 11) | 20) & 0xFu; }
#define XB_SPIN(cond, bar) do { unsigned _sp = 0; while (cond) { __builtin_amdgcn_s_sleep(1); \
    if ((++_sp & 255u) == 0u) { if (xb_ld(&(bar)[XB_TMO])) break; if (_sp > XB_SPIN_CAP) { atomicAdd(&(bar)[XB_TMO], 1u); break; } } } } while (0)

struct XcdBarrier {
    unsigned* bar; unsigned x;
    volatile LAS unsigned* st;
};

__device__ __forceinline__ XcdBarrier xcd_barrier_post(unsigned* bar, volatile LAS unsigned* st) {
    XcdBarrier b; b.bar = bar; b.x = xb_xcc_id(); b.st = st;
    if (threadIdx.x == 0) (void)xb_add(&bar[XB_XCNT(b.x)], 1u);
    return b;
}
__device__ __forceinline__ void xcd_barrier_complete(unsigned* bar, unsigned x, unsigned& nloc, unsigned& nx) {
    const unsigned G = gridDim.x * gridDim.y * gridDim.z;
    unsigned sum, cnt, mine, sp = 0u;
    for (;;) {
        sum = 0u; cnt = 0u; mine = 0u;
#pragma unroll
        for (unsigned j = 0; j < 16; ++j) { const unsigned c = xb_ld(&bar[XB_XCNT(j)]); sum += c; cnt += (c > 0u) ? 1u : 0u; mine = (j == x) ? c : mine; }
        if (sum == G) break;
        __builtin_amdgcn_s_sleep(1);
        if ((++sp & 255u) == 0u) { if (xb_ld(&bar[XB_TMO])) break; if (sp > XB_SPIN_CAP) { atomicAdd(&bar[XB_TMO], 1u); break; } }
    }
    nloc = mine > 0u ? mine : 1u; nx = cnt > 0u ? cnt : 1u;
}

__device__ __forceinline__ void xcd_barrier(const XcdBarrier& b) {
    asm volatile("s_waitcnt vmcnt(0)" ::: "memory");
    __syncthreads();
    if (threadIdx.x == 0) {
        unsigned* bar = b.bar;
        __builtin_amdgcn_s_waitcnt(0);
        unsigned nloc = b.st[0], nx = b.st[1];
        if (nloc == 0u) { xcd_barrier_complete(bar, b.x, nloc, nx); b.st[0] = nloc; b.st[1] = nx; }
        const unsigned old = xb_add(&bar[XB_XSUB(b.x)], 1u);
        const unsigned gen = old / nloc;
        if (old + 1u == (gen + 1u) * nloc) {
            __builtin_amdgcn_fence(__ATOMIC_RELEASE, "agent");
            asm volatile("s_waitcnt vmcnt(0)" ::: "memory");
            const unsigned og = xb_add(&bar[XB_TOP], 1u);
            const unsigned tg = og / nx;
            if (og + 1u == (tg + 1u) * nx) xb_add(&bar[XB_TOPGEN], 1u);
            else XB_SPIN(xb_ld(&bar[XB_TOPGEN]) == tg, bar);
            __builtin_amdgcn_fence(__ATOMIC_ACQUIRE, "agent");
            xb_add(&bar[XB_XGEN(b.x)], 1u);
            asm volatile("s_waitcnt vmcnt(0)" ::: "memory");
        } else {
            XB_SPIN(xb_ld(&bar[XB_XGEN(b.x)]) == gen, bar);
            __builtin_amdgcn_fence(__ATOMIC_ACQUIRE, "agent");
            asm volatile("s_waitcnt vmcnt(0)" ::: "memory");
        }
    }
    __syncthreads();
}
namespace pg8 {
#define PG8_LAS __attribute__((address_space(3)))
typedef unsigned short bf16_t;
typedef short bf16x8 __attribute__((ext_vector_type(8)));
typedef float f32x4 __attribute__((ext_vector_type(4)));
typedef unsigned u32x4 __attribute__((ext_vector_type(4)));
constexpr int BM = 256, BK = 64, HALF = 128, HTB = HALF * BK * 2  , STAGE_BYTES = 8 * HTB, NXCD = 8, WGM = 8;

__host__ __device__ __forceinline__ int lds_byte(int r, int c) { const int st = (r >> 4) * 2 + (c >> 5), rr = r & 15, cc = c & 31, ob = rr * 64 + cc * 2; return st * 1024 + (ob ^ (((ob >> 9) & 1) << 5)); }
__host__ __device__ __forceinline__ void stage_rc(int b, int& R, int& C) { const int st = b / 1024, sb = b % 1024, swz = sb ^ (((sb >> 9) & 1) << 5); R = (st >> 1) * 16 + swz / 64; C = (st & 1) * 32 + (swz % 64) / 2; }
__host__ __device__ __forceinline__ int perm32(int rho) { const int n = rho >> 4, i = rho & 15; return 8 * (i >> 2) + 4 * n + (i & 3); }

struct Unit { int pm, pn; };
struct Gemm { const bf16_t* A; const bf16_t* Bt; int M, N, K; };

struct StaticOrder {
    int nM, nN, nwg, G, c;
    __host__ __device__ void init(int M, int N, int G_, int c_) { nM = M / BM; nN = N / BM; nwg = nM * nN; G = G_; c = c_; }
    __host__ __device__ bool next(int i, Unit& u) const {
        const long L = (long)i * G + c; if (L >= nwg) return false;
        int wgid = (int)L; { const int q = nwg / NXCD, r = nwg % NXCD, xcd = wgid % NXCD, off = wgid / NXCD; wgid = (xcd < r ? xcd * (q + 1) : r * (q + 1) + (xcd - r) * q) + off; }
        const int nig = WGM * nN, gid = wgid / nig, fm = gid * WGM, gsz = (nM - fm) < WGM ? (nM - fm) : WGM;
        u.pm = fm + ((wgid % nig) % gsz); u.pn = (wgid % nig) / gsz; return true;
    }
    __device__ __forceinline__ void a_ready(const Unit&) const {}
    __device__ __forceinline__ void done(const Unit&) const {}
};


__device__ __forceinline__ unsigned cvt_pk_bf16(float lo, float hi) { unsigned r; asm volatile("v_cvt_pk_bf16_f32 %0, %1, %2" : "=v"(r) : "v"(lo), "v"(hi)); return r; }

template <bool HALO> struct EpiBf16 {
    static constexpr bool PERM = true, AFTER_DRAIN = false;
    bf16_t* O; int ldc; bf16_t* halo; int halo_cols;
    __device__ __forceinline__ void operator()(const f32x4 (&acc)[2][2][4][2], const Unit& u, int wr, int wc, int fr, int fq) const {
        const int row0 = u.pm * BM + wr * 64 + fr; const int col0 = u.pn * BM + wc * 32 + 8 * fq;
#pragma unroll
        for (int ai = 0; ai < 2; ++ai)
#pragma unroll
            for (int m = 0; m < 4; ++m) { const int row = row0 + ai * HALF + m * 16; bf16_t* rowp = O + (size_t)row * ldc + col0;
#pragma unroll
                for (int bj = 0; bj < 2; ++bj) { const f32x4 v0 = acc[ai][bj][m][0], v1 = acc[ai][bj][m][1];
                    u32x4 w; w.x = cvt_pk_bf16(v0[0], v0[1]); w.y = cvt_pk_bf16(v0[2], v0[3]); w.z = cvt_pk_bf16(v1[0], v1[1]); w.w = cvt_pk_bf16(v1[2], v1[3]);
                    *(u32x4*)(rowp + bj * HALF) = w;
                    if (HALO) { if (m == 3 && fr >= 13 && (col0 + bj * HALF) < halo_cols) *(u32x4*)(halo + ((size_t)(row >> 6) * 3 + (fr - 13)) * halo_cols + col0 + bj * HALF) = w; }
                } }
    }
};
struct EpiF32 {
    static constexpr bool PERM = false, AFTER_DRAIN = false;
    float* C; int ldc;
    __device__ __forceinline__ void operator()(const f32x4 (&acc)[2][2][4][2], const Unit& u, int wr, int wc, int fr, int fq) const {
        const int row0 = u.pm * BM + wr * 64 + fr, col0 = u.pn * BM + wc * 32 + 4 * fq;
#pragma unroll
        for (int ai = 0; ai < 2; ++ai)
#pragma unroll
            for (int m = 0; m < 4; ++m) { float* rowp = C + (size_t)(row0 + ai * HALF + m * 16) * ldc + col0;
#pragma unroll
                for (int bj = 0; bj < 2; ++bj)
#pragma unroll
                    for (int n = 0; n < 2; ++n) *(f32x4*)(rowp + bj * HALF + n * 16) = acc[ai][bj][m][n]; }
    }
};
struct EpiGlu {
    static constexpr bool PERM = true, AFTER_DRAIN = false;
    const bf16_t* yb; const bf16_t* z0; const float* glu_b; bf16_t* O;
    __device__ __forceinline__ void operator()(const f32x4 (&acc)[2][2][4][2], const Unit& u, int wr, int wc, int fr, int fq) const {
        const int row0 = u.pm * BM + wr * 64 + fr; const int col0 = u.pn * BM + wc * 32 + 8 * fq;
#pragma unroll
        for (int bj = 0; bj < 2; ++bj) { const int c = col0 + bj * HALF;
            const f32x4 b0 = *(const f32x4*)(glu_b + c), b1 = *(const f32x4*)(glu_b + c + 4);
#pragma unroll
            for (int ai = 0; ai < 2; ++ai)
#pragma unroll
                for (int m = 0; m < 4; ++m) { const size_t row = (size_t)(row0 + ai * HALF + m * 16);
                    const u32x4 yw = *(const u32x4*)(yb + row * 512 + c); const u32x4 gw = *(const u32x4*)(z0 + row * 3072 + 2560 + c);
                    const f32x4 v0 = acc[ai][bj][m][0] + b0, v1 = acc[ai][bj][m][1] + b1;
                    float r[8];
#pragma unroll
                    for (int j = 0; j < 4; ++j) { const unsigned ywj = yw[j], gwj = gw[j];
                        const float ylo = __builtin_bit_cast(float, ywj << 16), yhi = __builtin_bit_cast(float, ywj & 0xffff0000u);
                        const float glo = __builtin_bit_cast(float, gwj << 16), ghi = __builtin_bit_cast(float, gwj & 0xffff0000u);
                        const float a0 = (j < 2) ? v0[2 * j] : v1[2 * j - 4], a1 = (j < 2) ? v0[2 * j + 1] : v1[2 * j - 3];
                        r[2 * j] = ylo / (1.0f + __expf(-a0)) * (glo / (1.0f + __expf(-glo)));
                        r[2 * j + 1] = yhi / (1.0f + __expf(-a1)) * (ghi / (1.0f + __expf(-ghi))); }
                    u32x4 w; w.x = cvt_pk_bf16(r[0], r[1]); w.y = cvt_pk_bf16(r[2], r[3]); w.z = cvt_pk_bf16(r[4], r[5]); w.w = cvt_pk_bf16(r[6], r[7]);
                    *(u32x4*)(O + row * 1024 + 512 + c) = w; } }
    }
};
template <class Epi, class Sched, bool ALIGN_EPI = false, bool SP2 = false>
__device__ __forceinline__ void gemm_phase(PG8_LAS unsigned char* lds, const Gemm g, const Sched& S, const Epi& E) {
    const int tid = threadIdx.x, wid = __builtin_amdgcn_readfirstlane(tid >> 6), lane = tid & 63, wr = wid >> 2, wc = wid & 3, fr = lane & 15, fq = lane >> 4;
    const int K = g.K, nt = K / BK;
    unsigned voffA[2], voffB[2];
#pragma unroll
    for (int i = 0; i < 2; ++i) { int R, C; stage_rc(tid * 16 + i * 8192, R, C); const int Rb = Epi::PERM ? ((R & ~31) + perm32(R & 31)) : R;
        voffA[i] = (unsigned)(R * K + C) * 2u; voffB[i] = (unsigned)(Rb * K + C) * 2u; }
    const size_t kstep = (size_t)(BK * 2);
    const size_t hstep = (size_t)HALF * K * 2;
    const size_t tstep = 2 * hstep;
    const unsigned ldsw = (unsigned)wid * 1024u;
    const int aoff = lds_byte(wr * 64 + fr, fq * 8), boff = lds_byte(wc * 32 + fr, fq * 8);
#define PG8_SA(b, h) (((b) * 2 + (h)) * HTB)
#define PG8_SB(b, h) ((4 + (b) * 2 + (h)) * HTB)
#define PG8_STAGE(bufoff, gbase, voff) do { _Pragma("unroll") for (int _i = 0; _i < 2; ++_i) \
        __builtin_amdgcn_global_load_lds((const unsigned*)((const char*)(gbase) + (voff)[_i]), (PG8_LAS unsigned*)(lds + (bufoff) + ldsw + _i * 8192), 16, 0, 0); } while (0)
#define PG8_LDA(dst, b, h) do { _Pragma("unroll") for (int m = 0; m < 4; ++m) _Pragma("unroll") for (int k = 0; k < 2; ++k) dst[m][k] = *(const PG8_LAS bf16x8*)(lds + PG8_SA(b, h) + aoff + m * 2048 + k * 1024); } while (0)
#define PG8_LDB(dst, b, h) do { _Pragma("unroll") for (int n = 0; n < 2; ++n) _Pragma("unroll") for (int k = 0; k < 2; ++k) dst[n][k] = *(const PG8_LAS bf16x8*)(lds + PG8_SB(b, h) + boff + n * 2048 + k * 1024); } while (0)
#define PG8_MMA(ai, bj, At, Bt) do { __builtin_amdgcn_s_setprio(1); _Pragma("unroll") for (int m = 0; m < 4; ++m) _Pragma("unroll") for (int n = 0; n < 2; ++n) _Pragma("unroll") for (int k = 0; k < 2; ++k) \
        acc[ai][bj][m][n] = __builtin_amdgcn_mfma_f32_16x16x32_bf16(Bt[n][k], At[m][k], acc[ai][bj][m][n], 0, 0, 0); __builtin_amdgcn_s_setprio(0); } while (0)
#define PG8_WAIT_V(n) asm volatile("s_waitcnt vmcnt(" #n ")" ::: "memory")
#define PG8_WAIT_L(n) asm volatile("s_waitcnt lgkmcnt(" #n ")" ::: "memory")
#define PG8_BAR __builtin_amdgcn_s_barrier()
#define PG8_SCHED __builtin_amdgcn_sched_barrier(0)
    Unit cur, nxt; int ui = 0;
    if (!S.next(0, cur)) return;
    f32x4 acc[2][2][4][2];
#pragma unroll
    for (int a = 0; a < 2; ++a)
#pragma unroll
        for (int b = 0; b < 2; ++b)
#pragma unroll
            for (int m = 0; m < 4; ++m)
#pragma unroll
                for (int n = 0; n < 2; ++n) acc[a][b][m][n] = (f32x4){0.f, 0.f, 0.f, 0.f};
    bf16x8 At[4][2], B0[2][2], B1[2][2];
    const char* cA = (const char*)g.A + (size_t)cur.pm * tstep; const char* cB = (const char*)g.Bt + (size_t)cur.pn * tstep;
    S.a_ready(cur);
    if constexpr (SP2) {
        PG8_STAGE(PG8_SB(0, 0), cB, voffB); PG8_STAGE(PG8_SB(0, 1), cB + hstep, voffB); PG8_STAGE(PG8_SA(0, 0), cA, voffA); PG8_STAGE(PG8_SA(0, 1), cA + hstep, voffA);
        if (wr == 1) PG8_BAR;
        PG8_WAIT_V(2); PG8_BAR;
        PG8_STAGE(PG8_SB(1, 0), cB + kstep, voffB); PG8_STAGE(PG8_SA(1, 0), cA + kstep, voffA); PG8_STAGE(PG8_SB(1, 1), cB + hstep + kstep, voffB);
        PG8_WAIT_V(6); PG8_BAR;
    } else {
        PG8_STAGE(PG8_SB(0, 0), cB, voffB); PG8_STAGE(PG8_SA(0, 0), cA, voffA); PG8_STAGE(PG8_SB(0, 1), cB + hstep, voffB); PG8_STAGE(PG8_SA(0, 1), cA + hstep, voffA);
        if (wr == 1) PG8_BAR;
        PG8_WAIT_V(4); PG8_BAR;
        PG8_STAGE(PG8_SB(1, 0), cB + kstep, voffB); PG8_STAGE(PG8_SA(1, 0), cA + kstep, voffA); PG8_STAGE(PG8_SB(1, 1), cB + hstep + kstep, voffB);
        PG8_WAIT_V(6); PG8_BAR;
    }
    for (;;) {
        const bool has_next = S.next(ui + 1, nxt);
        const char* nA = has_next ? (const char*)g.A + (size_t)nxt.pm * tstep : cA; const char* nB = has_next ? (const char*)g.Bt + (size_t)nxt.pn * tstep : cB;
        for (int t = 0; t < nt; t += 2) {
            const bool last = (t == nt - 2);
            const char* a1 = cA + (size_t)(t + 1) * kstep;
            const char* a2 = last ? nA : cA + (size_t)(t + 2) * kstep; const char* b2 = last ? nB : cB + (size_t)(t + 2) * kstep;
            const char* a3 = a2 + kstep; const char* b3 = b2 + kstep;
            if (last && has_next) S.a_ready(nxt);
            if constexpr (SP2) {
            PG8_LDB(B0, 0, 0); PG8_LDB(B1, 0, 1); PG8_SCHED; PG8_LDA(At, 0, 0); PG8_STAGE(PG8_SA(1, 1), a1 + hstep, voffA);
            PG8_WAIT_V(8); PG8_WAIT_L(0); PG8_BAR; PG8_MMA(0, 0, At, B0); PG8_MMA(0, 1, At, B1); PG8_BAR; PG8_SCHED;
            PG8_LDA(At, 0, 1); PG8_STAGE(PG8_SB(0, 0), b2, voffB); PG8_STAGE(PG8_SB(0, 1), b2 + hstep, voffB); PG8_STAGE(PG8_SA(0, 0), a2, voffA);
            PG8_WAIT_V(8); PG8_WAIT_L(0); PG8_BAR; PG8_MMA(1, 0, At, B0); PG8_MMA(1, 1, At, B1); PG8_BAR; PG8_SCHED;
            PG8_LDB(B0, 1, 0); PG8_LDB(B1, 1, 1); PG8_SCHED; PG8_LDA(At, 1, 0); PG8_STAGE(PG8_SA(0, 1), a2 + hstep, voffA);
            PG8_WAIT_V(8); PG8_WAIT_L(0); PG8_BAR; PG8_MMA(0, 0, At, B0); PG8_MMA(0, 1, At, B1); PG8_BAR; PG8_SCHED;
            PG8_LDA(At, 1, 1); PG8_STAGE(PG8_SB(1, 0), b3, voffB); PG8_STAGE(PG8_SB(1, 1), b3 + hstep, voffB); PG8_STAGE(PG8_SA(1, 0), a3, voffA);
            PG8_WAIT_V(8); PG8_WAIT_L(0); PG8_BAR; PG8_MMA(1, 0, At, B0); PG8_MMA(1, 1, At, B1); PG8_BAR; PG8_SCHED;
            } else {
            PG8_LDB(B0, 0, 0); PG8_SCHED; PG8_LDA(At, 0, 0); PG8_STAGE(PG8_SA(1, 1), a1 + hstep, voffA);
            PG8_WAIT_L(8); PG8_BAR; PG8_WAIT_L(0); PG8_MMA(0, 0, At, B0); PG8_BAR; PG8_SCHED;
            PG8_LDB(B1, 0, 1); PG8_STAGE(PG8_SB(0, 0), b2, voffB);
            PG8_BAR; PG8_WAIT_L(0); PG8_MMA(0, 1, At, B1); PG8_BAR;
            PG8_LDA(At, 0, 1); PG8_STAGE(PG8_SA(0, 0), a2, voffA);
            PG8_BAR; PG8_WAIT_L(0); PG8_MMA(1, 0, At, B0); PG8_BAR; PG8_SCHED;
            PG8_STAGE(PG8_SB(0, 1), b2 + hstep, voffB);
            PG8_WAIT_V(6); PG8_BAR; PG8_MMA(1, 1, At, B1); PG8_BAR;
            PG8_LDB(B0, 1, 0); PG8_SCHED; PG8_LDA(At, 1, 0); PG8_STAGE(PG8_SA(0, 1), a2 + hstep, voffA);
            PG8_WAIT_L(8); PG8_BAR; PG8_WAIT_L(0); PG8_MMA(0, 0, At, B0); PG8_BAR; PG8_SCHED;
            PG8_LDB(B1, 1, 1); PG8_STAGE(PG8_SB(1, 0), b3, voffB);
            PG8_BAR; PG8_WAIT_L(0); PG8_MMA(0, 1, At, B1); PG8_BAR;
            PG8_LDA(At, 1, 1); PG8_STAGE(PG8_SA(1, 0), a3, voffA);
            PG8_BAR; PG8_WAIT_L(0); PG8_MMA(1, 0, At, B0); PG8_BAR; PG8_SCHED;
            PG8_STAGE(PG8_SB(1, 1), b3 + hstep, voffB);
            PG8_WAIT_V(6); PG8_BAR; PG8_MMA(1, 1, At, B1); PG8_BAR;
            }
        }
        if constexpr (ALIGN_EPI) { if (wr == 0) PG8_BAR; }
        if constexpr (!Epi::AFTER_DRAIN) { E(acc, cur, wr, wc, fr, fq); S.done(cur); }
        if (!has_next) break;
#pragma unroll
        for (int a = 0; a < 2; ++a)
#pragma unroll
            for (int b = 0; b < 2; ++b)
#pragma unroll
                for (int m = 0; m < 4; ++m)
#pragma unroll
                    for (int n = 0; n < 2; ++n) acc[a][b][m][n] = (f32x4){0.f, 0.f, 0.f, 0.f};
        cur = nxt; cA = nA; cB = nB; ++ui;
        if constexpr (ALIGN_EPI) { if (wr == 1) PG8_BAR; }
    }
    PG8_WAIT_V(0);
    if constexpr (!ALIGN_EPI) { if (wr == 0) PG8_BAR; }
    PG8_BAR;
    if constexpr (Epi::AFTER_DRAIN) { E.fused(acc, cur, wr, wc, fr, fq, lds, wid, lane); S.done(cur); }
#undef PG8_SA
#undef PG8_SB
#undef PG8_STAGE
#undef PG8_LDA
#undef PG8_LDB
#undef PG8_MMA
#undef PG8_WAIT_V
#undef PG8_WAIT_L
#undef PG8_BAR
#undef PG8_SCHED
}
}

struct Frame {
    LAS unsigned char* lds;
    int tid, lane, wave, G, bid;
    const float* in[N_IN];
    float* out;
    unsigned char* ws;
};

__device__ __forceinline__ void p0_transpose_item(const float* W, int K, int N, int ldn, bf16* WT, LAS float* scr, int item, int lane) {
    const int nblk = N / 32, kb = item / nblk, nb = item % nblk, k0 = 64 * kb, n0 = 32 * nb;
#pragma unroll 8
    for (int i = 0; i < 32; ++i) { const int kk = 2 * i + (lane >> 5); scr[kk * 33 + (lane & 31)] = W[(size_t)(k0 + kk) * ldn + n0 + (lane & 31)]; }
    LDS_WAIT(); asm volatile("" ::: "memory");
    const int c = lane & 7;
#pragma unroll
    for (int j = 0; j < 4; ++j) { const int n = (lane >> 3) + 8 * j; const LAS float* s = scr + (8 * c) * 33 + n;
        v4u o; o.x = pk2(s[0 * 33], s[1 * 33]); o.y = pk2(s[2 * 33], s[3 * 33]); o.z = pk2(s[4 * 33], s[5 * 33]); o.w = pk2(s[6 * 33], s[7 * 33]);
        *(GAS v4u*)(WT + (size_t)(n0 + n) * K + k0 + 8 * c) = o; }
    LDS_WAIT(); asm volatile("" ::: "memory");
}

__device__ __forceinline__ void p0_mod_item(Frame& F, int item) {
    LAS float* sc = (LAS float*)(F.lds);
    LAS float* red = (LAS float*)(F.lds + 16384);
    const float* c = F.in[I_C];
    for (int i = F.tid; i < 4096; i += 512) sc[i] = siluf_(c[i]);
    __syncthreads();
    const int l = item / 96, nb = item % 96, n = nb * 32 + (F.lane & 31), kh = F.lane >> 5;
    const float* W = F.in[I_ADAW] + (size_t)l * 1024 * 3072;
    float a0 = 0.f, a1 = 0.f, a2 = 0.f, a3 = 0.f;
    const int kbase = F.wave * 128;
#pragma unroll 8
    for (int i = 0; i < 64; ++i) { const int k = kbase + 2 * i + kh; const float w = W[(size_t)k * 3072 + n];
        a0 += sc[k] * w; a1 += sc[1024 + k] * w; a2 += sc[2048 + k] * w; a3 += sc[3072 + k] * w; }
    a0 += __shfl_xor(a0, 32); a1 += __shfl_xor(a1, 32); a2 += __shfl_xor(a2, 32); a3 += __shfl_xor(a3, 32);
    if (F.lane < 32) { red[(F.wave * 4 + 0) * 32 + F.lane] = a0; red[(F.wave * 4 + 1) * 32 + F.lane] = a1; red[(F.wave * 4 + 2) * 32 + F.lane] = a2; red[(F.wave * 4 + 3) * 32 + F.lane] = a3; }
    __syncthreads();
    if (F.tid < 128) { const int b = F.tid >> 5, nn = F.tid & 31; float s = 0.f;
#pragma unroll
        for (int w = 0; w < 8; ++w) s += red[(w * 4 + b) * 32 + nn];
        float* mod = (float*)(F.ws + WS_MOD);
        mod[(size_t)(l * 4 + b) * 3072 + nb * 32 + nn] = s + F.in[I_ADAB][l * 3072 + nb * 32 + nn]; }
    __syncthreads();
}

__device__ __forceinline__ void p0_s5_tables(Frame& F, int g) {
    LAS float* pw = (LAS float*)(F.lds);
    LAS float* bb = (LAS float*)(F.lds + 34816);
    LAS float* cc = (LAS float*)(F.lds + 34816 + 8192);
    const float dt = __expf(F.in[I_S5LOGDT][g]);
    for (int i = F.tid; i < 65 * 64; i += 512) { const int tau = i >> 6, p = i & 63;
        const float ar = F.in[I_S5ARE][g * 64 + p], ai = F.in[I_S5AIM][g * 64 + p];
        const float mag = expf((float)tau * (dt * ar)); float sn, cs; sincosf((float)tau * (dt * ai), &sn, &cs);
        pw[2 * i] = mag * cs; pw[2 * i + 1] = mag * sn; }
    for (int i = F.tid; i < 64 * 16; i += 512) { const int p = i >> 4, m = i & 15;
        const float ar = F.in[I_S5ARE][g * 64 + p], ai = F.in[I_S5AIM][g * 64 + p];
        const float mag = expf(dt * ar); float sn, cs; sincosf(dt * ai, &sn, &cs);
        const float abr = mag * cs, abi = mag * sn, den = ar * ar + ai * ai;
        const float fr = ((abr - 1.0f) * ar + abi * ai) / den, fi = (abi * ar - (abr - 1.0f) * ai) / den;
        const float br = F.in[I_S5BRE][(size_t)(g * 64 + p) * 16 + m], bi = F.in[I_S5BIM][(size_t)(g * 64 + p) * 16 + m];
        bb[2 * i] = fr * br - fi * bi; bb[2 * i + 1] = fr * bi + fi * br; }
    for (int i = F.tid; i < 16 * 64; i += 512) { cc[2 * i] = F.in[I_S5CRE][(size_t)g * 1024 + i]; cc[2 * i + 1] = F.in[I_S5CIM][(size_t)g * 1024 + i]; }
    __syncthreads();
    if (F.tid < 64) { float* lam = (float*)(F.ws + WS_LAM); lam[(g * 64 + F.tid) * 2] = pw[2 * (64 * 64 + F.tid)]; lam[(g * 64 + F.tid) * 2 + 1] = pw[2 * (64 * 64 + F.tid) + 1]; }
    { const int tau = F.tid >> 3, m0 = (F.tid & 7) * 2;
      float acc[2][16];
#pragma unroll
      for (int a = 0; a < 2; ++a)
#pragma unroll
          for (int b = 0; b < 16; ++b) acc[a][b] = 0.f;
      for (int p = 0; p < 64; ++p) { const float wr_ = pw[2 * (tau * 64 + p)], wi_ = pw[2 * (tau * 64 + p) + 1];
#pragma unroll
          for (int a = 0; a < 2; ++a) { const float cr = cc[2 * ((m0 + a) * 64 + p)], ci = cc[2 * ((m0 + a) * 64 + p) + 1];
              const float hr = cr * wr_ - ci * wi_, hi = cr * wi_ + ci * wr_;
#pragma unroll
              for (int b = 0; b < 16; ++b) acc[a][b] += hr * bb[2 * (p * 16 + b)] - hi * bb[2 * (p * 16 + b) + 1]; } }
      bf16* Kt = (bf16*)(F.ws + WS_KT) + (size_t)g * 64 * 256;
#pragma unroll
      for (int a = 0; a < 2; ++a) { unsigned* dst = (unsigned*)(Kt + (size_t)tau * 256 + (m0 + a) * 16);
#pragma unroll
          for (int b = 0; b < 8; ++b) dst[b] = pk2(acc[a][2 * b], acc[a][2 * b + 1]); } }
    { unsigned* Et = (unsigned*)((bf16*)(F.ws + WS_ET) + (size_t)g * 128 * 1024);
      for (int i = F.tid; i < 128 * 512; i += 512) { const int row = i >> 9, k = (i & 511) * 2, part = row >> 6, p = row & 63, t = k >> 4, m = k & 15;
          const float wr_ = pw[2 * ((63 - t) * 64 + p)], wi_ = pw[2 * ((63 - t) * 64 + p) + 1];
          const float b0r = bb[2 * (p * 16 + m)], b0i = bb[2 * (p * 16 + m) + 1], b1r = bb[2 * (p * 16 + m + 1)], b1i = bb[2 * (p * 16 + m + 1) + 1];
          const float v0 = part ? (wr_ * b0i + wi_ * b0r) : (wr_ * b0r - wi_ * b0i), v1 = part ? (wr_ * b1i + wi_ * b1r) : (wr_ * b1r - wi_ * b1i);
          Et[i] = pk2(v0, v1); } }
    { unsigned* Ft = (unsigned*)((bf16*)(F.ws + WS_FT) + (size_t)g * 1024 * 128);
      for (int i = F.tid; i < 1024 * 64; i += 512) { const int row = i >> 6, pk = (i & 63) * 2, ti = row >> 4, m = row & 15, part = pk >> 6, p = pk & 63;
          float v[2];
#pragma unroll
          for (int e = 0; e < 2; ++e) { const float wr_ = pw[2 * ((ti + 1) * 64 + p + e)], wi_ = pw[2 * ((ti + 1) * 64 + p + e) + 1];
              const float cr = cc[2 * (m * 64 + p + e)], ci = cc[2 * (m * 64 + p + e) + 1];
              v[e] = part ? -(cr * wi_ + ci * wr_) : (cr * wr_ - ci * wi_); }
          Ft[i] = pk2(v[0], v[1]); } }
    __syncthreads();
}

__device__ __forceinline__ void p0_prologue(Frame& F) {
    if (F.bid < 192) p0_mod_item(F, F.bid);
    else if (F.bid < 224) p0_s5_tables(F, F.bid - 192);
    __syncthreads();
    LAS float* scr = (LAS float*)(F.lds + F.wave * 16384);
    const int gw = F.bid * 8 + F.wave, NGW = F.G * 8;
    constexpr int I_A = 16 * 96, I_B = 16 * 32, I_C2 = 8 * 16, I_D = 16 * 128, I_E = 16 * 32;
    constexpr int NITEMS = I_A + I_B + I_C2 + I_D + I_E;
    for (int it = gw; it < NITEMS; it += NGW) {
        int r = it;
        if (r < I_A) { p0_transpose_item(F.in[I_ABWIN], 1024, 3072, 3072, (bf16*)(F.ws + WS_WIN0), scr, r, F.lane); continue; } r -= I_A;
        if (r < I_B) { p0_transpose_item(F.in[I_ABWOUT], 1024, 1024, 1024, (bf16*)(F.ws + WS_WOUT0), scr, r, F.lane); continue; } r -= I_B;
        if (r < I_C2) { p0_transpose_item(F.in[I_S5GLUW], 512, 512, 512, (bf16*)(F.ws + WS_WGLU), scr, r, F.lane); continue; } r -= I_C2;
        if (r < I_D) { p0_transpose_item(F.in[I_GDNWIN], 1024, 4096, C_IN, (bf16*)(F.ws + WS_WIN1), scr, r, F.lane); continue; } r -= I_D;
        p0_transpose_item(F.in[I_GDNWOUT], 1024, 1024, 1024, (bf16*)(F.ws + WS_WOUT1), scr, r, F.lane);
    }
    { bf16* we = (bf16*)(F.ws + WS_WEXT); const float* W = F.in[I_GDNWIN];
      for (int i = F.bid * 512 + F.tid; i < 16 * 1024; i += F.G * 512) { const int j = i >> 10, k = i & 1023; we[i] = (bf16)f2bf(W[(size_t)k * C_IN + 4096 + j]); } }
}

__device__ __forceinline__ void modnorm_row(const f32x4 (&v)[4], int lane, const float* g, const float* shift, const float* scale, bf16* orow) {
    float s = 0.f;
#pragma unroll
    for (int j = 0; j < 4; ++j) s += (v[j].x * v[j].x + v[j].y * v[j].y) + (v[j].z * v[j].z + v[j].w * v[j].w);
    const float r = rsqrtf(wave_sum(s) * (1.f / D) + EPS);
    GAS unsigned long long* o8 = (GAS unsigned long long*)orow + lane;
#pragma unroll
    for (int j = 0; j < 4; ++j) { const int c = 4 * lane + 256 * j;
        const f32x4 gg = *(const f32x4*)(g + c), sh = *(const f32x4*)(shift + c), sc = *(const f32x4*)(scale + c);
        const float h0 = v[j].x * r * gg.x * (1.f + sc.x) + sh.x, h1 = v[j].y * r * gg.y * (1.f + sc.y) + sh.y;
        const float h2 = v[j].z * r * gg.z * (1.f + sc.z) + sh.z, h3 = v[j].w * r * gg.w * (1.f + sc.w) + sh.w;
        o8[64 * j] = (unsigned long long)pk2(h0, h1) | ((unsigned long long)pk2(h2, h3) << 32); }
}
__device__ __forceinline__ void p1_modnorm(Frame& F, const float* x, int layer) {
    const int gw = F.bid * 8 + F.wave, NGW = F.G * 8;
    const float* mod = (const float*)(F.ws + WS_MOD) + (size_t)layer * 4 * 3072;
    bf16* H = (bf16*)(F.ws + WS_RA);
    for (int m = gw; m < M; m += NGW) { const int b = m >> 12;
        const GAS f32x4* xr = (const GAS f32x4*)(x + (size_t)m * D) + F.lane;
        f32x4 v[4];
#pragma unroll
        for (int j = 0; j < 4; ++j) v[j] = xr[64 * j];
        modnorm_row(v, F.lane, F.in[I_PREG] + layer * 1024, mod + b * 3072, mod + b * 3072 + 1024, H + (size_t)m * D); }
}
template <bool NEXT> __device__ __forceinline__ void p_residual(Frame& F, const float* xin, const float* y, float* xout, int layer) {
    const int gw = F.bid * 8 + F.wave, NGW = F.G * 8;
    const float* mod = (const float*)(F.ws + WS_MOD) + (size_t)layer * 4 * 3072;
    const float* modn = (const float*)(F.ws + WS_MOD) + (size_t)(layer + 1) * 4 * 3072;
    const float* pg = F.in[I_POSTG] + layer * 1024;
    bf16* H = (bf16*)(F.ws + WS_RA);
    for (int m = gw; m < M; m += NGW) { const int b = m >> 12;
        const GAS f32x4* yr = (const GAS f32x4*)(y + (size_t)m * D) + F.lane; const GAS f32x4* xr = (const GAS f32x4*)(xin + (size_t)m * D) + F.lane;
        f32x4 v[4], xv[4]; float s = 0.f;
#pragma unroll
        for (int j = 0; j < 4; ++j) { v[j] = yr[64 * j]; xv[j] = xr[64 * j]; s += (v[j].x * v[j].x + v[j].y * v[j].y) + (v[j].z * v[j].z + v[j].w * v[j].w); }
        const float r = rsqrtf(wave_sum(s) * (1.f / D) + EPS);
        GAS f32x4* orow = (GAS f32x4*)(xout + (size_t)m * D) + F.lane;
#pragma unroll
        for (int j = 0; j < 4; ++j) { const int c = 4 * F.lane + 256 * j;
            const f32x4 gg = *(const f32x4*)(pg + c), gt = *(const f32x4*)(mod + b * 3072 + 2048 + c);
            xv[j].x += gt.x * (v[j].x * r * gg.x); xv[j].y += gt.y * (v[j].y * r * gg.y); xv[j].z += gt.z * (v[j].z * r * gg.z); xv[j].w += gt.w * (v[j].w * r * gg.w);
            orow[64 * j] = xv[j]; }
        if (NEXT) modnorm_row(xv, F.lane, F.in[I_PREG] + (layer + 1) * 1024, modn + b * 3072, modn + b * 3072 + 1024, H + (size_t)m * D);
    }
}

__constant__ unsigned char T5B[3][132] = {
{0,1,2,3,4,5,6,7,8,9,10,11,12,13,14,15,16,16,16,16,16,16,17,17,17,17,17,17,17,17,18,18,18,18,18,18,18,18,18,18,19,19,19,19,19,19,19,19,19,19,19,19,19,19,20,20,20,20,20,20,20,20,20,20,20,20,20,20,20,20,20,20,20,21,21,21,21,21,21,21,21,21,21,21,21,21,21,21,21,21,21,21,21,21,21,21,21,21,21,22,22,22,22,22,22,22,22,22,22,22,22,22,22,22,22,22,22,22,22,22,22,22,22,22,22,22,22,22,22,0,0,0},
{0,4,8,12,16,16,17,17,18,18,19,19,19,19,20,20,20,20,20,21,21,21,21,21,21,22,22,22,22,22,22,22,22,22,23,23,23,23,23,23,23,23,23,23,23,23,24,24,24,24,24,24,24,24,24,24,24,24,24,24,24,24,25,25,25,25,25,25,25,25,25,25,25,25,25,25,25,25,25,25,25,25,25,26,26,26,26,26,26,26,26,26,26,26,26,26,26,26,26,26,26,26,26,26,26,26,26,26,26,26,26,26,26,27,27,27,27,27,27,27,27,27,27,27,27,27,27,27,27,0,0,0},
{0,16,18,19,20,21,21,22,22,23,23,23,24,24,24,24,25,25,25,25,25,26,26,26,26,26,26,26,26,27,27,27,27,27,27,27,27,27,27,28,28,28,28,28,28,28,28,28,28,28,28,28,29,29,29,29,29,29,29,29,29,29,29,29,29,29,29,29,29,29,30,30,30,30,30,30,30,30,30,30,30,30,30,30,30,30,30,30,30,30,30,30,30,30,30,31,31,31,31,31,31,31,31,31,31,31,31,31,31,31,31,31,31,31,31,31,31,31,31,31,31,31,31,31,31,31,31,31,31,0,0,0}};

constexpr int ATT_VB_OFF = 2048, ATT_VB_WAVE = 4608;
struct AttLd { bf16x8 kf[2][2]; v4u vv[4]; };
__device__ __forceinline__ void att_step_geom(int st, int P0r, int& ci, int& sh, int& q0, int& qs, int& kbase) {
    ci = st >= 18 ? 2 : (st >= 12 ? 1 : 0); const int kt = st - (ci == 0 ? 0 : (ci == 1 ? 12 : 18));
    sh = 2 * ci; q0 = P0r >> sh; qs = 16 >> sh; kbase = q0 - 128 + 32 * kt;
}
__device__ __forceinline__ void att_load(AttLd& L, const bf16* zb, int st, int P0r, int h, int lane) {
    int ci, sh, q0, qs, kbase; att_step_geom(st, P0r, ci, sh, q0, qs, kbase);
    const int res = P0r & ((1 << sh) - 1), jq = lane & 15, g = lane >> 4;
#pragma unroll
    for (int tt = 0; tt < 2; ++tt) { int kidx = kbase + 16 * tt + jq; kidx = kidx < 0 ? 0 : kidx; const int kpos = (kidx << sh) + res;
        const bf16* kp = zb + (size_t)kpos * 3072 + 512 + h * 64 + 8 * g;
        L.kf[tt][0] = *(const bf16x8*)kp; L.kf[tt][1] = *(const bf16x8*)(kp + 32); }
#pragma unroll
    for (int i = 0; i < 4; ++i) { int kidx = kbase + (lane >> 3) + 8 * i; kidx = kidx < 0 ? 0 : kidx; const int kpos = (kidx << sh) + res;
        L.vv[i] = *(const v4u*)(zb + (size_t)kpos * 3072 + 1024 + h * 64 + 8 * (lane & 7)); }
}
__device__ __forceinline__ void attn_task(Frame& F, int task) {
    const int b = task >> 7, h = (task >> 4) & 7, span = task & 15, lane = F.lane;
    LAS float* biasT = (LAS float*)(F.lds);
    LAS unsigned char* vbuf = F.lds + ATT_VB_OFF + F.wave * ATT_VB_WAVE;
    __syncthreads();
    for (int i = F.tid; i < 3 * 132; i += 512) { const int ci = i / 132, rel = i % 132; biasT[i] = F.in[I_RELB][T5B[ci][rel] * 8 + h] * LOG2E; }
    __syncthreads();
    const bf16* zb = (const bf16*)(F.ws + WS_RZ) + (size_t)b * SEQ * 3072;
    bf16* O = (bf16*)(F.ws + WS_RA) + (size_t)b * SEQ * 1024;
    const int jq = lane & 15, g = lane >> 4;
    for (int it = 0; it < 2; ++it) {
        const int P0r = span * 256 + F.wave + 8 * it;
        const int qpos = P0r + 16 * jq;
        bf16x8 qf[2];
        { const bf16* qp = zb + (size_t)qpos * 3072 + h * 64 + 8 * g; qf[0] = *(const bf16x8*)qp; qf[1] = *(const bf16x8*)(qp + 32); }
        float mrun = -1e30f, lrun = 0.f; f32x4 o[4];
#pragma unroll
        for (int hb = 0; hb < 4; ++hb) o[hb] = (f32x4){0.f, 0.f, 0.f, 0.f};
        AttLd cur, nxt; att_load(cur, zb, 0, P0r, h, lane);
        for (int st = 0; st < 23; ++st) {
            if (st + 1 < 23) att_load(nxt, zb, st + 1, P0r, h, lane);
            int ci, sh, q0, qs, kbase; att_step_geom(st, P0r, ci, sh, q0, qs, kbase);
            const int qidx = q0 + qs * jq;
            f32x4 s0 = (f32x4){0.f, 0.f, 0.f, 0.f}, s1 = s0;
            s0 = MFMA16(cur.kf[0][0], qf[0], s0); s0 = MFMA16(cur.kf[0][1], qf[1], s0);
            s1 = MFMA16(cur.kf[1][0], qf[0], s1); s1 = MFMA16(cur.kf[1][1], qf[1], s1);
            float sv[8]; float tm = -1e30f;
#pragma unroll
            for (int e = 0; e < 8; ++e) { const int tt = e >> 2, rr = e & 3; const int kidx = kbase + 16 * tt + 4 * g + rr, rel = qidx - kidx;
                const bool ok = (rel >= 0) && (rel <= 128) && (kidx >= 0); const int relc = rel < 0 ? 0 : (rel > 128 ? 128 : rel);
                const float sc = (tt ? s1[rr] : s0[rr]) * (0.125f * LOG2E) + biasT[ci * 132 + relc];
                sv[e] = ok ? sc : -1e30f; tm = fmaxf(tm, sv[e]); }
            tm = fmaxf(tm, __shfl_xor(tm, 16)); tm = fmaxf(tm, __shfl_xor(tm, 32));
            const float mnew = fmaxf(mrun, tm), alpha = exp2f(mrun - mnew); mrun = mnew;
            float ps = 0.f;
#pragma unroll
            for (int e = 0; e < 8; ++e) { sv[e] = exp2f(sv[e] - mnew); ps += sv[e]; }
            lrun = lrun * alpha + ps;
#pragma unroll
            for (int hb = 0; hb < 4; ++hb) o[hb] = o[hb] * alpha;
            v4u pw; pw.x = pk2(sv[0], sv[1]); pw.y = pk2(sv[2], sv[3]); pw.z = pk2(sv[4], sv[5]); pw.w = pk2(sv[6], sv[7]);
            const bf16x8 pf = __builtin_bit_cast(bf16x8, pw);
            asm volatile("" ::: "memory");
#pragma unroll
            for (int i = 0; i < 4; ++i) *(LAS v4u*)(vbuf + ((lane >> 3) + 8 * i) * 144 + (lane & 7) * 16) = cur.vv[i];
            asm volatile("" ::: "memory");
            const lds_cptr va = (lds_cptr)vbuf + (4 * g + (jq >> 2)) * 144 + 8 * (jq & 3);
#pragma unroll
            for (int hb = 0; hb < 4; ++hb) { const s16x4 lo4 = vtr(va + 32 * hb), hi4 = vtr(va + 32 * hb + 16 * 144);
                const bf16x8 vf = (bf16x8){lo4[0], lo4[1], lo4[2], lo4[3], hi4[0], hi4[1], hi4[2], hi4[3]};
                o[hb] = MFMA16(vf, pf, o[hb]); }
            asm volatile("" ::: "memory");
            cur = nxt;
        }
        float lt = lrun + __shfl_xor(lrun, 16); lt += __shfl_xor(lt, 32);
        const float inv = 1.0f / lt;
#pragma unroll
        for (int hb = 0; hb < 4; ++hb) { const int col = h * 64 + 16 * hb + 4 * g;
            const v2u gw = *(const v2u*)(zb + (size_t)qpos * 3072 + 2048 + col);
            const float g0 = bflo(gw.x), g1 = bfhi(gw.x), g2 = bflo(gw.y), g3 = bfhi(gw.y);
            v2u w; w.x = pk2(o[hb][0] * inv * siluf_(g0), o[hb][1] * inv * siluf_(g1)); w.y = pk2(o[hb][2] * inv * siluf_(g2), o[hb][3] * inv * siluf_(g3));
            *(v2u*)(O + (size_t)qpos * 1024 + col) = w; }
    }
}

__device__ __forceinline__ void s5_pass1(Frame& F, int task) {
    const int g = task >> 4, ct = task & 15, n = F.lane & 15, gq = F.lane >> 4;
    const int cgi = ct * 16 + n, b = cgi >> 6, c = cgi & 63;
    const bf16* Et = (const bf16*)(F.ws + WS_ET) + (size_t)g * 128 * 1024 + (size_t)n * 1024 + 8 * gq;
    const bf16* ub = (const bf16*)(F.ws + WS_RZ) + (size_t)(b * SEQ + c * 64) * 3072 + 1536 + g * 16 + 8 * (gq & 1);
    f32x4 acc[8];
#pragma unroll
    for (int st = 0; st < 8; ++st) acc[st] = (f32x4){0.f, 0.f, 0.f, 0.f};
    for (int s = 0; s < 32; ++s) { const int tok = 2 * s + (gq >> 1);
        const bf16x8 bfr = *(const bf16x8*)(ub + (size_t)tok * 3072);
#pragma unroll
        for (int st = 0; st < 8; ++st) { const bf16x8 afr = *(const bf16x8*)(Et + (size_t)st * 16 * 1024 + 32 * s); acc[st] = MFMA16(afr, bfr, acc[st]); } }
    float* SC = (float*)(F.ws + WS_SC) + (size_t)((b * 32 + g) * 64 + c) * 128 + 4 * gq;
#pragma unroll
    for (int st = 0; st < 8; ++st) *(f32x4*)(SC + 16 * st) = acc[st];
}
__device__ __forceinline__ void s5_carry(Frame& F) {
    const int idx = F.bid * 512 + F.tid; if (idx >= NB * 32 * 64) return;
    const int b = idx >> 11, g = (idx >> 6) & 31, p = idx & 63;
    const float* lam = (const float*)(F.ws + WS_LAM); const float lr = lam[(g * 64 + p) * 2], li = lam[(g * 64 + p) * 2 + 1];
    const float* sc = (const float*)(F.ws + WS_SC) + (size_t)((b * 32 + g) * 64) * 128 + p;
    float* xs = (float*)(F.ws + WS_XS) + (size_t)((b * 32 + g) * 64) * 128 + p;
    float xr = 0.f, xi = 0.f;
#pragma unroll 8
    for (int c = 0; c < 64; ++c) { xs[c * 128] = xr; xs[c * 128 + 64] = xi; const float sr = sc[c * 128], si = sc[c * 128 + 64];
        const float nr = lr * xr - li * xi + sr, ni = lr * xi + li * xr + si; xr = nr; xi = ni; }
}
__device__ __forceinline__ void s5_pass2(Frame& F, int task) {
    const int g = task >> 6, ct = (task >> 2) & 15, q = task & 3, n = F.lane & 15, gq = F.lane >> 4;
    const int cgi = ct * 16 + n, b = cgi >> 6, c = cgi & 63;
    const bf16* Kt = (const bf16*)(F.ws + WS_KT) + (size_t)g * 64 * 256 + n * 16 + 8 * (gq & 1);
    const bf16* Ft = (const bf16*)(F.ws + WS_FT) + (size_t)g * 1024 * 128 + (size_t)n * 128 + 8 * gq;
    const float* XS = (const float*)(F.ws + WS_XS) + (size_t)((b * 32 + g) * 64 + c) * 128 + 8 * gq;
    const bf16* zrow = (const bf16*)(F.ws + WS_RZ) + (size_t)(b * SEQ + c * 64) * 3072 + 1536 + g * 16;
    f32x4 acc[16];
#pragma unroll
    for (int ii = 0; ii < 16; ++ii) acc[ii] = (f32x4){0.f, 0.f, 0.f, 0.f};
    for (int sp = 0; sp < 4; ++sp) { const f32x4 x0 = *(const f32x4*)(XS + 32 * sp), x1 = *(const f32x4*)(XS + 32 * sp + 4);
        v4u xw; xw.x = pk2(x0.x, x0.y); xw.y = pk2(x0.z, x0.w); xw.z = pk2(x1.x, x1.y); xw.w = pk2(x1.z, x1.w); const bf16x8 xf = __builtin_bit_cast(bf16x8, xw);
#pragma unroll
        for (int ii = 0; ii < 16; ++ii) { const int i = q + 4 * ii; const bf16x8 afr = *(const bf16x8*)(Ft + (size_t)i * 16 * 128 + 32 * sp); acc[ii] = MFMA16(afr, xf, acc[ii]); } }
    for (int s = 0; s < 32; ++s) { const int tok = 2 * s + (gq >> 1);
        const bf16x8 bfr = *(const bf16x8*)(zrow + (size_t)tok * 3072 + 8 * (gq & 1));
#pragma unroll
        for (int ii = 0; ii < 16; ++ii) { const int i = q + 4 * ii;
            if ((i >> 1) >= s) { const int tau = i - tok; const bf16x8 ld = *(const bf16x8*)(Kt + (size_t)(tau < 0 ? 0 : tau) * 256);
                const bf16x8 afr = tau < 0 ? (bf16x8){0, 0, 0, 0, 0, 0, 0, 0} : ld; acc[ii] = MFMA16(afr, bfr, acc[ii]); } } }
    const f32x4 dsk = *(const f32x4*)(F.in[I_S5D] + g * 16 + 4 * gq);
    bf16* YB = (bf16*)(F.ws + WS_YB) + (size_t)(b * SEQ + c * 64) * 512 + g * 16 + 4 * gq;
#pragma unroll
    for (int ii = 0; ii < 16; ++ii) { const int i = q + 4 * ii; const v2u uw = *(const v2u*)(zrow + (size_t)i * 3072 + 4 * gq);
        const float y0 = gelu_tanh(acc[ii][0] + dsk.x * bflo(uw.x)), y1 = gelu_tanh(acc[ii][1] + dsk.y * bfhi(uw.x));
        const float y2 = gelu_tanh(acc[ii][2] + dsk.z * bflo(uw.y)), y3 = gelu_tanh(acc[ii][3] + dsk.w * bfhi(uw.y));
        v2u w; w.x = pk2(y0, y1); w.y = pk2(y2, y3); *(v2u*)(YB + (size_t)i * 512) = w; }
}

__device__ __forceinline__ int perm_pos(int o) { return (o & ~31) | (((o >> 2) & 3) << 3) | (((o >> 4) & 1) << 2) | (o & 3); }

__device__ __forceinline__ void gdn_extras_item(Frame& F, int item) {
    if (F.wave >= 4) return;
    const int n = F.lane & 15, g = F.lane >> 4, row0 = item * 64 + F.wave * 16;
    const bf16* A = (const bf16*)(F.ws + WS_RA) + (size_t)(row0 + n) * 1024 + 8 * g;
    const bf16* B = (const bf16*)(F.ws + WS_WEXT) + (size_t)n * 1024 + 8 * g;
    f32x4 acc0 = (f32x4){0.f, 0.f, 0.f, 0.f}, acc1 = acc0;
#pragma unroll 4
    for (int s = 0; s < 32; s += 2) { acc0 = MFMA16(*(const bf16x8*)(A + 32 * s), *(const bf16x8*)(B + 32 * s), acc0); acc1 = MFMA16(*(const bf16x8*)(A + 32 * s + 32), *(const bf16x8*)(B + 32 * s + 32), acc1); }
    float* ex = (float*)(F.ws + WS_EXTRA);
#pragma unroll
    for (int e = 0; e < 4; ++e) ex[(size_t)(row0 + 4 * g + e) * 16 + n] = acc0[e] + acc1[e];
}

constexpr int GP_QS = 0, GP_KS = 17408, GP_VS = 34816, GP_LS = 52224, GP_TB = 69632, GP_TW = 78848, GP_SM = 88064;
__device__ __forceinline__ void gdn_prep_task(Frame& F, int task) {
    const int b = task >> 9, h = (task >> 6) & 7, c = task & 63, tid = F.tid, lane = F.lane, wave = F.wave;
    LAS unsigned char* L = F.lds;
    LAS float* bet = (LAS float*)(L + GP_SM); LAS float* gg = bet + 64; LAS float* gcs = bet + 128;
    bf16* z1 = (bf16*)(F.ws + WS_RZ);
    const size_t row0 = (size_t)b * SEQ + c * 64;
    __syncthreads();
    { const int t = tid >> 3, seg = tid & 7;
      const bf16* halo = (const bf16*)(F.ws + WS_HALO) + (size_t)(b * 64 + c - 1) * 3 * 3072;
#pragma unroll 1
      for (int w3 = 0; w3 < 3; ++w3) { const int ch = w3 * 1024 + h * 128 + seg * 16;
          float a[16];
#pragma unroll
          for (int e = 0; e < 16; ++e) a[e] = 0.f;
#pragma unroll
          for (int j = 0; j < 4; ++j) { const int tl = t - 3 + j;
              v4u r0 = (v4u){0u, 0u, 0u, 0u}, r1 = r0;
              if (tl >= 0) { const bf16* p = z1 + (row0 + tl) * 4096 + ch; r0 = *(const v4u*)p; r1 = *(const v4u*)(p + 8); }
              else if (c > 0) { const bf16* p = halo + (size_t)(tl + 3) * 3072 + ch; r0 = *(const v4u*)p; r1 = *(const v4u*)(p + 8); }
              const float* cw = F.in[I_GDNCONV] + j * 3072 + ch;
              const f32x4 w0 = *(const f32x4*)cw, w1 = *(const f32x4*)(cw + 4), w2 = *(const f32x4*)(cw + 8), w3v = *(const f32x4*)(cw + 12);
              a[0] += w0.x * bflo(r0.x); a[1] += w0.y * bfhi(r0.x); a[2] += w0.z * bflo(r0.y); a[3] += w0.w * bfhi(r0.y);
              a[4] += w1.x * bflo(r0.z); a[5] += w1.y * bfhi(r0.z); a[6] += w1.z * bflo(r0.w); a[7] += w1.w * bfhi(r0.w);
              a[8] += w2.x * bflo(r1.x); a[9] += w2.y * bfhi(r1.x); a[10] += w2.z * bflo(r1.y); a[11] += w2.w * bfhi(r1.y);
              a[12] += w3v.x * bflo(r1.z); a[13] += w3v.y * bfhi(r1.z); a[14] += w3v.z * bflo(r1.w); a[15] += w3v.w * bfhi(r1.w); }
          float s = 0.f;
#pragma unroll
          for (int e = 0; e < 16; ++e) { a[e] = siluf_(a[e]); s += a[e] * a[e]; }
          s += __shfl_xor(s, 1); s += __shfl_xor(s, 2); s += __shfl_xor(s, 4);
          const float r = (w3 == 2) ? 1.0f : rsqrtf(s + EPS) * (w3 == 0 ? 0.08838834764831845f : 1.0f);
#pragma unroll
          for (int e = 0; e < 16; ++e) a[e] *= r;
          LAS unsigned char* dst = L + w3 * 17408 + t * 272 + seg * 32;
          v4u o0, o1; o0.x = pk2(a[0], a[1]); o0.y = pk2(a[2], a[3]); o0.z = pk2(a[4], a[5]); o0.w = pk2(a[6], a[7]);
          o1.x = pk2(a[8], a[9]); o1.y = pk2(a[10], a[11]); o1.z = pk2(a[12], a[13]); o1.w = pk2(a[14], a[15]);
          *(LAS v4u*)dst = o0; *(LAS v4u*)(dst + 16) = o1; }
      if (seg == 0) { const float* ex = (const float*)(F.ws + WS_EXTRA) + (row0 + t) * 16;
          const float braw = ex[h], araw = ex[8 + h] + F.in[I_GDNDTB][h];
          const float sp = araw > 20.f ? araw : log1pf(expf(araw));
          bet[t] = 1.0f / (1.0f + expf(-braw)); gg[t] = -expf(F.in[I_GDNALOG][h]) * sp; } }
    __syncthreads();
    if (wave == 0) { float v = gg[lane];
#pragma unroll
        for (int o = 1; o < 64; o <<= 1) { const float u = __shfl_up(v, o); if (lane >= o) v += u; }
        const float glast = __shfl(v, 63);
        gcs[lane] = v;
        float* egc = (float*)(F.ws + WS_EGC); egc[(row0 + lane) * 8 + h] = expf(v); egc[(size_t)M * 8 + (row0 + lane) * 8 + h] = expf(glast - v);
        if (lane == 0) ((float*)(F.ws + WS_DEC))[(b * 8 + h) * 64 + c] = expf(glast); }
    __syncthreads();
    { const int n = lane & 15, g = lane >> 4;
#pragma unroll
      for (int x = 0; x < 2; ++x) { const int tl = wave + 8 * x, it = tl >> 2, jt = tl & 3;
          const int i = 16 * it + n, j0 = 16 * jt + 4 * g;
          bf16* aq = z1 + (row0 + i) * 4096 + 1024 + h * 128 + ((jt >> 1) * 32 + 8 * g + 4 * (jt & 1));
          if (jt > it) { *(v2u*)aq = (v2u){0u, 0u}; *(LAS f32x4*)(L + GP_LS + i * 272 + j0 * 4) = (f32x4){0.f, 0.f, 0.f, 0.f}; continue; }
          f32x4 kk = (f32x4){0.f, 0.f, 0.f, 0.f}, qk = kk;
#pragma unroll
          for (int s = 0; s < 4; ++s) { const bf16x8 af = *(const LAS bf16x8*)(L + GP_KS + (16 * jt + n) * 272 + 64 * s + 16 * g);
              const bf16x8 bk = *(const LAS bf16x8*)(L + GP_KS + (16 * it + n) * 272 + 64 * s + 16 * g);
              const bf16x8 bq = *(const LAS bf16x8*)(L + GP_QS + (16 * it + n) * 272 + 64 * s + 16 * g);
              kk = MFMA16(af, bk, kk); qk = MFMA16(af, bq, qk); }
          const float gi = gcs[i], bi = bet[i]; f32x4 lv; float av[4];
#pragma unroll
          for (int e = 0; e < 4; ++e) { const int j = j0 + e; const float dcy = expf(gi - gcs[j]);
              lv[e] = (j < i) ? bi * kk[e] * dcy : 0.f; av[e] = (j <= i) ? qk[e] * dcy : 0.f; }
          *(LAS f32x4*)(L + GP_LS + i * 272 + j0 * 4) = lv;
          v2u w; w.x = pk2(av[0], av[1]); w.y = pk2(av[2], av[3]); *(v2u*)aq = w; } }
    __syncthreads();
    if (wave == 0) {
        float t[64];
#pragma unroll
        for (int i = 0; i < 64; ++i) { float a0 = (i == lane) ? 1.f : 0.f, a1 = 0.f;
#pragma unroll
            for (int j4 = 0; j4 < (i + 3) / 4; ++j4) { const f32x4 lr = *(const LAS f32x4*)(L + GP_LS + i * 272 + j4 * 16);
                if (4 * j4 + 0 < i) a0 -= lr.x * t[4 * j4 + 0];
                if (4 * j4 + 1 < i) a1 -= lr.y * t[4 * j4 + 1];
                if (4 * j4 + 2 < i) a0 -= lr.z * t[4 * j4 + 2];
                if (4 * j4 + 3 < i) a1 -= lr.w * t[4 * j4 + 3]; }
            t[i] = a0 + a1; asm volatile("" ::: "memory"); }
        const float bc = bet[lane], bw = bc * expf(gcs[lane]);
#pragma unroll
        for (int i = 0; i < 64; ++i) { *(LAS bf16*)(L + GP_TB + i * 144 + lane * 2) = (bf16)f2bf(t[i] * bc); *(LAS bf16*)(L + GP_TW + i * 144 + lane * 2) = (bf16)f2bf(t[i] * bw); }
    } else {
        const int lt = tid - 64;
        for (int q = lt; q < 1024; q += 448) { const int t = q >> 4, ck = q & 15, J = ck >> 2, g = ck & 3;
            const v2u lo = *(const LAS v2u*)(L + GP_QS + t * 272 + (32 * J + 4 * g) * 2), hi = *(const LAS v2u*)(L + GP_QS + t * 272 + (32 * J + 16 + 4 * g) * 2);
            *(v4u*)(z1 + (row0 + t) * 4096 + h * 128 + 32 * J + 8 * g) = (v4u){lo.x, lo.y, hi.x, hi.y}; }
        bf16* kT = (bf16*)(F.ws + WS_KTP) + (size_t)((b * 8 + h) * 64 + c) * 8192;
        const int n = lane & 15, g = lane >> 4;
        for (int op = wave - 1; op < 16; op += 7) { const int db = op >> 1, J = op & 1;
            const lds_cptr a = (lds_cptr)(L + GP_KS) + (32 * J + 4 * g + (n >> 2)) * 272 + (16 * db + 4 * (n & 3)) * 2;
            const s16x4 lo4 = vtr(a), hi4 = vtr(a + 16 * 272);
            *(v4u*)(kT + (size_t)(16 * db + n) * 64 + 32 * J + 8 * g) = __builtin_bit_cast(v4u, (bf16x8){lo4[0], lo4[1], lo4[2], lo4[3], hi4[0], hi4[1], hi4[2], hi4[3]}); }
    }
    __syncthreads();
    { const int n = lane & 15, g = lane >> 4;
      bf16x8 vfr[2], kfr[2];
#pragma unroll
      for (int s = 0; s < 2; ++s) { const int roff = (32 * s + 8 * g + (n >> 2)) * 272 + (16 * wave + 4 * (n & 3)) * 2;
          const s16x4 v0 = vtr((lds_cptr)(L + GP_VS) + roff), v1 = vtr((lds_cptr)(L + GP_VS) + roff + 4 * 272);
          const s16x4 k0 = vtr((lds_cptr)(L + GP_KS) + roff), k1 = vtr((lds_cptr)(L + GP_KS) + roff + 4 * 272);
          vfr[s] = (bf16x8){v0[0], v0[1], v0[2], v0[3], v1[0], v1[1], v1[2], v1[3]}; kfr[s] = (bf16x8){k0[0], k0[1], k0[2], k0[3], k1[0], k1[1], k1[2], k1[3]}; }
      bf16* uT = (bf16*)(F.ws + WS_RA) + (size_t)((b * 8 + h) * 64 + c) * 8192 + (size_t)(16 * wave + n) * 64;
      bf16* wn = (bf16*)(F.ws + WS_WNEG) + h * 128 + ((wave >> 1) * 32 + 8 * g + 4 * (wave & 1));
#pragma unroll
      for (int it = 0; it < 4; ++it) { f32x4 ua = (f32x4){0.f, 0.f, 0.f, 0.f}, wa = ua;
#pragma unroll
          for (int s = 0; s < 2; ++s) { if (s == 1 && it < 2) continue;
              const bf16x8 tb = *(const LAS bf16x8*)(L + GP_TB + (16 * it + n) * 144 + 64 * s + 16 * g), tw = *(const LAS bf16x8*)(L + GP_TW + (16 * it + n) * 144 + 64 * s + 16 * g);
              ua = MFMA16(tb, vfr[s], ua);
              wa = MFMA16(kfr[s], tw, wa); }
          v2u uw; uw.x = pk2(ua[0], ua[1]); uw.y = pk2(ua[2], ua[3]); *(v2u*)(uT + 16 * it + 4 * g) = uw;
          v2u ww; ww.x = pk2(-wa[0], -wa[1]); ww.y = pk2(-wa[2], -wa[3]); *(v2u*)(wn + (row0 + 16 * it + n) * 1024) = ww; } }
}

constexpr int GS_W = 0, GS_Q = 17408, GS_K = 34816, GS_A = 53248, GS_U = 62464, GS_E = 64768, GS_BUF = 65536;
struct ScanRole { const bf16* src; size_t cstep, delta; int dst, ddelta; };
__device__ __forceinline__ ScanRole gdn_scan_role(Frame& F, int b, int h) {
    const int lw = F.wave - 1, lane = F.lane; const size_t rowb = (size_t)b * SEQ;
    const bf16* z1 = (const bf16*)(F.ws + WS_RZ);
    ScanRole R;
    int cpr, tpb, tix, dstride; size_t sstride; const bf16* base;
    if (lw < 2)      { base = (const bf16*)(F.ws + WS_WNEG) + rowb * 1024 + h * 128; sstride = 1024; cpr = 16; tpb = 128; tix = lw * 64 + lane; R.dst = GS_W; dstride = 272; R.cstep = 64 * 1024; }
    else if (lw < 4) { base = z1 + rowb * 4096 + h * 128; sstride = 4096; cpr = 16; tpb = 128; tix = (lw - 2) * 64 + lane; R.dst = GS_Q; dstride = 272; R.cstep = 64 * 4096; }
    else if (lw < 6) { base = (const bf16*)(F.ws + WS_KTP) + (size_t)((b * 8 + h) * 64) * 8192; sstride = 64; cpr = 8; tpb = 128; tix = (lw - 4) * 64 + lane; R.dst = GS_K; dstride = 144; R.cstep = 8192; }
    else             { base = z1 + rowb * 4096 + 1024 + h * 128; sstride = 4096; cpr = 8; tpb = 64; tix = lane; R.dst = GS_A; dstride = 144; R.cstep = 64 * 4096; }
    const int r0 = tix / cpr, ck = tix % cpr;
    R.src = base + (size_t)r0 * sstride + ck * 8; R.delta = (size_t)(tpb / cpr) * sstride;
    R.dst += r0 * dstride + ck * 16; R.ddelta = (tpb / cpr) * dstride;
    return R;
}
struct ScanLd { v4u v[8]; v4u u[2]; float e[3]; };
__device__ __forceinline__ void gdn_scan_load(Frame& F, ScanLd& L, const ScanRole& R, int b, int h, int c, int dv0) {
    const bf16* s = R.src + (size_t)c * R.cstep;
#pragma unroll
    for (int k = 0; k < 8; ++k) L.v[k] = *(const v4u*)(s + (size_t)k * R.delta);
    if (F.wave == 7) { const int lane = F.lane; const size_t row0 = (size_t)b * SEQ + c * 64;
        const bf16* uT = (const bf16*)(F.ws + WS_RA) + (size_t)((b * 8 + h) * 64 + c) * 8192 + (size_t)dv0 * 64 + (lane >> 3) * 64 + (lane & 7) * 8;
        L.u[0] = *(const v4u*)uT; L.u[1] = *(const v4u*)(uT + 8 * 64);
        const float* egc = (const float*)(F.ws + WS_EGC); L.e[0] = egc[(row0 + lane) * 8 + h]; L.e[1] = egc[(size_t)M * 8 + (row0 + lane) * 8 + h];
        L.e[2] = ((const float*)(F.ws + WS_DEC))[(b * 8 + h) * 64 + c]; }
}
__device__ __forceinline__ void gdn_scan_store(Frame& F, const ScanLd& L, const ScanRole& R, LAS unsigned char* buf) {
#pragma unroll
    for (int k = 0; k < 8; ++k) *(LAS v4u*)(buf + R.dst + k * R.ddelta) = L.v[k];
    if (F.wave == 7) { const int lane = F.lane;
        *(LAS v4u*)(buf + GS_U + (lane >> 3) * 144 + (lane & 7) * 16) = L.u[0]; *(LAS v4u*)(buf + GS_U + (8 + (lane >> 3)) * 144 + (lane & 7) * 16) = L.u[1];
        ((LAS float*)(buf + GS_E))[lane] = L.e[0]; ((LAS float*)(buf + GS_E))[64 + lane] = L.e[1]; if (lane == 0) ((LAS float*)(buf + GS_E))[128] = L.e[2]; }
}
__device__ __forceinline__ void gdn_scan_task(Frame& F, int task) {
    const int b = task >> 6, h = (task >> 3) & 7, dv0 = (task & 7) * 16, lane = F.lane, n = lane & 15, g = lane >> 4;
    __syncthreads();
    ScanLd LD; ScanRole RL = gdn_scan_role(F, b, h);
    if (F.wave != 0) { gdn_scan_load(F, LD, RL, b, h, 0, dv0); gdn_scan_store(F, LD, RL, F.lds); }
    __syncthreads();
    f32x4 S[8];
#pragma unroll
    for (int d = 0; d < 8; ++d) S[d] = (f32x4){0.f, 0.f, 0.f, 0.f};
    bf16* z1 = (bf16*)(F.ws + WS_RZ);
    for (int c = 0; c < 64; ++c) {
        LAS unsigned char* buf = F.lds + (c & 1) * GS_BUF;
        if (F.wave != 0) { if (c + 1 < 64) { gdn_scan_load(F, LD, RL, b, h, c + 1, dv0); gdn_scan_store(F, LD, RL, F.lds + ((c + 1) & 1) * GS_BUF); } }
        else {
            const float dec = ((const LAS float*)(buf + GS_E))[128];
            bf16x8 Sb[4];
#pragma unroll
            for (int kq = 0; kq < 4; ++kq) { v4u w; w.x = pk2(S[2 * kq][0], S[2 * kq][1]); w.y = pk2(S[2 * kq][2], S[2 * kq][3]); w.z = pk2(S[2 * kq + 1][0], S[2 * kq + 1][1]); w.w = pk2(S[2 * kq + 1][2], S[2 * kq + 1][3]); Sb[kq] = __builtin_bit_cast(bf16x8, w); }
            f32x4 vn[4];
#pragma unroll
            for (int it = 0; it < 4; ++it) { const v2u uw = *(const LAS v2u*)(buf + GS_U + n * 144 + (16 * it + 4 * g) * 2);
                f32x4 a = (f32x4){bflo(uw.x), bfhi(uw.x), bflo(uw.y), bfhi(uw.y)};
#pragma unroll
                for (int kq = 0; kq < 4; ++kq) a = MFMA16(*(const LAS bf16x8*)(buf + GS_W + (16 * it + n) * 272 + 64 * kq + 16 * g), Sb[kq], a);
                vn[it] = a; }
            asm volatile("" ::: "memory");
            bf16x8 Vb[2], Vs[2];
            const LAS float* eg = (const LAS float*)(buf + GS_E);
#pragma unroll
            for (int J = 0; J < 2; ++J) { const f32x4 a = vn[2 * J], c2 = vn[2 * J + 1];
                v4u w; w.x = pk2(a[0], a[1]); w.y = pk2(a[2], a[3]); w.z = pk2(c2[0], c2[1]); w.w = pk2(c2[2], c2[3]); Vb[J] = __builtin_bit_cast(bf16x8, w);
                const f32x4 e0 = *(const LAS f32x4*)(eg + 64 + 32 * J + 4 * g), e1 = *(const LAS f32x4*)(eg + 64 + 32 * J + 16 + 4 * g);
                v4u s; s.x = pk2(a[0] * e0.x, a[1] * e0.y); s.y = pk2(a[2] * e0.z, a[3] * e0.w); s.z = pk2(c2[0] * e1.x, c2[1] * e1.y); s.w = pk2(c2[2] * e1.z, c2[3] * e1.w); Vs[J] = __builtin_bit_cast(bf16x8, s); }
#pragma unroll
            for (int it = 0; it < 4; ++it) { f32x4 qo = (f32x4){0.f, 0.f, 0.f, 0.f};
#pragma unroll
                for (int kq = 0; kq < 4; ++kq) qo = MFMA16(Sb[kq], *(const LAS bf16x8*)(buf + GS_Q + (16 * it + n) * 272 + 64 * kq + 16 * g), qo);
                qo = qo * eg[16 * it + n];
#pragma unroll
                for (int J = 0; J < 2; ++J) { if (J == 1 && it < 2) continue; qo = MFMA16(Vb[J], *(const LAS bf16x8*)(buf + GS_A + (16 * it + n) * 144 + 64 * J + 16 * g), qo); }
                v2u w; w.x = pk2(qo[0], qo[1]); w.y = pk2(qo[2], qo[3]);
                *(v2u*)(z1 + ((size_t)b * SEQ + c * 64 + 16 * it + n) * 4096 + 2048 + h * 128 + dv0 + 4 * g) = w; }
            asm volatile("" ::: "memory");
#pragma unroll
            for (int d = 0; d < 8; ++d) { f32x4 a = S[d] * dec;
#pragma unroll
                for (int J = 0; J < 2; ++J) a = MFMA16(*(const LAS bf16x8*)(buf + GS_K + (16 * d + n) * 144 + 64 * J + 16 * g), Vs[J], a);
                S[d] = a; }
        }
        __syncthreads();
    }
}

__device__ __forceinline__ void gdn_outnorm(Frame& F) {
    const int gw = F.bid * 8 + F.wave, NGW = F.G * 8, lane = F.lane;
    const bf16* z1 = (const bf16*)(F.ws + WS_RZ); bf16* og = (bf16*)(F.ws + WS_RA);
    const float* ng = F.in[I_GDNNORMG] + (lane & 7) * 16;
    for (int m = gw; m < M; m += NGW) {
        const v4u o0 = *(const v4u*)(z1 + (size_t)m * 4096 + 2048 + lane * 16), o1 = *(const v4u*)(z1 + (size_t)m * 4096 + 2048 + lane * 16 + 8);
        const v4u g0 = *(const v4u*)(z1 + (size_t)m * 4096 + 3072 + lane * 16), g1 = *(const v4u*)(z1 + (size_t)m * 4096 + 3072 + lane * 16 + 8);
        float ov[16], gv[16];
#pragma unroll
        for (int e = 0; e < 4; ++e) { ov[2 * e] = bflo(o0[e]); ov[2 * e + 1] = bfhi(o0[e]); ov[8 + 2 * e] = bflo(o1[e]); ov[8 + 2 * e + 1] = bfhi(o1[e]);
            gv[2 * e] = bflo(g0[e]); gv[2 * e + 1] = bfhi(g0[e]); gv[8 + 2 * e] = bflo(g1[e]); gv[8 + 2 * e + 1] = bfhi(g1[e]); }
        float s = 0.f;
#pragma unroll
        for (int e = 0; e < 16; ++e) s += ov[e] * ov[e];
        s += __shfl_xor(s, 1); s += __shfl_xor(s, 2); s += __shfl_xor(s, 4);
        const float r = rsqrtf(s * (1.f / 128.f) + EPS);
        float rv[16];
#pragma unroll
        for (int e = 0; e < 16; ++e) rv[e] = ov[e] * r * ng[e] * siluf_(gv[e]);
        v4u w0, w1; w0.x = pk2(rv[0], rv[1]); w0.y = pk2(rv[2], rv[3]); w0.z = pk2(rv[4], rv[5]); w0.w = pk2(rv[6], rv[7]);
        w1.x = pk2(rv[8], rv[9]); w1.y = pk2(rv[10], rv[11]); w1.z = pk2(rv[12], rv[13]); w1.w = pk2(rv[14], rv[15]);
        *(v4u*)(og + (size_t)m * 1024 + lane * 16) = w0; *(v4u*)(og + (size_t)m * 1024 + lane * 16 + 8) = w1; }
}

struct Args { const float* in[N_IN]; float* out; unsigned char* ws; int ph_lo, ph_hi, rep_mask, pad; };
#ifndef REP_MASK
#define REP_MASK 0
#endif
constexpr int NPH = 16;

__global__ void __launch_bounds__(512, 2) mega(Args args) {
    extern __shared__ __attribute__((aligned(16))) unsigned char lds[];
    cg::grid_group grid = cg::this_grid();
    Frame F;
    F.lds = (LAS unsigned char*)lds;
    F.tid = threadIdx.x; F.lane = F.tid & 63; F.wave = __builtin_amdgcn_readfirstlane(F.tid >> 6);
    F.G = gridDim.x; F.bid = blockIdx.x;
#pragma unroll
    for (int i = 0; i < N_IN; ++i) F.in[i] = args.in[i];
    F.out = args.out; F.ws = args.ws;
    const int lo = args.ph_lo, hi = args.ph_hi;
#ifdef PH_ONLY
#define IN(k) ((k) == PH_ONLY && lo <= (k) && (k) < hi)
#else
#define IN(k) (lo <= (k) && (k) < hi)
#endif
#define SEAM(k) do { if (IN(k) && IN((k) + 1)) xcd_barrier(bar); } while (0)
    volatile LAS unsigned* MISC = (volatile LAS unsigned*)(F.lds + LDS_BYTES - 256);
    if (F.tid < 64) MISC[F.tid] = 0u;
    __syncthreads();
    XcdBarrier bar = xcd_barrier_post((unsigned*)(F.ws + WS_CTL) + 4096, MISC + 8);
    if (lo < 0) grid.sync();
    const int gw = F.bid * 8 + F.wave, NGW = F.G * 8;
#define RUNPH(k, ...) if (IN(k)) { { __VA_ARGS__ } if ((REP_MASK >> (k)) & 1) { xcd_barrier(bar); { __VA_ARGS__ } } } SEAM(k);

    RUNPH(0,  p0_prologue(F); )
    RUNPH(1,  p1_modnorm(F, F.in[I_X], 0); )
    RUNPH(2,  pg8::Gemm g{(const bf16*)(F.ws + WS_RA), (const bf16*)(F.ws + WS_WIN0), M, AB_IN, D}; pg8::StaticOrder S; S.init(M, AB_IN, F.G, F.bid);
        pg8::EpiBf16<false> E{(bf16*)(F.ws + WS_RZ), AB_IN, nullptr, 0};
        pg8::gemm_phase<pg8::EpiBf16<false>, pg8::StaticOrder, true, true>(F.lds, g, S, E); )
    RUNPH(3,  if (F.wave < 2) { for (int t = F.bid * 2 + F.wave; t < 512; t += F.G * 2) s5_pass1(F, t); }
        for (int t = F.bid; t < 512; t += F.G) attn_task(F, t); )
    RUNPH(4,  s5_carry(F); )
    RUNPH(5,  for (int t = gw; t < 2048; t += NGW) s5_pass2(F, t); )
    RUNPH(6,  pg8::Gemm g{(const bf16*)(F.ws + WS_YB), (const bf16*)(F.ws + WS_WGLU), M, 512, 512}; pg8::StaticOrder S; S.init(M, 512, F.G, F.bid);
        pg8::EpiGlu E{(const bf16*)(F.ws + WS_YB), (const bf16*)(F.ws + WS_RZ), F.in[I_S5GLUB], (bf16*)(F.ws + WS_RA)};
        pg8::gemm_phase<pg8::EpiGlu, pg8::StaticOrder, true, true>(F.lds, g, S, E); )
    RUNPH(7,  pg8::Gemm g{(const bf16*)(F.ws + WS_RA), (const bf16*)(F.ws + WS_WOUT0), M, D, D}; pg8::StaticOrder S; S.init(M, D, F.G, F.bid);
        pg8::EpiF32 E{(float*)(F.ws + WS_RZ), D};
        pg8::gemm_phase<pg8::EpiF32, pg8::StaticOrder, true, true>(F.lds, g, S, E); )
    RUNPH(8,  p_residual<true>(F, F.in[I_X], (const float*)(F.ws + WS_RZ), F.out, 0); )
    RUNPH(9,  for (int t = F.bid; t < 256; t += F.G) gdn_extras_item(F, t);
        pg8::Gemm g{(const bf16*)(F.ws + WS_RA), (const bf16*)(F.ws + WS_WIN1), M, 4096, D}; pg8::StaticOrder S; S.init(M, 4096, F.G, F.bid);
        pg8::EpiBf16<true> E{(bf16*)(F.ws + WS_RZ), 4096, (bf16*)(F.ws + WS_HALO), 3072};
        pg8::gemm_phase<pg8::EpiBf16<true>, pg8::StaticOrder, true, true>(F.lds, g, S, E); )
    RUNPH(10,  for (int t = F.bid; t < 2048; t += F.G) gdn_prep_task(F, t); )
    RUNPH(11,  for (int t = F.bid; t < 256; t += F.G) { const int tt = (F.G == 256) ? (((t & 7) * 4 + (t >> 6)) * 8 + ((t >> 3) & 7)) : t; gdn_scan_task(F, tt); }     )
    RUNPH(12,  gdn_outnorm(F); )
    RUNPH(13,  pg8::Gemm g{(const bf16*)(F.ws + WS_RA), (const bf16*)(F.ws + WS_WOUT1), M, D, D}; pg8::StaticOrder S; S.init(M, D, F.G, F.bid);
        pg8::EpiF32 E{(float*)(F.ws + WS_RZ), D};
        pg8::gemm_phase<pg8::EpiF32, pg8::StaticOrder, true, true>(F.lds, g, S, E); )
    RUNPH(14,  p_residual<false>(F, F.out, (const float*)(F.ws + WS_RZ), F.out, 1); )
#undef IN
#undef SEAM
}

extern "C" void kernel_launch(void* const* d_in, const int* in_sizes, int n_in, void* d_out, int out_size, void* d_ws, size_t ws_size, hipStream_t stream) {
    static int grid = 0;
    if (grid == 0) {
        if (n_in != N_IN || out_size != M * D || ws_size < WS_END) { fprintf(stderr, "kernel_launch: unexpected shapes n_in %d out %d ws %zu\n", n_in, out_size, ws_size); grid = -1; return; }
        int dev = 0, cus = 0, per_cu = 0;
        if (hipGetDevice(&dev) != hipSuccess || hipDeviceGetAttribute(&cus, hipDeviceAttributeMultiprocessorCount, dev) != hipSuccess) { grid = -1; return; }
        if (hipFuncSetAttribute((const void*)mega, hipFuncAttributeMaxDynamicSharedMemorySize, LDS_BYTES) != hipSuccess) { fprintf(stderr, "hipFuncSetAttribute failed\n"); grid = -1; return; }
        if (hipOccupancyMaxActiveBlocksPerMultiprocessor(&per_cu, (const void*)mega, 512, LDS_BYTES) != hipSuccess || per_cu < 1) { fprintf(stderr, "occupancy query: %d\n", per_cu); per_cu = 1; }
        (void)hipGetLastError();
        grid = cus;
        fprintf(stderr, "kernel_launch: grid %d (per_cu %d)\n", grid, per_cu);
    }
    if (grid < 0) return;
    if (hipMemsetAsync((char*)d_ws + WS_CTL, 0, 65536, stream) != hipSuccess) { fprintf(stderr, "memset failed\n"); return; }
    Args a{};
    for (int i = 0; i < N_IN; ++i) a.in[i] = (const float*)d_in[i];
    a.out = (float*)d_out; a.ws = (unsigned char*)d_ws;
#ifdef MULTI_LAUNCH
    for (int p = 0; p < NPH; ++p) { a.ph_lo = p; a.ph_hi = p + 1; void* kargs[] = {&a};
        hipError_t e = hipLaunchCooperativeKernel((const void*)mega, dim3(grid), dim3(512), kargs, LDS_BYTES, stream);
        if (e != hipSuccess) { fprintf(stderr, "launch %d failed: %s\n", p, hipGetErrorString(e)); break; } }
#else
    a.ph_lo = 0; a.ph_hi = NPH; a.rep_mask = REP_MASK; void* kargs[] = {&a};
    hipError_t e = hipLaunchCooperativeKernel((const void*)mega, dim3(grid), dim3(512), kargs, LDS_BYTES, stream);
    if (e != hipSuccess) fprintf(stderr, "cooperative launch failed: %s (grid %d)\n", hipGetErrorString(e), grid);
#endif
}
```

```cpp
#define REP_MASK 0
#define PREPREP 0
#include <hip/hip_runtime.h>
#include <hip/hip_cooperative_groups.h>
#include <cstdio>
#include <cstdint>
namespace cg = cooperative_groups;

constexpr int NB = 4, SEQ = 4096, M = NB * SEQ, D = 1024;
constexpr int AB_IN = 3072, C_IN = 4112;
constexpr float EPS = 1e-6f;
constexpr float LOG2E = 1.4426950408889634f;

enum { I_X = 0, I_C, I_ADAW, I_ADAB, I_PREG, I_POSTG, I_RELB, I_ABWIN, I_ABWOUT, I_S5ARE, I_S5AIM, I_S5LOGDT, I_S5BRE, I_S5BIM, I_S5CRE, I_S5CIM,
       I_S5D, I_S5GLUW, I_S5GLUB, I_GDNWIN, I_GDNCONV, I_GDNALOG, I_GDNDTB, I_GDNNORMG, I_GDNWOUT, N_IN };

constexpr size_t MiB = 1u << 20;
constexpr size_t WS_CTL = 0;
constexpr size_t WS_MOD = 1 * MiB;
constexpr size_t WS_LAM = WS_MOD + 128 * 1024;
constexpr size_t WS_DEC = WS_MOD + 256 * 1024;
constexpr size_t WS_WIN0 = 2 * MiB, WS_WOUT0 = 8 * MiB, WS_WGLU = 10 * MiB, WS_WIN1 = 11 * MiB, WS_WEXT = 19 * MiB, WS_WOUT1 = 20 * MiB;
constexpr size_t WS_EXTRA = 22 * MiB;
constexpr size_t WS_EGC = 23 * MiB;
constexpr size_t WS_RA = 24 * MiB;
constexpr size_t WS_RZ = 56 * MiB;
constexpr size_t WS_RB = 184 * MiB;
constexpr size_t WS_SC = WS_RB, WS_XS = WS_RB + 4 * MiB, WS_YB = WS_RB + 8 * MiB, WS_KT = WS_RB + 24 * MiB, WS_ET = WS_RB + 25 * MiB, WS_FT = WS_RB + 33 * MiB;
constexpr size_t WS_WNEG = WS_RB, WS_KTP = WS_RB + 32 * MiB, WS_HALO = WS_RB + 64 * MiB;
constexpr size_t WS_END = 256 * MiB;

constexpr int LDS_BYTES = 147456;

#define GAS __attribute__((address_space(1)))
#define LAS __attribute__((address_space(3)))
typedef unsigned short bf16;
typedef unsigned v4u __attribute__((ext_vector_type(4)));
typedef unsigned v2u __attribute__((ext_vector_type(2)));
typedef float f32x4 __attribute__((ext_vector_type(4)));
typedef float f32x2 __attribute__((ext_vector_type(2)));
typedef short bf16x8 __attribute__((ext_vector_type(8)));
typedef short s16x4 __attribute__((ext_vector_type(4)));
#define LDS_WAIT() asm volatile("s_waitcnt lgkmcnt(0)" ::: "memory")
#define VM_WAIT() asm volatile("s_waitcnt vmcnt(0)" ::: "memory")
__device__ __forceinline__ unsigned f2bf(float f) { unsigned u = __builtin_bit_cast(unsigned, f); return (u + 0x7fffu + ((u >> 16) & 1u)) >> 16; }
typedef __bf16 bf16x2_t __attribute__((ext_vector_type(2)));
__device__ __forceinline__ unsigned pk2(float lo, float hi) { f32x2 v = {lo, hi}; bf16x2_t b = __builtin_convertvector(v, bf16x2_t); return __builtin_bit_cast(unsigned, b); }
__device__ __forceinline__ float bflo(unsigned w) { return __builtin_bit_cast(float, w << 16); }
__device__ __forceinline__ float bfhi(unsigned w) { return __builtin_bit_cast(float, w & 0xffff0000u); }
__device__ __forceinline__ float bf2f(bf16 b) { return __builtin_bit_cast(float, ((unsigned)b) << 16); }
__device__ __forceinline__ float wave_sum(float v) {
#pragma unroll
    for (int o = 1; o < 64; o <<= 1) v += __shfl_xor(v, o);
    return v;
}
__device__ __forceinline__ float sigmoidf_(float x) { return 1.0f / (1.0f + __expf(-x)); }
__device__ __forceinline__ float siluf_(float x) { return x / (1.0f + __expf(-x)); }
__device__ __forceinline__ float gelu_tanh(float x) { const float u = 0.7978845608028654f * (x + 0.044715f * x * x * x); const float e = __expf(2.0f * u); const float t = 1.0f - 2.0f / (e + 1.0f); return 0.5f * x * (1.0f + t); }
typedef GAS unsigned gu32;
#define RLX_AGENT __ATOMIC_RELAXED, __HIP_MEMORY_SCOPE_AGENT
typedef __attribute__((address_space(3))) const char* lds_cptr;
typedef short v4i16_t __attribute__((ext_vector_type(4)));
__device__ __forceinline__ s16x4 vtr(lds_cptr p) { return __builtin_bit_cast(s16x4, __builtin_amdgcn_ds_read_tr16_b64_v4i16((__attribute__((address_space(3))) v4i16_t*)p)); }
#define MFMA16(a, b, c) __builtin_amdgcn_mfma_f32_16x16x32_bf16((a), (b), (c), 0, 0, 0)

#define XB_TMO      128
#define XB_XCNT(j)  (256  + 64 * (j))
#define XB_XSUB(j)  (1280 + 64 * (j))
#define XB_XGEN(j)  (2304 + 64 * (j))
#define XB_TOP      3328
#define XB_TOPGEN   3392
#define XCD_BAR_WORDS 3456
#define XB_SPIN_CAP (1u << 18)

__device__ __forceinline__ unsigned xb_ld(unsigned* p)              { return __hip_atomic_load(p, __ATOMIC_RELAXED, __HIP_MEMORY_SCOPE_AGENT); }
__device__ __forceinline__ unsigned xb_add(unsigned* p, unsigned v) { return __hip_atomic_fetch_add(p, v, __ATOMIC_RELAXED, __HIP_MEMORY_SCOPE_AGENT); }
__device__ __forceinline__ unsigned xb_xcc_id() { return (unsigned)__builtin_amdgcn_s_getreg((3 << 11) | 20) & 0xFu; }
#define XB_SPIN(cond, bar) do { unsigned _sp = 0; while (cond) { __builtin_amdgcn_s_sleep(1); \
    if ((++_sp & 255u) == 0u) { if (xb_ld(&(bar)[XB_TMO])) break; if (_sp > XB_SPIN_CAP) { atomicAdd(&(bar)[XB_TMO], 1u); break; } } } } while (0)

struct XcdBarrier {
    unsigned* bar; unsigned x;
    volatile LAS unsigned* st;
};

__device__ __forceinline__ XcdBarrier xcd_barrier_post(unsigned* bar, volatile LAS unsigned* st) {
    XcdBarrier b; b.bar = bar; b.x = xb_xcc_id(); b.st = st;
    if (threadIdx.x == 0) (void)xb_add(&bar[XB_XCNT(b.x)], 1u);
    return b;
}
__device__ __forceinline__ void xcd_barrier_complete(unsigned* bar, unsigned x, unsigned& nloc, unsigned& nx) {
    const unsigned G = gridDim.x * gridDim.y * gridDim.z;
    unsigned sum, cnt, mine, sp = 0u;
    for (;;) {
        sum = 0u; cnt = 0u; mine = 0u;
#pragma unroll
        for (unsigned j = 0; j < 16; ++j) { const unsigned c = xb_ld(&bar[XB_XCNT(j)]); sum += c; cnt += (c > 0u) ? 1u : 0u; mine = (j == x) ? c : mine; }
        if (sum == G) break;
        __builtin_amdgcn_s_sleep(1);
        if ((++sp & 255u) == 0u) { if (xb_ld(&bar[XB_TMO])) break; if (sp > XB_SPIN_CAP) { atomicAdd(&bar[XB_TMO], 1u); break; } }
    }
    nloc = mine > 0u ? mine : 1u; nx = cnt > 0u ? cnt : 1u;
}

__device__ __forceinline__ void xcd_barrier(const XcdBarrier& b) {
    asm volatile("s_waitcnt vmcnt(0)" ::: "memory");
    __syncthreads();
    if (threadIdx.x == 0) {
        unsigned* bar = b.bar;
        __builtin_amdgcn_s_waitcnt(0);
        unsigned nloc = b.st[0], nx = b.st[1];
        if (nloc == 0u) { xcd_barrier_complete(bar, b.x, nloc, nx); b.st[0] = nloc; b.st[1] = nx; }
        const unsigned old = xb_add(&bar[XB_XSUB(b.x)], 1u);
        const unsigned gen = old / nloc;
        if (old + 1u == (gen + 1u) * nloc) {
            __builtin_amdgcn_fence(__ATOMIC_RELEASE, "agent");
            asm volatile("s_waitcnt vmcnt(0)" ::: "memory");
            const unsigned og = xb_add(&bar[XB_TOP], 1u);
            const unsigned tg = og / nx;
            if (og + 1u == (tg + 1u) * nx) xb_add(&bar[XB_TOPGEN], 1u);
            else XB_SPIN(xb_ld(&bar[XB_TOPGEN]) == tg, bar);
            __builtin_amdgcn_fence(__ATOMIC_ACQUIRE, "agent");
            xb_add(&bar[XB_XGEN(b.x)], 1u);
            asm volatile("s_waitcnt vmcnt(0)" ::: "memory");
        } else {
            XB_SPIN(xb_ld(&bar[XB_XGEN(b.x)]) == gen, bar);
            __builtin_amdgcn_fence(__ATOMIC_ACQUIRE, "agent");
            asm volatile("s_waitcnt vmcnt(0)" ::: "memory");
        }
    }
    __syncthreads();
}
namespace pg8 {
#define PG8_LAS __attribute__((address_space(3)))
typedef unsigned short bf16_t;
typedef short bf16x8 __attribute__((ext_vector_type(8)));
typedef float f32x4 __attribute__((ext_vector_type(4)));
typedef unsigned u32x4 __attribute__((ext_vector_type(4)));
constexpr int BM = 256, BK = 64, HALF = 128, HTB = HALF * BK * 2  , STAGE_BYTES = 8 * HTB, NXCD = 8, WGM = 8;

__host__ __device__ __forceinline__ int lds_byte(int r, int c) { const int st = (r >> 4) * 2 + (c >> 5), rr = r & 15, cc = c & 31, ob = rr * 64 + cc * 2; return st * 1024 + (ob ^ (((ob >> 9) & 1) << 5)); }
__host__ __device__ __forceinline__ void stage_rc(int b, int& R, int& C) { const int st = b / 1024, sb = b % 1024, swz = sb ^ (((sb >> 9) & 1) << 5); R = (st >> 1) * 16 + swz / 64; C = (st & 1) * 32 + (swz % 64) / 2; }
__host__ __device__ __forceinline__ int perm32(int rho) { const int n = rho >> 4, i = rho & 15; return 8 * (i >> 2) + 4 * n + (i & 3); }

struct Unit { int pm, pn; };
struct Gemm { const bf16_t* A; const bf16_t* Bt; int M, N, K; };

struct StaticOrder {
    int nM, nN, nwg, G, c;
    __host__ __device__ void init(int M, int N, int G_, int c_) { nM = M / BM; nN = N / BM; nwg = nM * nN; G = G_; c = c_; }
    __host__ __device__ bool next(int i, Unit& u) const {
        const long L = (long)i * G + c; if (L >= nwg) return false;
        int wgid = (int)L; { const int q = nwg / NXCD, r = nwg % NXCD, xcd = wgid % NXCD, off = wgid / NXCD; wgid = (xcd < r ? xcd * (q + 1) : r * (q + 1) + (xcd - r) * q) + off; }
        const int nig = WGM * nN, gid = wgid / nig, fm = gid * WGM, gsz = (nM - fm) < WGM ? (nM - fm) : WGM;
        u.pm = fm + ((wgid % nig) % gsz); u.pn = (wgid % nig) / gsz; return true;
    }
    __device__ __forceinline__ void a_ready(const Unit&) const {}
    __device__ __forceinline__ void done(const Unit&) const {}
};


__device__ __forceinline__ unsigned cvt_pk_bf16(float lo, float hi) { unsigned r; asm volatile("v_cvt_pk_bf16_f32 %0, %1, %2" : "=v"(r) : "v"(lo), "v"(hi)); return r; }

template <bool HALO> struct EpiBf16 {
    static constexpr bool PERM = true, AFTER_DRAIN = false;
    bf16_t* O; int ldc; bf16_t* halo; int halo_cols;
    __device__ __forceinline__ void operator()(const f32x4 (&acc)[2][2][4][2], const Unit& u, int wr, int wc, int fr, int fq) const {
        const int row0 = u.pm * BM + wr * 64 + fr; const int col0 = u.pn * BM + wc * 32 + 8 * fq;
#pragma unroll
        for (int ai = 0; ai < 2; ++ai)
#pragma unroll
            for (int m = 0; m < 4; ++m) { const int row = row0 + ai * HALF + m * 16; bf16_t* rowp = O + (size_t)row * ldc + col0;
#pragma unroll
                for (int bj = 0; bj < 2; ++bj) { const f32x4 v0 = acc[ai][bj][m][0], v1 = acc[ai][bj][m][1];
                    u32x4 w; w.x = cvt_pk_bf16(v0[0], v0[1]); w.y = cvt_pk_bf16(v0[2], v0[3]); w.z = cvt_pk_bf16(v1[0], v1[1]); w.w = cvt_pk_bf16(v1[2], v1[3]);
                    *(u32x4*)(rowp + bj * HALF) = w;
                    if (HALO) { if (m == 3 && fr >= 13 && (col0 + bj * HALF) < halo_cols) *(u32x4*)(halo + ((size_t)(row >> 6) * 3 + (fr - 13)) * halo_cols + col0 + bj * HALF) = w; }
                } }
    }
};
struct EpiF32 {
    static constexpr bool PERM = false, AFTER_DRAIN = false;
    float* C; int ldc;
    __device__ __forceinline__ void operator()(const f32x4 (&acc)[2][2][4][2], const Unit& u, int wr, int wc, int fr, int fq) const {
        const int row0 = u.pm * BM + wr * 64 + fr, col0 = u.pn * BM + wc * 32 + 4 * fq;
#pragma unroll
        for (int ai = 0; ai < 2; ++ai)
#pragma unroll
            for (int m = 0; m < 4; ++m) { float* rowp = C + (size_t)(row0 + ai * HALF + m * 16) * ldc + col0;
#pragma unroll
                for (int bj = 0; bj < 2; ++bj)
#pragma unroll
                    for (int n = 0; n < 2; ++n) *(f32x4*)(rowp + bj * HALF + n * 16) = acc[ai][bj][m][n]; }
    }
};
struct EpiGlu {
    static constexpr bool PERM = true, AFTER_DRAIN = false;
    const bf16_t* yb; const bf16_t* z0; const float* glu_b; bf16_t* O;
    __device__ __forceinline__ void operator()(const f32x4 (&acc)[2][2][4][2], const Unit& u, int wr, int wc, int fr, int fq) const {
        const int row0 = u.pm * BM + wr * 64 + fr; const int col0 = u.pn * BM + wc * 32 + 8 * fq;
#pragma unroll
        for (int bj = 0; bj < 2; ++bj) { const int c = col0 + bj * HALF;
            const f32x4 b0 = *(const f32x4*)(glu_b + c), b1 = *(const f32x4*)(glu_b + c + 4);
#pragma unroll
            for (int ai = 0; ai < 2; ++ai)
#pragma unroll
                for (int m = 0; m < 4; ++m) { const size_t row = (size_t)(row0 + ai * HALF + m * 16);
                    const u32x4 yw = *(const u32x4*)(yb + row * 512 + c); const u32x4 gw = *(const u32x4*)(z0 + row * 3072 + 2560 + c);
                    const f32x4 v0 = acc[ai][bj][m][0] + b0, v1 = acc[ai][bj][m][1] + b1;
                    float r[8];
#pragma unroll
                    for (int j = 0; j < 4; ++j) { const unsigned ywj = yw[j], gwj = gw[j];
                        const float ylo = __builtin_bit_cast(float, ywj << 16), yhi = __builtin_bit_cast(float, ywj & 0xffff0000u);
                        const float glo = __builtin_bit_cast(float, gwj << 16), ghi = __builtin_bit_cast(float, gwj & 0xffff0000u);
                        const float a0 = (j < 2) ? v0[2 * j] : v1[2 * j - 4], a1 = (j < 2) ? v0[2 * j + 1] : v1[2 * j - 3];
                        r[2 * j] = ylo / (1.0f + __expf(-a0)) * (glo / (1.0f + __expf(-glo)));
                        r[2 * j + 1] = yhi / (1.0f + __expf(-a1)) * (ghi / (1.0f + __expf(-ghi))); }
                    u32x4 w; w.x = cvt_pk_bf16(r[0], r[1]); w.y = cvt_pk_bf16(r[2], r[3]); w.z = cvt_pk_bf16(r[4], r[5]); w.w = cvt_pk_bf16(r[6], r[7]);
                    *(u32x4*)(O + row * 1024 + 512 + c) = w; } }
    }
};
template <class Epi, class Sched, bool ALIGN_EPI = false, bool SP2 = false>
__device__ __forceinline__ void gemm_phase(PG8_LAS unsigned char* lds, const Gemm g, const Sched& S, const Epi& E) {
    const int tid = threadIdx.x, wid = __builtin_amdgcn_readfirstlane(tid >> 6), lane = tid & 63, wr = wid >> 2, wc = wid & 3, fr = lane & 15, fq = lane >> 4;
    const int K = g.K, nt = K / BK;
    unsigned voffA[2], voffB[2];
#pragma unroll
    for (int i = 0; i < 2; ++i) { int R, C; stage_rc(tid * 16 + i * 8192, R, C); const int Rb = Epi::PERM ? ((R & ~31) + perm32(R & 31)) : R;
        voffA[i] = (unsigned)(R * K + C) * 2u; voffB[i] = (unsigned)(Rb * K + C) * 2u; }
    const size_t kstep = (size_t)(BK * 2);
    const size_t hstep = (size_t)HALF * K * 2;
    const size_t tstep = 2 * hstep;
    const unsigned ldsw = (unsigned)wid * 1024u;
    const int aoff = lds_byte(wr * 64 + fr, fq * 8), boff = lds_byte(wc * 32 + fr, fq * 8);
#define PG8_SA(b, h) (((b) * 2 + (h)) * HTB)
#define PG8_SB(b, h) ((4 + (b) * 2 + (h)) * HTB)
#define PG8_STAGE(bufoff, gbase, voff) do { _Pragma("unroll") for (int _i = 0; _i < 2; ++_i) \
        __builtin_amdgcn_global_load_lds((const unsigned*)((const char*)(gbase) + (voff)[_i]), (PG8_LAS unsigned*)(lds + (bufoff) + ldsw + _i * 8192), 16, 0, 0); } while (0)
#define PG8_LDA(dst, b, h) do { _Pragma("unroll") for (int m = 0; m < 4; ++m) _Pragma("unroll") for (int k = 0; k < 2; ++k) dst[m][k] = *(const PG8_LAS bf16x8*)(lds + PG8_SA(b, h) + aoff + m * 2048 + k * 1024); } while (0)
#define PG8_LDB(dst, b, h) do { _Pragma("unroll") for (int n = 0; n < 2; ++n) _Pragma("unroll") for (int k = 0; k < 2; ++k) dst[n][k] = *(const PG8_LAS bf16x8*)(lds + PG8_SB(b, h) + boff + n * 2048 + k * 1024); } while (0)
#define PG8_MMA(ai, bj, At, Bt) do { __builtin_amdgcn_s_setprio(1); _Pragma("unroll") for (int m = 0; m < 4; ++m) _Pragma("unroll") for (int n = 0; n < 2; ++n) _Pragma("unroll") for (int k = 0; k < 2; ++k) \
        acc[ai][bj][m][n] = __builtin_amdgcn_mfma_f32_16x16x32_bf16(Bt[n][k], At[m][k], acc[ai][bj][m][n], 0, 0, 0); __builtin_amdgcn_s_setprio(0); } while (0)
#define PG8_WAIT_V(n) asm volatile("s_waitcnt vmcnt(" #n ")" ::: "memory")
#define PG8_WAIT_L(n) asm volatile("s_waitcnt lgkmcnt(" #n ")" ::: "memory")
#define PG8_BAR __builtin_amdgcn_s_barrier()
#define PG8_SCHED __builtin_amdgcn_sched_barrier(0)
    Unit cur, nxt; int ui = 0;
    if (!S.next(0, cur)) return;
    f32x4 acc[2][2][4][2];
#pragma unroll
    for (int a = 0; a < 2; ++a)
#pragma unroll
        for (int b = 0; b < 2; ++b)
#pragma unroll
            for (int m = 0; m < 4; ++m)
#pragma unroll
                for (int n = 0; n < 2; ++n) acc[a][b][m][n] = (f32x4){0.f, 0.f, 0.f, 0.f};
    bf16x8 At[4][2], B0[2][2], B1[2][2];
    const char* cA = (const char*)g.A + (size_t)cur.pm * tstep; const char* cB = (const char*)g.Bt + (size_t)cur.pn * tstep;
    S.a_ready(cur);
    if constexpr (SP2) {
        PG8_STAGE(PG8_SB(0, 0), cB, voffB); PG8_STAGE(PG8_SB(0, 1), cB + hstep, voffB); PG8_STAGE(PG8_SA(0, 0), cA, voffA); PG8_STAGE(PG8_SA(0, 1), cA + hstep, voffA);
        if (wr == 1) PG8_BAR;
        PG8_WAIT_V(2); PG8_BAR;
        PG8_STAGE(PG8_SB(1, 0), cB + kstep, voffB); PG8_STAGE(PG8_SA(1, 0), cA + kstep, voffA); PG8_STAGE(PG8_SB(1, 1), cB + hstep + kstep, voffB);
        PG8_WAIT_V(6); PG8_BAR;
    } else {
        PG8_STAGE(PG8_SB(0, 0), cB, voffB); PG8_STAGE(PG8_SA(0, 0), cA, voffA); PG8_STAGE(PG8_SB(0, 1), cB + hstep, voffB); PG8_STAGE(PG8_SA(0, 1), cA + hstep, voffA);
        if (wr == 1) PG8_BAR;
        PG8_WAIT_V(4); PG8_BAR;
        PG8_STAGE(PG8_SB(1, 0), cB + kstep, voffB); PG8_STAGE(PG8_SA(1, 0), cA + kstep, voffA); PG8_STAGE(PG8_SB(1, 1), cB + hstep + kstep, voffB);
        PG8_WAIT_V(6); PG8_BAR;
    }
    for (;;) {
        const bool has_next = S.next(ui + 1, nxt);
        const char* nA = has_next ? (const char*)g.A + (size_t)nxt.pm * tstep : cA; const char* nB = has_next ? (const char*)g.Bt + (size_t)nxt.pn * tstep : cB;
        for (int t = 0; t < nt; t += 2) {
            const bool last = (t == nt - 2);
            const char* a1 = cA + (size_t)(t + 1) * kstep;
            const char* a2 = last ? nA : cA + (size_t)(t + 2) * kstep; const char* b2 = last ? nB : cB + (size_t)(t + 2) * kstep;
            const char* a3 = a2 + kstep; const char* b3 = b2 + kstep;
            if (last && has_next) S.a_ready(nxt);
            if constexpr (SP2) {
            PG8_LDB(B0, 0, 0); PG8_LDB(B1, 0, 1); PG8_SCHED; PG8_LDA(At, 0, 0); PG8_STAGE(PG8_SA(1, 1), a1 + hstep, voffA);
            PG8_WAIT_V(8); PG8_WAIT_L(0); PG8_BAR; PG8_MMA(0, 0, At, B0); PG8_MMA(0, 1, At, B1); PG8_BAR; PG8_SCHED;
            PG8_LDA(At, 0, 1); PG8_STAGE(PG8_SB(0, 0), b2, voffB); PG8_STAGE(PG8_SB(0, 1), b2 + hstep, voffB); PG8_STAGE(PG8_SA(0, 0), a2, voffA);
            PG8_WAIT_V(8); PG8_WAIT_L(0); PG8_BAR; PG8_MMA(1, 0, At, B0); PG8_MMA(1, 1, At, B1); PG8_BAR; PG8_SCHED;
            PG8_LDB(B0, 1, 0); PG8_LDB(B1, 1, 1); PG8_SCHED; PG8_LDA(At, 1, 0); PG8_STAGE(PG8_SA(0, 1), a2 + hstep, voffA);
            PG8_WAIT_V(8); PG8_WAIT_L(0); PG8_BAR; PG8_MMA(0, 0, At, B0); PG8_MMA(0, 1, At, B1); PG8_BAR; PG8_SCHED;
            PG8_LDA(At, 1, 1); PG8_STAGE(PG8_SB(1, 0), b3, voffB); PG8_STAGE(PG8_SB(1, 1), b3 + hstep, voffB); PG8_STAGE(PG8_SA(1, 0), a3, voffA);
            PG8_WAIT_V(8); PG8_WAIT_L(0); PG8_BAR; PG8_MMA(1, 0, At, B0); PG8_MMA(1, 1, At, B1); PG8_BAR; PG8_SCHED;
            } else {
            PG8_LDB(B0, 0, 0); PG8_SCHED; PG8_LDA(At, 0, 0); PG8_STAGE(PG8_SA(1, 1), a1 + hstep, voffA);
            PG8_WAIT_L(8); PG8_BAR; PG8_WAIT_L(0); PG8_MMA(0, 0, At, B0); PG8_BAR; PG8_SCHED;
            PG8_LDB(B1, 0, 1); PG8_STAGE(PG8_SB(0, 0), b2, voffB);
            PG8_BAR; PG8_WAIT_L(0); PG8_MMA(0, 1, At, B1); PG8_BAR;
            PG8_LDA(At, 0, 1); PG8_STAGE(PG8_SA(0, 0), a2, voffA);
            PG8_BAR; PG8_WAIT_L(0); PG8_MMA(1, 0, At, B0); PG8_BAR; PG8_SCHED;
            PG8_STAGE(PG8_SB(0, 1), b2 + hstep, voffB);
            PG8_WAIT_V(6); PG8_BAR; PG8_MMA(1, 1, At, B1); PG8_BAR;
            PG8_LDB(B0, 1, 0); PG8_SCHED; PG8_LDA(At, 1, 0); PG8_STAGE(PG8_SA(0, 1), a2 + hstep, voffA);
            PG8_WAIT_L(8); PG8_BAR; PG8_WAIT_L(0); PG8_MMA(0, 0, At, B0); PG8_BAR; PG8_SCHED;
            PG8_LDB(B1, 1, 1); PG8_STAGE(PG8_SB(1, 0), b3, voffB);
            PG8_BAR; PG8_WAIT_L(0); PG8_MMA(0, 1, At, B1); PG8_BAR;
            PG8_LDA(At, 1, 1); PG8_STAGE(PG8_SA(1, 0), a3, voffA);
            PG8_BAR; PG8_WAIT_L(0); PG8_MMA(1, 0, At, B0); PG8_BAR; PG8_SCHED;
            PG8_STAGE(PG8_SB(1, 1), b3 + hstep, voffB);
            PG8_WAIT_V(6); PG8_BAR; PG8_MMA(1, 1, At, B1); PG8_BAR;
            }
        }
        if constexpr (ALIGN_EPI) { if (wr == 0) PG8_BAR; }
        if constexpr (!Epi::AFTER_DRAIN) { E(acc, cur, wr, wc, fr, fq); S.done(cur); }
        if (!has_next) break;
#pragma unroll
        for (int a = 0; a < 2; ++a)
#pragma unroll
            for (int b = 0; b < 2; ++b)
#pragma unroll
                for (int m = 0; m < 4; ++m)
#pragma unroll
                    for (int n = 0; n < 2; ++n) acc[a][b][m][n] = (f32x4){0.f, 0.f, 0.f, 0.f};
        cur = nxt; cA = nA; cB = nB; ++ui;
        if constexpr (ALIGN_EPI) { if (wr == 1) PG8_BAR; }
    }
    PG8_WAIT_V(0);
    if constexpr (!ALIGN_EPI) { if (wr == 0) PG8_BAR; }
    PG8_BAR;
    if constexpr (Epi::AFTER_DRAIN) { E.fused(acc, cur, wr, wc, fr, fq, lds, wid, lane); S.done(cur); }
#undef PG8_SA
#undef PG8_SB
#undef PG8_STAGE
#undef PG8_LDA
#undef PG8_LDB
#undef PG8_MMA
#undef PG8_WAIT_V
#undef PG8_WAIT_L
#undef PG8_BAR
#undef PG8_SCHED
}
}

struct Frame {
    LAS unsigned char* lds;
    int tid, lane, wave, G, bid;
    const float* in[N_IN];
    float* out;
    unsigned char* ws;
};

__device__ __forceinline__ void p0_transpose_item(const float* W, int K, int N, int ldn, bf16* WT, LAS float* scr, int item, int lane) {
    const int nblk = N / 32, kb = item / nblk, nb = item % nblk, k0 = 64 * kb, n0 = 32 * nb;
#pragma unroll 8
    for (int i = 0; i < 32; ++i) { const int kk = 2 * i + (lane >> 5); scr[kk * 33 + (lane & 31)] = W[(size_t)(k0 + kk) * ldn + n0 + (lane & 31)]; }
    LDS_WAIT(); asm volatile("" ::: "memory");
    const int c = lane & 7;
#pragma unroll
    for (int j = 0; j < 4; ++j) { const int n = (lane >> 3) + 8 * j; const LAS float* s = scr + (8 * c) * 33 + n;
        v4u o; o.x = pk2(s[0 * 33], s[1 * 33]); o.y = pk2(s[2 * 33], s[3 * 33]); o.z = pk2(s[4 * 33], s[5 * 33]); o.w = pk2(s[6 * 33], s[7 * 33]);
        *(GAS v4u*)(WT + (size_t)(n0 + n) * K + k0 + 8 * c) = o; }
    LDS_WAIT(); asm volatile("" ::: "memory");
}

__device__ __forceinline__ void p0_mod_item(Frame& F, int item) {
    LAS float* sc = (LAS float*)(F.lds);
    LAS float* red = (LAS float*)(F.lds + 16384);
    const float* c = F.in[I_C];
    for (int i = F.tid; i < 4096; i += 512) sc[i] = siluf_(c[i]);
    __syncthreads();
    const int l = item / 96, nb = item % 96, n = nb * 32 + (F.lane & 31), kh = F.lane >> 5;
    const float* W = F.in[I_ADAW] + (size_t)l * 1024 * 3072;
    float a0 = 0.f, a1 = 0.f, a2 = 0.f, a3 = 0.f;
    const int kbase = F.wave * 128;
#pragma unroll 8
    for (int i = 0; i < 64; ++i) { const int k = kbase + 2 * i + kh; const float w = W[(size_t)k * 3072 + n];
        a0 += sc[k] * w; a1 += sc[1024 + k] * w; a2 += sc[2048 + k] * w; a3 += sc[3072 + k] * w; }
    a0 += __shfl_xor(a0, 32); a1 += __shfl_xor(a1, 32); a2 += __shfl_xor(a2, 32); a3 += __shfl_xor(a3, 32);
    if (F.lane < 32) { red[(F.wave * 4 + 0) * 32 + F.lane] = a0; red[(F.wave * 4 + 1) * 32 + F.lane] = a1; red[(F.wave * 4 + 2) * 32 + F.lane] = a2; red[(F.wave * 4 + 3) * 32 + F.lane] = a3; }
    __syncthreads();
    if (F.tid < 128) { const int b = F.tid >> 5, nn = F.tid & 31; float s = 0.f;
#pragma unroll
        for (int w = 0; w < 8; ++w) s += red[(w * 4 + b) * 32 + nn];
        float* mod = (float*)(F.ws + WS_MOD);
        mod[(size_t)(l * 4 + b) * 3072 + nb * 32 + nn] = s + F.in[I_ADAB][l * 3072 + nb * 32 + nn]; }
    __syncthreads();
}

__device__ __forceinline__ void p0_s5_tables(Frame& F, int g) {
    LAS float* pw = (LAS float*)(F.lds);
    LAS float* bb = (LAS float*)(F.lds + 34816);
    LAS float* cc = (LAS float*)(F.lds + 34816 + 8192);
    const float dt = __expf(F.in[I_S5LOGDT][g]);
    for (int i = F.tid; i < 65 * 64; i += 512) { const int tau = i >> 6, p = i & 63;
        const float ar = F.in[I_S5ARE][g * 64 + p], ai = F.in[I_S5AIM][g * 64 + p];
        const float mag = expf((float)tau * (dt * ar)); float sn, cs; sincosf((float)tau * (dt * ai), &sn, &cs);
        pw[2 * i] = mag * cs; pw[2 * i + 1] = mag * sn; }
    for (int i = F.tid; i < 64 * 16; i += 512) { const int p = i >> 4, m = i & 15;
        const float ar = F.in[I_S5ARE][g * 64 + p], ai = F.in[I_S5AIM][g * 64 + p];
        const float mag = expf(dt * ar); float sn, cs; sincosf(dt * ai, &sn, &cs);
        const float abr = mag * cs, abi = mag * sn, den = ar * ar + ai * ai;
        const float fr = ((abr - 1.0f) * ar + abi * ai) / den, fi = (abi * ar - (abr - 1.0f) * ai) / den;
        const float br = F.in[I_S5BRE][(size_t)(g * 64 + p) * 16 + m], bi = F.in[I_S5BIM][(size_t)(g * 64 + p) * 16 + m];
        bb[2 * i] = fr * br - fi * bi; bb[2 * i + 1] = fr * bi + fi * br; }
    for (int i = F.tid; i < 16 * 64; i += 512) { cc[2 * i] = F.in[I_S5CRE][(size_t)g * 1024 + i]; cc[2 * i + 1] = F.in[I_S5CIM][(size_t)g * 1024 + i]; }
    __syncthreads();
    if (F.tid < 64) { float* lam = (float*)(F.ws + WS_LAM); lam[(g * 64 + F.tid) * 2] = pw[2 * (64 * 64 + F.tid)]; lam[(g * 64 + F.tid) * 2 + 1] = pw[2 * (64 * 64 + F.tid) + 1]; }
    { const int tau = F.tid >> 3, m0 = (F.tid & 7) * 2;
      float acc[2][16];
#pragma unroll
      for (int a = 0; a < 2; ++a)
#pragma unroll
          for (int b = 0; b < 16; ++b) acc[a][b] = 0.f;
      for (int p = 0; p < 64; ++p) { const float wr_ = pw[2 * (tau * 64 + p)], wi_ = pw[2 * (tau * 64 + p) + 1];
#pragma unroll
          for (int a = 0; a < 2; ++a) { const float cr = cc[2 * ((m0 + a) * 64 + p)], ci = cc[2 * ((m0 + a) * 64 + p) + 1];
              const float hr = cr * wr_ - ci * wi_, hi = cr * wi_ + ci * wr_;
#pragma unroll
              for (int b = 0; b < 16; ++b) acc[a][b] += hr * bb[2 * (p * 16 + b)] - hi * bb[2 * (p * 16 + b) + 1]; } }
      bf16* Kt = (bf16*)(F.ws + WS_KT) + (size_t)g * 64 * 256;
#pragma unroll
      for (int a = 0; a < 2; ++a) { unsigned* dst = (unsigned*)(Kt + (size_t)tau * 256 + (m0 + a) * 16);
#pragma unroll
          for (int b = 0; b < 8; ++b) dst[b] = pk2(acc[a][2 * b], acc[a][2 * b + 1]); } }
    { unsigned* Et = (unsigned*)((bf16*)(F.ws + WS_ET) + (size_t)g * 128 * 1024);
      for (int i = F.tid; i < 128 * 512; i += 512) { const int row = i >> 9, k = (i & 511) * 2, part = row >> 6, p = row & 63, t = k >> 4, m = k & 15;
          const float wr_ = pw[2 * ((63 - t) * 64 + p)], wi_ = pw[2 * ((63 - t) * 64 + p) + 1];
          const float b0r = bb[2 * (p * 16 + m)], b0i = bb[2 * (p * 16 + m) + 1], b1r = bb[2 * (p * 16 + m + 1)], b1i = bb[2 * (p * 16 + m + 1) + 1];
          const float v0 = part ? (wr_ * b0i + wi_ * b0r) : (wr_ * b0r - wi_ * b0i), v1 = part ? (wr_ * b1i + wi_ * b1r) : (wr_ * b1r - wi_ * b1i);
          Et[i] = pk2(v0, v1); } }
    { unsigned* Ft = (unsigned*)((bf16*)(F.ws + WS_FT) + (size_t)g * 1024 * 128);
      for (int i = F.tid; i < 1024 * 64; i += 512) { const int row = i >> 6, pk = (i & 63) * 2, ti = row >> 4, m = row & 15, part = pk >> 6, p = pk & 63;
          float v[2];
#pragma unroll
          for (int e = 0; e < 2; ++e) { const float wr_ = pw[2 * ((ti + 1) * 64 + p + e)], wi_ = pw[2 * ((ti + 1) * 64 + p + e) + 1];
              const float cr = cc[2 * (m * 64 + p + e)], ci = cc[2 * (m * 64 + p + e) + 1];
              v[e] = part ? -(cr * wi_ + ci * wr_) : (cr * wr_ - ci * wi_); }
          Ft[i] = pk2(v[0], v[1]); } }
    __syncthreads();
}

__device__ __forceinline__ void p0_prologue(Frame& F) {
    if (F.bid < 192) p0_mod_item(F, F.bid);
    else if (F.bid < 224) p0_s5_tables(F, F.bid - 192);
    __syncthreads();
    LAS float* scr = (LAS float*)(F.lds + F.wave * 16384);
    const int gw = F.bid * 8 + F.wave, NGW = F.G * 8;
    constexpr int I_A = 16 * 96, I_B = 16 * 32, I_C2 = 8 * 16, I_D = 16 * 128, I_E = 16 * 32;
    constexpr int NITEMS = I_A + I_B + I_C2 + I_D + I_E;
    for (int it = gw; it < NITEMS; it += NGW) {
        int r = it;
        if (r < I_A) { p0_transpose_item(F.in[I_ABWIN], 1024, 3072, 3072, (bf16*)(F.ws + WS_WIN0), scr, r, F.lane); continue; } r -= I_A;
        if (r < I_B) { p0_transpose_item(F.in[I_ABWOUT], 1024, 1024, 1024, (bf16*)(F.ws + WS_WOUT0), scr, r, F.lane); continue; } r -= I_B;
        if (r < I_C2) { p0_transpose_item(F.in[I_S5GLUW], 512, 512, 512, (bf16*)(F.ws + WS_WGLU), scr, r, F.lane); continue; } r -= I_C2;
        if (r < I_D) { p0_transpose_item(F.in[I_GDNWIN], 1024, 4096, C_IN, (bf16*)(F.ws + WS_WIN1), scr, r, F.lane); continue; } r -= I_D;
        p0_transpose_item(F.in[I_GDNWOUT], 1024, 1024, 1024, (bf16*)(F.ws + WS_WOUT1), scr, r, F.lane);
    }
    { bf16* we = (bf16*)(F.ws + WS_WEXT); const float* W = F.in[I_GDNWIN];
      for (int i = F.bid * 512 + F.tid; i < 16 * 1024; i += F.G * 512) { const int j = i >> 10, k = i & 1023; we[i] = (bf16)f2bf(W[(size_t)k * C_IN + 4096 + j]); } }
}

__device__ __forceinline__ void modnorm_row(const f32x4 (&v)[4], int lane, const float* g, const float* shift, const float* scale, bf16* orow) {
    float s = 0.f;
#pragma unroll
    for (int j = 0; j < 4; ++j) s += (v[j].x * v[j].x + v[j].y * v[j].y) + (v[j].z * v[j].z + v[j].w * v[j].w);
    const float r = rsqrtf(wave_sum(s) * (1.f / D) + EPS);
    GAS unsigned long long* o8 = (GAS unsigned long long*)orow + lane;
#pragma unroll
    for (int j = 0; j < 4; ++j) { const int c = 4 * lane + 256 * j;
        const f32x4 gg = *(const f32x4*)(g + c), sh = *(const f32x4*)(shift + c), sc = *(const f32x4*)(scale + c);
        const float h0 = v[j].x * r * gg.x * (1.f + sc.x) + sh.x, h1 = v[j].y * r * gg.y * (1.f + sc.y) + sh.y;
        const float h2 = v[j].z * r * gg.z * (1.f + sc.z) + sh.z, h3 = v[j].w * r * gg.w * (1.f + sc.w) + sh.w;
        o8[64 * j] = (unsigned long long)pk2(h0, h1) | ((unsigned long long)pk2(h2, h3) << 32); }
}
__device__ __forceinline__ void p1_modnorm(Frame& F, const float* x, int layer) {
    const int gw = F.bid * 8 + F.wave, NGW = F.G * 8;
    const float* mod = (const float*)(F.ws + WS_MOD) + (size_t)layer * 4 * 3072;
    bf16* H = (bf16*)(F.ws + WS_RA);
    for (int m = gw; m < M; m += NGW) { const int b = m >> 12;
        const GAS f32x4* xr = (const GAS f32x4*)(x + (size_t)m * D) + F.lane;
        f32x4 v[4];
#pragma unroll
        for (int j = 0; j < 4; ++j) v[j] = xr[64 * j];
        modnorm_row(v, F.lane, F.in[I_PREG] + layer * 1024, mod + b * 3072, mod + b * 3072 + 1024, H + (size_t)m * D); }
}
template <bool NEXT> __device__ __forceinline__ void p_residual(Frame& F, const float* xin, const bf16* y, float* xout, int layer) {
    const int gw = F.bid * 8 + F.wave, NGW = F.G * 8;
    const float* mod = (const float*)(F.ws + WS_MOD) + (size_t)layer * 4 * 3072;
    const float* modn = (const float*)(F.ws + WS_MOD) + (size_t)(layer + 1) * 4 * 3072;
    const float* pg = F.in[I_POSTG] + layer * 1024;
    bf16* H = (bf16*)(F.ws + WS_RA);
    for (int m = gw; m < M; m += NGW) { const int b = m >> 12;
        const GAS v2u* yr = (const GAS v2u*)(y + (size_t)m * D) + F.lane; const GAS f32x4* xr = (const GAS f32x4*)(xin + (size_t)m * D) + F.lane;
        f32x4 v[4], xv[4]; float s = 0.f;
#pragma unroll
        for (int j = 0; j < 4; ++j) { const v2u yw = yr[64 * j]; v[j] = (f32x4){bflo(yw.x), bfhi(yw.x), bflo(yw.y), bfhi(yw.y)}; xv[j] = xr[64 * j]; s += (v[j].x * v[j].x + v[j].y * v[j].y) + (v[j].z * v[j].z + v[j].w * v[j].w); }
        const float r = rsqrtf(wave_sum(s) * (1.f / D) + EPS);
        GAS f32x4* orow = (GAS f32x4*)(xout + (size_t)m * D) + F.lane;
#pragma unroll
        for (int j = 0; j < 4; ++j) { const int c = 4 * F.lane + 256 * j;
            const f32x4 gg = *(const f32x4*)(pg + c), gt = *(const f32x4*)(mod + b * 3072 + 2048 + c);
            xv[j].x += gt.x * (v[j].x * r * gg.x); xv[j].y += gt.y * (v[j].y * r * gg.y); xv[j].z += gt.z * (v[j].z * r * gg.z); xv[j].w += gt.w * (v[j].w * r * gg.w);
            orow[64 * j] = xv[j]; }
        if (NEXT) modnorm_row(xv, F.lane, F.in[I_PREG] + (layer + 1) * 1024, modn + b * 3072, modn + b * 3072 + 1024, H + (size_t)m * D);
    }
}

__constant__ unsigned char T5B[3][132] = {
{0,1,2,3,4,5,6,7,8,9,10,11,12,13,14,15,16,16,16,16,16,16,17,17,17,17,17,17,17,17,18,18,18,18,18,18,18,18,18,18,19,19,19,19,19,19,19,19,19,19,19,19,19,19,20,20,20,20,20,20,20,20,20,20,20,20,20,20,20,20,20,20,20,21,21,21,21,21,21,21,21,21,21,21,21,21,21,21,21,21,21,21,21,21,21,21,21,21,21,22,22,22,22,22,22,22,22,22,22,22,22,22,22,22,22,22,22,22,22,22,22,22,22,22,22,22,22,22,22,0,0,0},
{0,4,8,12,16,16,17,17,18,18,19,19,19,19,20,20,20,20,20,21,21,21,21,21,21,22,22,22,22,22,22,22,22,22,23,23,23,23,23,23,23,23,23,23,23,23,24,24,24,24,24,24,24,24,24,24,24,24,24,24,24,24,25,25,25,25,25,25,25,25,25,25,25,25,25,25,25,25,25,25,25,25,25,26,26,26,26,26,26,26,26,26,26,26,26,26,26,26,26,26,26,26,26,26,26,26,26,26,26,26,26,26,26,27,27,27,27,27,27,27,27,27,27,27,27,27,27,27,27,0,0,0},
{0,16,18,19,20,21,21,22,22,23,23,23,24,24,24,24,25,25,25,25,25,26,26,26,26,26,26,26,26,27,27,27,27,27,27,27,27,27,27,28,28,28,28,28,28,28,28,28,28,28,28,28,29,29,29,29,29,29,29,29,29,29,29,29,29,29,29,29,29,29,30,30,30,30,30,30,30,30,30,30,30,30,30,30,30,30,30,30,30,30,30,30,30,30,30,31,31,31,31,31,31,31,31,31,31,31,31,31,31,31,31,31,31,31,31,31,31,31,31,31,31,31,31,31,31,31,31,31,31,0,0,0}};

constexpr int ATT_VB_OFF = 2048, ATT_VB_WAVE = 4608;
struct AttLd { bf16x8 kf[2][2]; v4u vv[4]; };
__device__ __forceinline__ void att_step_geom(int st, int P0r, int& ci, int& sh, int& q0, int& qs, int& kbase) {
    ci = st >= 18 ? 2 : (st >= 12 ? 1 : 0); const int kt = st - (ci == 0 ? 0 : (ci == 1 ? 12 : 18));
    sh = 2 * ci; q0 = P0r >> sh; qs = 16 >> sh; kbase = q0 - 128 + 32 * kt;
}
__device__ __forceinline__ void att_load(AttLd& L, const bf16* zb, int st, int P0r, int h, int lane) {
    int ci, sh, q0, qs, kbase; att_step_geom(st, P0r, ci, sh, q0, qs, kbase);
    const int res = P0r & ((1 << sh) - 1), jq = lane & 15, g = lane >> 4;
#pragma unroll
    for (int tt = 0; tt < 2; ++tt) { int kidx = kbase + 16 * tt + jq; kidx = kidx < 0 ? 0 : kidx; const int kpos = (kidx << sh) + res;
        const bf16* kp = zb + (size_t)kpos * 3072 + 512 + h * 64 + 8 * g;
        L.kf[tt][0] = *(const bf16x8*)kp; L.kf[tt][1] = *(const bf16x8*)(kp + 32); }
#pragma unroll
    for (int i = 0; i < 4; ++i) { int kidx = kbase + (lane >> 3) + 8 * i; kidx = kidx < 0 ? 0 : kidx; const int kpos = (kidx << sh) + res;
        L.vv[i] = *(const v4u*)(zb + (size_t)kpos * 3072 + 1024 + h * 64 + 8 * (lane & 7)); }
}
__device__ __forceinline__ void attn_task(Frame& F, int task) {
    const int b = task >> 7, h = (task >> 4) & 7, span = task & 15, lane = F.lane;
    LAS float* biasT = (LAS float*)(F.lds);
    LAS unsigned char* vbuf = F.lds + ATT_VB_OFF + F.wave * ATT_VB_WAVE;
    __syncthreads();
    for (int i = F.tid; i < 3 * 132; i += 512) { const int ci = i / 132, rel = i % 132; biasT[i] = F.in[I_RELB][T5B[ci][rel] * 8 + h] * LOG2E; }
    __syncthreads();
    const bf16* zb = (const bf16*)(F.ws + WS_RZ) + (size_t)b * SEQ * 3072;
    bf16* O = (bf16*)(F.ws + WS_RA) + (size_t)b * SEQ * 1024;
    const int jq = lane & 15, g = lane >> 4;
    for (int it = 0; it < 2; ++it) {
        const int P0r = span * 256 + F.wave + 8 * it;
        const int qpos = P0r + 16 * jq;
        bf16x8 qf[2];
        { const bf16* qp = zb + (size_t)qpos * 3072 + h * 64 + 8 * g; qf[0] = *(const bf16x8*)qp; qf[1] = *(const bf16x8*)(qp + 32); }
        float mrun = -1e30f, lrun = 0.f; f32x4 o[4];
#pragma unroll
        for (int hb = 0; hb < 4; ++hb) o[hb] = (f32x4){0.f, 0.f, 0.f, 0.f};
        AttLd cur, nxt; att_load(cur, zb, 0, P0r, h, lane);
        for (int st = 0; st < 23; ++st) {
            if (st + 1 < 23) att_load(nxt, zb, st + 1, P0r, h, lane);
            int ci, sh, q0, qs, kbase; att_step_geom(st, P0r, ci, sh, q0, qs, kbase);
            const int qidx = q0 + qs * jq;
            f32x4 s0 = (f32x4){0.f, 0.f, 0.f, 0.f}, s1 = s0;
            s0 = MFMA16(cur.kf[0][0], qf[0], s0); s0 = MFMA16(cur.kf[0][1], qf[1], s0);
            s1 = MFMA16(cur.kf[1][0], qf[0], s1); s1 = MFMA16(cur.kf[1][1], qf[1], s1);
            float sv[8]; float tm = -1e30f;
#pragma unroll
            for (int e = 0; e < 8; ++e) { const int tt = e >> 2, rr = e & 3; const int kidx = kbase + 16 * tt + 4 * g + rr, rel = qidx - kidx;
                const bool ok = (rel >= 0) && (rel <= 128) && (kidx >= 0); const int relc = rel < 0 ? 0 : (rel > 128 ? 128 : rel);
                const float sc = (tt ? s1[rr] : s0[rr]) * (0.125f * LOG2E) + biasT[ci * 132 + relc];
                sv[e] = ok ? sc : -1e30f; tm = fmaxf(tm, sv[e]); }
            tm = fmaxf(tm, __shfl_xor(tm, 16)); tm = fmaxf(tm, __shfl_xor(tm, 32));
            const float mnew = fmaxf(mrun, tm), alpha = exp2f(mrun - mnew); mrun = mnew;
            float ps = 0.f;
#pragma unroll
            for (int e = 0; e < 8; ++e) { sv[e] = exp2f(sv[e] - mnew); ps += sv[e]; }
            lrun = lrun * alpha + ps;
#pragma unroll
            for (int hb = 0; hb < 4; ++hb) o[hb] = o[hb] * alpha;
            v4u pw; pw.x = pk2(sv[0], sv[1]); pw.y = pk2(sv[2], sv[3]); pw.z = pk2(sv[4], sv[5]); pw.w = pk2(sv[6], sv[7]);
            const bf16x8 pf = __builtin_bit_cast(bf16x8, pw);
            asm volatile("" ::: "memory");
#pragma unroll
            for (int i = 0; i < 4; ++i) *(LAS v4u*)(vbuf + ((lane >> 3) + 8 * i) * 144 + (lane & 7) * 16) = cur.vv[i];
            asm volatile("" ::: "memory");
            const lds_cptr va = (lds_cptr)vbuf + (4 * g + (jq >> 2)) * 144 + 8 * (jq & 3);
#pragma unroll
            for (int hb = 0; hb < 4; ++hb) { const s16x4 lo4 = vtr(va + 32 * hb), hi4 = vtr(va + 32 * hb + 16 * 144);
                const bf16x8 vf = (bf16x8){lo4[0], lo4[1], lo4[2], lo4[3], hi4[0], hi4[1], hi4[2], hi4[3]};
                o[hb] = MFMA16(vf, pf, o[hb]); }
            asm volatile("" ::: "memory");
            cur = nxt;
        }
        float lt = lrun + __shfl_xor(lrun, 16); lt += __shfl_xor(lt, 32);
        const float inv = 1.0f / lt;
#pragma unroll
        for (int hb = 0; hb < 4; ++hb) { const int col = h * 64 + 16 * hb + 4 * g;
            const v2u gw = *(const v2u*)(zb + (size_t)qpos * 3072 + 2048 + col);
            const float g0 = bflo(gw.x), g1 = bfhi(gw.x), g2 = bflo(gw.y), g3 = bfhi(gw.y);
            v2u w; w.x = pk2(o[hb][0] * inv * siluf_(g0), o[hb][1] * inv * siluf_(g1)); w.y = pk2(o[hb][2] * inv * siluf_(g2), o[hb][3] * inv * siluf_(g3));
            *(v2u*)(O + (size_t)qpos * 1024 + col) = w; }
    }
}

__device__ __forceinline__ void s5_pass1(Frame& F, int task) {
    const int g = task >> 4, ct = task & 15, n = F.lane & 15, gq = F.lane >> 4;
    const int cgi = ct * 16 + n, b = cgi >> 6, c = cgi & 63;
    const bf16* Et = (const bf16*)(F.ws + WS_ET) + (size_t)g * 128 * 1024 + (size_t)n * 1024 + 8 * gq;
    const bf16* ub = (const bf16*)(F.ws + WS_RZ) + (size_t)(b * SEQ + c * 64) * 3072 + 1536 + g * 16 + 8 * (gq & 1);
    f32x4 acc[8];
#pragma unroll
    for (int st = 0; st < 8; ++st) acc[st] = (f32x4){0.f, 0.f, 0.f, 0.f};
    for (int s = 0; s < 32; ++s) { const int tok = 2 * s + (gq >> 1);
        const bf16x8 bfr = *(const bf16x8*)(ub + (size_t)tok * 3072);
#pragma unroll
        for (int st = 0; st < 8; ++st) { const bf16x8 afr = *(const bf16x8*)(Et + (size_t)st * 16 * 1024 + 32 * s); acc[st] = MFMA16(afr, bfr, acc[st]); } }
    float* SC = (float*)(F.ws + WS_SC) + (size_t)((b * 32 + g) * 64 + c) * 128 + 4 * gq;
#pragma unroll
    for (int st = 0; st < 8; ++st) *(f32x4*)(SC + 16 * st) = acc[st];
}
__device__ __forceinline__ void s5_carry(Frame& F) {
    const int idx = F.bid * 512 + F.tid; if (idx >= NB * 32 * 64) return;
    const int b = idx >> 11, g = (idx >> 6) & 31, p = idx & 63;
    const float* lam = (const float*)(F.ws + WS_LAM); const float lr = lam[(g * 64 + p) * 2], li = lam[(g * 64 + p) * 2 + 1];
    const float* sc = (const float*)(F.ws + WS_SC) + (size_t)((b * 32 + g) * 64) * 128 + p;
    float* xs = (float*)(F.ws + WS_XS) + (size_t)((b * 32 + g) * 64) * 128 + p;
    float xr = 0.f, xi = 0.f;
#pragma unroll 8
    for (int c = 0; c < 64; ++c) { xs[c * 128] = xr; xs[c * 128 + 64] = xi; const float sr = sc[c * 128], si = sc[c * 128 + 64];
        const float nr = lr * xr - li * xi + sr, ni = lr * xi + li * xr + si; xr = nr; xi = ni; }
}
__device__ __forceinline__ void s5_pass2(Frame& F, int task) {
    const int g = task >> 3, ct = 2 * (task & 7) + (F.wave >> 2), q = F.wave & 3, n = F.lane & 15, gq = F.lane >> 4;
    __syncthreads();
    { const v4u* src = (const v4u*)((const bf16*)(F.ws + WS_KT) + (size_t)g * 64 * 256);
#pragma unroll
      for (int k = 0; k < 4; ++k) *(LAS v4u*)(F.lds + (F.tid + 512 * k) * 16) = src[F.tid + 512 * k]; }
    __syncthreads();
    const LAS unsigned char* KtL = F.lds + n * 32 + (gq & 1) * 16;
    const int cgi = ct * 16 + n, b = cgi >> 6, c = cgi & 63;
    const bf16* Ft = (const bf16*)(F.ws + WS_FT) + (size_t)g * 1024 * 128 + (size_t)n * 128 + 8 * gq;
    const float* XS = (const float*)(F.ws + WS_XS) + (size_t)((b * 32 + g) * 64 + c) * 128 + 8 * gq;
    const bf16* zrow = (const bf16*)(F.ws + WS_RZ) + (size_t)(b * SEQ + c * 64) * 3072 + 1536 + g * 16;
    f32x4 acc[16];
#pragma unroll
    for (int ii = 0; ii < 16; ++ii) acc[ii] = (f32x4){0.f, 0.f, 0.f, 0.f};
    for (int sp = 0; sp < 4; ++sp) { const f32x4 x0 = *(const f32x4*)(XS + 32 * sp), x1 = *(const f32x4*)(XS + 32 * sp + 4);
        v4u xw; xw.x = pk2(x0.x, x0.y); xw.y = pk2(x0.z, x0.w); xw.z = pk2(x1.x, x1.y); xw.w = pk2(x1.z, x1.w); const bf16x8 xf = __builtin_bit_cast(bf16x8, xw);
#pragma unroll
        for (int ii = 0; ii < 16; ++ii) { const int i = q + 4 * ii; const bf16x8 afr = *(const bf16x8*)(Ft + (size_t)i * 16 * 128 + 32 * sp); acc[ii] = MFMA16(afr, xf, acc[ii]); } }
    for (int s = 0; s < 32; ++s) { const int tok = 2 * s + (gq >> 1);
        const bf16x8 bfr = *(const bf16x8*)(zrow + (size_t)tok * 3072 + 8 * (gq & 1));
#pragma unroll
        for (int ii = 0; ii < 16; ++ii) { const int i = q + 4 * ii;
            if ((i >> 1) >= s) { const int tau = i - tok; const bf16x8 ld = *(const LAS bf16x8*)(KtL + (tau < 0 ? 0 : tau) * 512);
                const bf16x8 afr = tau < 0 ? (bf16x8){0, 0, 0, 0, 0, 0, 0, 0} : ld; acc[ii] = MFMA16(afr, bfr, acc[ii]); } } }
    const f32x4 dsk = *(const f32x4*)(F.in[I_S5D] + g * 16 + 4 * gq);
    bf16* YB = (bf16*)(F.ws + WS_YB) + (size_t)(b * SEQ + c * 64) * 512 + g * 16 + 4 * gq;
#pragma unroll
    for (int ii = 0; ii < 16; ++ii) { const int i = q + 4 * ii; const v2u uw = *(const v2u*)(zrow + (size_t)i * 3072 + 4 * gq);
        const float y0 = gelu_tanh(acc[ii][0] + dsk.x * bflo(uw.x)), y1 = gelu_tanh(acc[ii][1] + dsk.y * bfhi(uw.x));
        const float y2 = gelu_tanh(acc[ii][2] + dsk.z * bflo(uw.y)), y3 = gelu_tanh(acc[ii][3] + dsk.w * bfhi(uw.y));
        v2u w; w.x = pk2(y0, y1); w.y = pk2(y2, y3); *(v2u*)(YB + (size_t)i * 512) = w; }
}

__device__ __forceinline__ int perm_pos(int o) { return (o & ~31) | (((o >> 2) & 3) << 3) | (((o >> 4) & 1) << 2) | (o & 3); }

__device__ __forceinline__ void gdn_extras_item(Frame& F, int item) {
    if (F.wave >= 4) return;
    const int n = F.lane & 15, g = F.lane >> 4, row0 = item * 64 + F.wave * 16;
    const bf16* A = (const bf16*)(F.ws + WS_RA) + (size_t)(row0 + n) * 1024 + 8 * g;
    const bf16* B = (const bf16*)(F.ws + WS_WEXT) + (size_t)n * 1024 + 8 * g;
    f32x4 acc0 = (f32x4){0.f, 0.f, 0.f, 0.f}, acc1 = acc0;
#pragma unroll 4
    for (int s = 0; s < 32; s += 2) { acc0 = MFMA16(*(const bf16x8*)(A + 32 * s), *(const bf16x8*)(B + 32 * s), acc0); acc1 = MFMA16(*(const bf16x8*)(A + 32 * s + 32), *(const bf16x8*)(B + 32 * s + 32), acc1); }
    float* ex = (float*)(F.ws + WS_EXTRA);
#pragma unroll
    for (int e = 0; e < 4; ++e) ex[(size_t)(row0 + 4 * g + e) * 16 + n] = acc0[e] + acc1[e];
}

#ifndef PREPREP
#define PREPREP 0
#endif
constexpr int GP_QS = 0, GP_KS = 17408, GP_VS = 34816, GP_LS = 52224, GP_LSLOT = 8448, GP_SM = GP_LS + 8 * GP_LSLOT;
constexpr int GP_TW = 6144;
__host__ __device__ constexpr int lrow_off(int i) { return 4 * (2 * (i >> 2) * (i >> 2) + (i >> 2) + ((i & 3) == 0 ? 0 : ((i & 3) == 1 ? (i >> 2) : ((i & 3) == 2 ? 2 * (i >> 2) + 1 : 3 * (i >> 2) + 2)))); }
template <int I0, int I1> __device__ __forceinline__ void inv_rows(float (&t)[64], f32x4 (&cur)[4], const LAS float* Ls, int lane) {
#pragma unroll
    for (int i = I0; i < I1; ++i) {
        float a0 = (i == lane) ? 1.f : 0.f, a1 = 0.f;
#pragma unroll
        for (int jb = 0; jb < (i + 15) / 16; ++jb) {
            const bool same = (jb + 1) * 16 < i; const int ni = same ? i : i + 1, njb = same ? jb + 1 : 0;
            f32x4 nxt[4];
#pragma unroll
            for (int q = 0; q < 4; ++q) nxt[q] = cur[q];
            if (ni < 64) {
#pragma unroll
                for (int q = 0; q < 4; ++q) if (16 * njb + 4 * q < ni) nxt[q] = *(const LAS f32x4*)(Ls + lrow_off(ni) + 16 * njb + 4 * q); }
            asm volatile("" ::: "memory");
#pragma unroll
            for (int q = 0; q < 4; ++q) { const int j = 16 * jb + 4 * q;
                if (j + 0 < i) a0 -= cur[q].x * t[j + 0];
                if (j + 1 < i) a1 -= cur[q].y * t[j + 1];
                if (j + 2 < i) a0 -= cur[q].z * t[j + 2];
                if (j + 3 < i) a1 -= cur[q].w * t[j + 3]; }
#pragma unroll
            for (int q = 0; q < 4; ++q) cur[q] = nxt[q];
        }
        t[i] = a0 + a1; asm volatile("" : "+v"(t[i]) :: "memory"); }
}
__device__ __forceinline__ void gdn_prep_batch(Frame& F, int batch) {
    const int b = batch >> 6, c = batch & 63, tid = F.tid, lane = F.lane, wave = F.wave;
    LAS unsigned char* L = F.lds;
    LAS float* bet = (LAS float*)(L + GP_SM); LAS float* gcs = bet + 512;
    bf16* z1 = (bf16*)(F.ws + WS_RZ);
    const size_t row0 = (size_t)b * SEQ + c * 64;
    const int n = lane & 15, g = lane >> 4;
    __syncthreads();
    { const float* ex = (const float*)(F.ws + WS_EXTRA) + (row0 + lane) * 16; const int h = wave;
      const float braw = ex[h], araw = ex[8 + h] + F.in[I_GDNDTB][h];
      const float sp = araw > 20.f ? araw : log1pf(expf(araw));
      float v = -expf(F.in[I_GDNALOG][h]) * sp;
#pragma unroll
      for (int o = 1; o < 64; o <<= 1) { const float u = __shfl_up(v, o); if (lane >= o) v += u; }
      const float glast = __shfl(v, 63);
      bet[h * 64 + lane] = 1.0f / (1.0f + expf(-braw)); gcs[h * 64 + lane] = v;
      float* egc = (float*)(F.ws + WS_EGC); egc[(row0 + lane) * 8 + h] = expf(v); egc[(size_t)M * 8 + (row0 + lane) * 8 + h] = expf(glast - v);
      if (lane == 0) ((float*)(F.ws + WS_DEC))[(b * 8 + h) * 64 + c] = expf(glast); }
    for (int h = 0; h < 8; ++h) {
        if (h) __syncthreads();
        for (int rp1_ = 0; rp1_ < ((PREPREP & 1) ? 2 : 1); ++rp1_) {
          const int tb = wave; const bool zero_head = (tb == 0) && (c == 0);
          const bf16* halo = (const bf16*)(F.ws + WS_HALO) + (size_t)(b * 64 + c - 1) * 3 * 3072;
          unsigned raw[3][11]; f32x2 cwt[3][4];
#pragma unroll
          for (int w3 = 0; w3 < 3; ++w3) { const int ch = w3 * 1024 + h * 128 + 2 * lane;
#pragma unroll
              for (int j = 0; j < 4; ++j) cwt[w3][j] = *(const f32x2*)(F.in[I_GDNCONV] + j * 3072 + ch);
#pragma unroll
              for (int r = 0; r < 11; ++r) { const int tl = 8 * tb - 3 + r;
                  const bf16* src = (tl >= 0) ? z1 + (row0 + tl) * 4096 + ch : halo + (size_t)(tl + 3) * 3072 + ch;
                  raw[w3][r] = (tl < 0 && zero_head) ? 0u : *(const unsigned*)src; } }
          asm volatile("" ::: "memory");
#pragma unroll
          for (int w3 = 0; w3 < 3; ++w3) {
              float s0[8], s1[8];
#pragma unroll
              for (int k = 0; k < 8; ++k) { float a0 = 0.f, a1 = 0.f;
#pragma unroll
                  for (int j = 0; j < 4; ++j) { a0 += cwt[w3][j].x * bflo(raw[w3][k + j]); a1 += cwt[w3][j].y * bfhi(raw[w3][k + j]); }
                  s0[k] = siluf_(a0); s1[k] = siluf_(a1); }
#pragma unroll
              for (int k = 0; k < 8; ++k) { float r = 1.0f;
                  if (w3 < 2) { const float ss = wave_sum(s0[k] * s0[k] + s1[k] * s1[k]); r = rsqrtf(ss + EPS) * (w3 == 0 ? 0.08838834764831845f : 1.0f); }
                  *(LAS unsigned*)(L + w3 * 17408 + (8 * tb + k) * 272 + 4 * lane) = pk2(s0[k] * r, s1[k] * r); } } }
        __syncthreads();
        for (int rp2_ = 0; rp2_ < ((PREPREP & 4) ? 2 : 1); ++rp2_) {
        { LAS float* Ls = (LAS float*)(L + GP_LS + h * GP_LSLOT);
#pragma unroll
          for (int x = 0; x < 2; ++x) { const int tl = wave + 8 * x, it = tl >> 2, jt = tl & 3;
              const int i = 16 * it + n, j0 = 16 * jt + 4 * g;
              bf16* aq = z1 + (row0 + i) * 4096 + 1024 + h * 128 + ((jt >> 1) * 32 + 8 * g + 4 * (jt & 1));
              if (jt > it) { *(v2u*)aq = (v2u){0u, 0u}; continue; }
              f32x4 kk = (f32x4){0.f, 0.f, 0.f, 0.f}, qk = kk;
#pragma unroll
              for (int s = 0; s < 4; ++s) { const bf16x8 af = *(const LAS bf16x8*)(L + GP_KS + (16 * jt + n) * 272 + 64 * s + 16 * g);
                  const bf16x8 bk = *(const LAS bf16x8*)(L + GP_KS + (16 * it + n) * 272 + 64 * s + 16 * g);
                  const bf16x8 bq = *(const LAS bf16x8*)(L + GP_QS + (16 * it + n) * 272 + 64 * s + 16 * g);
                  kk = MFMA16(af, bk, kk); qk = MFMA16(af, bq, qk); }
              const float gi = gcs[h * 64 + i], bi = bet[h * 64 + i]; f32x4 lv; float av[4];
#pragma unroll
              for (int e = 0; e < 4; ++e) { const int j = j0 + e; const float dcy = __expf(gi - gcs[h * 64 + j]);
                  lv[e] = (j < i) ? bi * kk[e] * dcy : 0.f; av[e] = (j <= i) ? qk[e] * dcy : 0.f; }
              if (j0 < i) { const int a4 = i >> 2, b4 = i & 3; const int ro = 4 * (2 * a4 * a4 + a4 + (b4 == 0 ? 0 : (b4 == 1 ? a4 : (b4 == 2 ? 2 * a4 + 1 : 3 * a4 + 2))));
                  *(LAS f32x4*)(Ls + ro + j0) = lv; }
              v2u w; w.x = pk2(av[0], av[1]); w.y = pk2(av[2], av[3]); *(v2u*)aq = w; } }
        for (int q = tid; q < 1024; q += 512) { const int t = q >> 4, ck = q & 15, J = ck >> 2, gg = ck & 3;
            const v2u lo = *(const LAS v2u*)(L + GP_QS + t * 272 + (32 * J + 4 * gg) * 2), hi = *(const LAS v2u*)(L + GP_QS + t * 272 + (32 * J + 16 + 4 * gg) * 2);
            *(v4u*)(z1 + (row0 + t) * 4096 + h * 128 + 32 * J + 8 * gg) = (v4u){lo.x, lo.y, hi.x, hi.y}; }
        { bf16* kT = (bf16*)(F.ws + WS_KTP) + (size_t)((b * 8 + h) * 64 + c) * 8192;
#pragma unroll
          for (int x = 0; x < 4; ++x) { const int op = wave + 8 * x, isv = op >> 4, db = (op >> 1) & 7, J = op & 1;
              const lds_cptr a = (lds_cptr)(L + (isv ? GP_VS : GP_KS)) + (32 * J + 4 * g + (n >> 2)) * 272 + (16 * db + 4 * (n & 3)) * 2;
              const s16x4 lo4 = vtr(a), hi4 = vtr(a + 16 * 272);
              const v4u val = __builtin_bit_cast(v4u, (bf16x8){lo4[0], lo4[1], lo4[2], lo4[3], hi4[0], hi4[1], hi4[2], hi4[3]});
              const int d = 16 * db + n;
              if (isv) *(v4u*)(z1 + (row0 + (d >> 1)) * 4096 + 2048 + h * 128 + (d & 1) * 64 + 32 * J + 8 * g) = val;
              else *(v4u*)(kT + (size_t)d * 64 + 32 * J + 8 * g) = val; } }
        }
    }
    VM_WAIT();
    __syncthreads();
    for (int rp3_ = 0; rp3_ < ((PREPREP & 2) ? 2 : 1); ++rp3_) { const int h = wave;
      const LAS float* Ls = (const LAS float*)(L + GP_LS + h * GP_LSLOT);
      float t[64];
      t[0] = (__lane_id() == 0) ? 1.f : 0.f;
      f32x4 cur[4];
      cur[0] = *(const LAS f32x4*)(Ls + lrow_off(1)); cur[1] = cur[0]; cur[2] = cur[0]; cur[3] = cur[0];
      int lane_o = lane; asm volatile("" : "+v"(lane_o));
      inv_rows<1, 16>(t, cur, Ls, lane_o); inv_rows<16, 32>(t, cur, Ls, lane_o); inv_rows<32, 48>(t, cur, Ls, lane_o); inv_rows<48, 64>(t, cur, Ls, lane_o);
      LAS unsigned char* TB = L + wave * GP_TW;
      const float bc = bet[h * 64 + lane], bw = bc * __expf(gcs[h * 64 + lane]);
      const int sc = lane >> 5, kp = (((lane >> 2) & 3) << 3) | (((lane >> 4) & 1) << 2) | (lane & 3);
      bf16* uT = (bf16*)(F.ws + WS_RA) + (size_t)((b * 8 + h) * 64 + c) * 8192;
      const bf16* kT = (const bf16*)(F.ws + WS_KTP) + (size_t)((b * 8 + h) * 64 + c) * 8192;
#pragma unroll
      for (int pass = 0; pass < 2; ++pass) {
          const float scl = pass ? bw : bc;
#pragma unroll
          for (int i = 0; i < 64; ++i) { const int it = i >> 4; if (it >= 2 || sc == 0) { const int blk = (it < 2) ? it : (2 + 2 * (it - 2) + sc);
              *(LAS bf16*)(TB + blk * 1024 + (i & 15) * 64 + kp * 2) = (bf16)(pk2(t[i] * scl, 0.f) & 0xffffu); } }
          asm volatile("s_waitcnt lgkmcnt(0)" ::: "memory");
#pragma unroll 1
          for (int d = 0; d < 8; ++d) {
              bf16x8 opf[2];
#pragma unroll
              for (int s = 0; s < 2; ++s) { const int dd = 16 * d + n;
                  opf[s] = pass ? *(const bf16x8*)(kT + (size_t)dd * 64 + 32 * s + 8 * g)
                                : *(const bf16x8*)(z1 + (row0 + (dd >> 1)) * 4096 + 2048 + h * 128 + (dd & 1) * 64 + 32 * s + 8 * g); }
#pragma unroll
              for (int it = 0; it < 4; ++it) { f32x4 acc = (f32x4){0.f, 0.f, 0.f, 0.f};
#pragma unroll
                  for (int s = 0; s < 2; ++s) { if (s == 1 && it < 2) continue; const int blk = (it < 2) ? it : (2 + 2 * (it - 2) + s);
                      const bf16x8 tf = *(const LAS bf16x8*)(TB + blk * 1024 + n * 64 + g * 16);
                      acc = pass ? MFMA16(opf[s], tf, acc) : MFMA16(tf, opf[s], acc); }
                  if (pass == 0) { v2u uw; uw.x = pk2(acc[0], acc[1]); uw.y = pk2(acc[2], acc[3]); *(v2u*)(uT + (size_t)(16 * d + n) * 64 + 16 * it + 4 * g) = uw; }
                  else { v2u ww; ww.x = pk2(-acc[0], -acc[1]); ww.y = pk2(-acc[2], -acc[3]);
                      *(v2u*)((bf16*)(F.ws + WS_WNEG) + (row0 + 16 * it + n) * 1024 + h * 128 + ((d >> 1) * 32 + 8 * g + 4 * (d & 1))) = ww; } } }
          asm volatile("s_waitcnt lgkmcnt(0)" ::: "memory");
      } }
}

constexpr int GS_W = 0, GS_Q = 17408, GS_K = 34816, GS_A = 53248, GS_U = 62464, GS_E = 64768, GS_BUF = 65536;
struct ScanRole { const bf16* src; size_t cstep, delta; int dst, ddelta; };
__device__ __forceinline__ ScanRole gdn_scan_role(Frame& F, int b, int h) {
    const int lw = F.wave - 1, lane = F.lane; const size_t rowb = (size_t)b * SEQ;
    const bf16* z1 = (const bf16*)(F.ws + WS_RZ);
    ScanRole R;
    int cpr, tpb, tix, dstride; size_t sstride; const bf16* base;
    if (lw < 2)      { base = (const bf16*)(F.ws + WS_WNEG) + rowb * 1024 + h * 128; sstride = 1024; cpr = 16; tpb = 128; tix = lw * 64 + lane; R.dst = GS_W; dstride = 272; R.cstep = 64 * 1024; }
    else if (lw < 4) { base = z1 + rowb * 4096 + h * 128; sstride = 4096; cpr = 16; tpb = 128; tix = (lw - 2) * 64 + lane; R.dst = GS_Q; dstride = 272; R.cstep = 64 * 4096; }
    else if (lw < 6) { base = (const bf16*)(F.ws + WS_KTP) + (size_t)((b * 8 + h) * 64) * 8192; sstride = 64; cpr = 8; tpb = 128; tix = (lw - 4) * 64 + lane; R.dst = GS_K; dstride = 144; R.cstep = 8192; }
    else             { base = z1 + rowb * 4096 + 1024 + h * 128; sstride = 4096; cpr = 8; tpb = 64; tix = lane; R.dst = GS_A; dstride = 144; R.cstep = 64 * 4096; }
    const int r0 = tix / cpr, ck = tix % cpr;
    R.src = base + (size_t)r0 * sstride + ck * 8; R.delta = (size_t)(tpb / cpr) * sstride;
    R.dst += r0 * dstride + ck * 16; R.ddelta = (tpb / cpr) * dstride;
    return R;
}
struct ScanLd { v4u v[8]; v4u u[2]; float e[3]; };
__device__ __forceinline__ void gdn_scan_load(Frame& F, ScanLd& L, const ScanRole& R, int b, int h, int c, int dv0) {
    const bf16* s = R.src + (size_t)c * R.cstep;
#pragma unroll
    for (int k = 0; k < 8; ++k) L.v[k] = *(const v4u*)(s + (size_t)k * R.delta);
    if (F.wave == 7) { const int lane = F.lane; const size_t row0 = (size_t)b * SEQ + c * 64;
        const bf16* uT = (const bf16*)(F.ws + WS_RA) + (size_t)((b * 8 + h) * 64 + c) * 8192 + (size_t)dv0 * 64 + (lane >> 3) * 64 + (lane & 7) * 8;
        L.u[0] = *(const v4u*)uT; L.u[1] = *(const v4u*)(uT + 8 * 64);
        const float* egc = (const float*)(F.ws + WS_EGC); L.e[0] = egc[(row0 + lane) * 8 + h]; L.e[1] = egc[(size_t)M * 8 + (row0 + lane) * 8 + h];
        L.e[2] = ((const float*)(F.ws + WS_DEC))[(b * 8 + h) * 64 + c]; }
}
__device__ __forceinline__ void gdn_scan_store(Frame& F, const ScanLd& L, const ScanRole& R, LAS unsigned char* buf) {
#pragma unroll
    for (int k = 0; k < 8; ++k) *(LAS v4u*)(buf + R.dst + k * R.ddelta) = L.v[k];
    if (F.wave == 7) { const int lane = F.lane;
        *(LAS v4u*)(buf + GS_U + (lane >> 3) * 144 + (lane & 7) * 16) = L.u[0]; *(LAS v4u*)(buf + GS_U + (8 + (lane >> 3)) * 144 + (lane & 7) * 16) = L.u[1];
        ((LAS float*)(buf + GS_E))[lane] = L.e[0]; ((LAS float*)(buf + GS_E))[64 + lane] = L.e[1]; if (lane == 0) ((LAS float*)(buf + GS_E))[128] = L.e[2]; }
}
__device__ __forceinline__ void gdn_scan_task(Frame& F, int task) {
    const int b = task >> 6, h = (task >> 3) & 7, dv0 = (task & 7) * 16, lane = F.lane, n = lane & 15, g = lane >> 4;
    __syncthreads();
    ScanLd LD; ScanRole RL = gdn_scan_role(F, b, h);
    if (F.wave != 0) { gdn_scan_load(F, LD, RL, b, h, 0, dv0); gdn_scan_store(F, LD, RL, F.lds); }
    __syncthreads();
    f32x4 S[8];
#pragma unroll
    for (int d = 0; d < 8; ++d) S[d] = (f32x4){0.f, 0.f, 0.f, 0.f};
    bf16* z1 = (bf16*)(F.ws + WS_RZ);
    for (int c = 0; c < 64; ++c) {
        LAS unsigned char* buf = F.lds + (c & 1) * GS_BUF;
        if (F.wave != 0) { if (c + 1 < 64) { gdn_scan_load(F, LD, RL, b, h, c + 1, dv0); gdn_scan_store(F, LD, RL, F.lds + ((c + 1) & 1) * GS_BUF); } }
        else {
            const float dec = ((const LAS float*)(buf + GS_E))[128];
            bf16x8 Sb[4];
#pragma unroll
            for (int kq = 0; kq < 4; ++kq) { v4u w; w.x = pk2(S[2 * kq][0], S[2 * kq][1]); w.y = pk2(S[2 * kq][2], S[2 * kq][3]); w.z = pk2(S[2 * kq + 1][0], S[2 * kq + 1][1]); w.w = pk2(S[2 * kq + 1][2], S[2 * kq + 1][3]); Sb[kq] = __builtin_bit_cast(bf16x8, w); }
            f32x4 vn[4];
#pragma unroll
            for (int it = 0; it < 4; ++it) { const v2u uw = *(const LAS v2u*)(buf + GS_U + n * 144 + (16 * it + 4 * g) * 2);
                f32x4 a = (f32x4){bflo(uw.x), bfhi(uw.x), bflo(uw.y), bfhi(uw.y)};
#pragma unroll
                for (int kq = 0; kq < 4; ++kq) a = MFMA16(*(const LAS bf16x8*)(buf + GS_W + (16 * it + n) * 272 + 64 * kq + 16 * g), Sb[kq], a);
                vn[it] = a; }
            asm volatile("" ::: "memory");
            bf16x8 Vb[2], Vs[2];
            const LAS float* eg = (const LAS float*)(buf + GS_E);
#pragma unroll
            for (int J = 0; J < 2; ++J) { const f32x4 a = vn[2 * J], c2 = vn[2 * J + 1];
                v4u w; w.x = pk2(a[0], a[1]); w.y = pk2(a[2], a[3]); w.z = pk2(c2[0], c2[1]); w.w = pk2(c2[2], c2[3]); Vb[J] = __builtin_bit_cast(bf16x8, w);
                const f32x4 e0 = *(const LAS f32x4*)(eg + 64 + 32 * J + 4 * g), e1 = *(const LAS f32x4*)(eg + 64 + 32 * J + 16 + 4 * g);
                v4u s; s.x = pk2(a[0] * e0.x, a[1] * e0.y); s.y = pk2(a[2] * e0.z, a[3] * e0.w); s.z = pk2(c2[0] * e1.x, c2[1] * e1.y); s.w = pk2(c2[2] * e1.z, c2[3] * e1.w); Vs[J] = __builtin_bit_cast(bf16x8, s); }
#pragma unroll
            for (int it = 0; it < 4; ++it) { f32x4 qo = (f32x4){0.f, 0.f, 0.f, 0.f};
#pragma unroll
                for (int kq = 0; kq < 4; ++kq) qo = MFMA16(Sb[kq], *(const LAS bf16x8*)(buf + GS_Q + (16 * it + n) * 272 + 64 * kq + 16 * g), qo);
                qo = qo * eg[16 * it + n];
#pragma unroll
                for (int J = 0; J < 2; ++J) { if (J == 1 && it < 2) continue; qo = MFMA16(Vb[J], *(const LAS bf16x8*)(buf + GS_A + (16 * it + n) * 144 + 64 * J + 16 * g), qo); }
                v2u w; w.x = pk2(qo[0], qo[1]); w.y = pk2(qo[2], qo[3]);
                *(v2u*)(z1 + ((size_t)b * SEQ + c * 64 + 16 * it + n) * 4096 + 2048 + h * 128 + dv0 + 4 * g) = w; }
            asm volatile("" ::: "memory");
#pragma unroll
            for (int d = 0; d < 8; ++d) { f32x4 a = S[d] * dec;
#pragma unroll
                for (int J = 0; J < 2; ++J) a = MFMA16(*(const LAS bf16x8*)(buf + GS_K + (16 * d + n) * 144 + 64 * J + 16 * g), Vs[J], a);
                S[d] = a; }
        }
        __syncthreads();
    }
}

__device__ __forceinline__ void gdn_outnorm(Frame& F) {
    const int gw = F.bid * 8 + F.wave, NGW = F.G * 8, lane = F.lane;
    const bf16* z1 = (const bf16*)(F.ws + WS_RZ); bf16* og = (bf16*)(F.ws + WS_RA);
    const float* ng = F.in[I_GDNNORMG] + (lane & 7) * 16;
    for (int m = gw; m < M; m += NGW) {
        const v4u o0 = *(const v4u*)(z1 + (size_t)m * 4096 + 2048 + lane * 16), o1 = *(const v4u*)(z1 + (size_t)m * 4096 + 2048 + lane * 16 + 8);
        const v4u g0 = *(const v4u*)(z1 + (size_t)m * 4096 + 3072 + lane * 16), g1 = *(const v4u*)(z1 + (size_t)m * 4096 + 3072 + lane * 16 + 8);
        float ov[16], gv[16];
#pragma unroll
        for (int e = 0; e < 4; ++e) { ov[2 * e] = bflo(o0[e]); ov[2 * e + 1] = bfhi(o0[e]); ov[8 + 2 * e] = bflo(o1[e]); ov[8 + 2 * e + 1] = bfhi(o1[e]);
            gv[2 * e] = bflo(g0[e]); gv[2 * e + 1] = bfhi(g0[e]); gv[8 + 2 * e] = bflo(g1[e]); gv[8 + 2 * e + 1] = bfhi(g1[e]); }
        float s = 0.f;
#pragma unroll
        for (int e = 0; e < 16; ++e) s += ov[e] * ov[e];
        s += __shfl_xor(s, 1); s += __shfl_xor(s, 2); s += __shfl_xor(s, 4);
        const float r = rsqrtf(s * (1.f / 128.f) + EPS);
        float rv[16];
#pragma unroll
        for (int e = 0; e < 16; ++e) rv[e] = ov[e] * r * ng[e] * siluf_(gv[e]);
        v4u w0, w1; w0.x = pk2(rv[0], rv[1]); w0.y = pk2(rv[2], rv[3]); w0.z = pk2(rv[4], rv[5]); w0.w = pk2(rv[6], rv[7]);
        w1.x = pk2(rv[8], rv[9]); w1.y = pk2(rv[10], rv[11]); w1.z = pk2(rv[12], rv[13]); w1.w = pk2(rv[14], rv[15]);
        *(v4u*)(og + (size_t)m * 1024 + lane * 16) = w0; *(v4u*)(og + (size_t)m * 1024 + lane * 16 + 8) = w1; }
}

struct Args { const float* in[N_IN]; float* out; unsigned char* ws; int ph_lo, ph_hi, rep_mask, pad; };
#ifndef REP_MASK
#define REP_MASK 0
#endif
constexpr int NPH = 16;

__global__ void __launch_bounds__(512, 2) mega(Args args) {
    extern __shared__ __attribute__((aligned(16))) unsigned char lds[];
    cg::grid_group grid = cg::this_grid();
    Frame F;
    F.lds = (LAS unsigned char*)lds;
    F.tid = threadIdx.x; F.lane = F.tid & 63; F.wave = __builtin_amdgcn_readfirstlane(F.tid >> 6);
    F.G = gridDim.x; F.bid = blockIdx.x;
#pragma unroll
    for (int i = 0; i < N_IN; ++i) F.in[i] = args.in[i];
    F.out = args.out; F.ws = args.ws;
    const int lo = args.ph_lo, hi = args.ph_hi;
#ifdef PH_ONLY
#define IN(k) ((k) == PH_ONLY && lo <= (k) && (k) < hi)
#else
#define IN(k) (lo <= (k) && (k) < hi)
#endif
#define SEAM(k) do { if (IN(k) && IN((k) + 1)) xcd_barrier(bar); } while (0)
    volatile LAS unsigned* MISC = (volatile LAS unsigned*)(F.lds + LDS_BYTES - 256);
    if (F.tid < 64) MISC[F.tid] = 0u;
    __syncthreads();
    XcdBarrier bar = xcd_barrier_post((unsigned*)(F.ws + WS_CTL) + 4096, MISC + 8);
    if (lo < 0) grid.sync();
    const int gw = F.bid * 8 + F.wave, NGW = F.G * 8;
#ifdef TIME_PH
    unsigned long long tp0_ = 0, tp1_ = 0;
#define TSTAMP0(k) if ((k) == TIME_PH) tp0_ = __builtin_amdgcn_s_memrealtime();
#define TSTAMP1(k) if ((k) == TIME_PH) tp1_ = __builtin_amdgcn_s_memrealtime();
#else
#define TSTAMP0(k)
#define TSTAMP1(k)
#endif
#define RUNPH(k, ...) TSTAMP0(k) if (IN(k)) { { __VA_ARGS__ } if ((REP_MASK >> (k)) & 1) { xcd_barrier(bar); { __VA_ARGS__ } } } SEAM(k); TSTAMP1(k)

    RUNPH(0,  p0_prologue(F); )
    RUNPH(1,  p1_modnorm(F, F.in[I_X], 0); )
    RUNPH(2,  pg8::Gemm g{(const bf16*)(F.ws + WS_RA), (const bf16*)(F.ws + WS_WIN0), M, AB_IN, D}; pg8::StaticOrder S; S.init(M, AB_IN, F.G, F.bid);
        pg8::EpiBf16<false> E{(bf16*)(F.ws + WS_RZ), AB_IN, nullptr, 0};
        pg8::gemm_phase<pg8::EpiBf16<false>, pg8::StaticOrder, true, true>(F.lds, g, S, E); )
    RUNPH(3,  if (F.wave < 2) { for (int t = F.bid * 2 + F.wave; t < 512; t += F.G * 2) s5_pass1(F, t); }
        for (int t = F.bid; t < 512; t += F.G) attn_task(F, t); )
    RUNPH(4,  s5_carry(F); )
    RUNPH(5,  for (int t = F.bid; t < 256; t += F.G) s5_pass2(F, t); )
    RUNPH(6,  pg8::Gemm g{(const bf16*)(F.ws + WS_YB), (const bf16*)(F.ws + WS_WGLU), M, 512, 512}; pg8::StaticOrder S; S.init(M, 512, F.G, F.bid);
        pg8::EpiGlu E{(const bf16*)(F.ws + WS_YB), (const bf16*)(F.ws + WS_RZ), F.in[I_S5GLUB], (bf16*)(F.ws + WS_RA)};
        pg8::gemm_phase<pg8::EpiGlu, pg8::StaticOrder, true, true>(F.lds, g, S, E); )
    RUNPH(7,  pg8::Gemm g{(const bf16*)(F.ws + WS_RA), (const bf16*)(F.ws + WS_WOUT0), M, D, D}; pg8::StaticOrder S; S.init(M, D, F.G, F.bid);
        pg8::EpiBf16<false> E{(bf16*)(F.ws + WS_RZ), D, nullptr, 0};
        pg8::gemm_phase<pg8::EpiBf16<false>, pg8::StaticOrder, true, true>(F.lds, g, S, E); )
    RUNPH(8,  p_residual<true>(F, F.in[I_X], (const bf16*)(F.ws + WS_RZ), F.out, 0); )
    RUNPH(9,  for (int t = F.bid; t < 256; t += F.G) gdn_extras_item(F, t);
        pg8::Gemm g{(const bf16*)(F.ws + WS_RA), (const bf16*)(F.ws + WS_WIN1), M, 4096, D}; pg8::StaticOrder S; S.init(M, 4096, F.G, F.bid);
        pg8::EpiBf16<true> E{(bf16*)(F.ws + WS_RZ), 4096, (bf16*)(F.ws + WS_HALO), 3072};
        pg8::gemm_phase<pg8::EpiBf16<true>, pg8::StaticOrder, true, true>(F.lds, g, S, E); )
    RUNPH(10,  for (int t = F.bid; t < 256; t += F.G) gdn_prep_batch(F, t); )
    RUNPH(11,  for (int t = F.bid; t < 256; t += F.G) { const int tt = (F.G == 256) ? (((t & 7) * 4 + (t >> 6)) * 8 + ((t >> 3) & 7)) : t; gdn_scan_task(F, tt); }     )
    RUNPH(12,  gdn_outnorm(F); )
    RUNPH(13,  pg8::Gemm g{(const bf16*)(F.ws + WS_RA), (const bf16*)(F.ws + WS_WOUT1), M, D, D}; pg8::StaticOrder S; S.init(M, D, F.G, F.bid);
        pg8::EpiBf16<false> E{(bf16*)(F.ws + WS_RZ), D, nullptr, 0};
        pg8::gemm_phase<pg8::EpiBf16<false>, pg8::StaticOrder, true, true>(F.lds, g, S, E); )
    RUNPH(14,  p_residual<false>(F, F.out, (const bf16*)(F.ws + WS_RZ), F.out, 1); )
#ifdef TIME_PH
    if (F.bid == 0) { __syncthreads(); if (F.tid == 0) F.out[0] = (float)(tp1_ - tp0_) * 0.01f; }
#endif
#undef IN
#undef SEAM
}

extern "C" void kernel_launch(void* const* d_in, const int* in_sizes, int n_in, void* d_out, int out_size, void* d_ws, size_t ws_size, hipStream_t stream) {
    static int grid = 0;
    if (grid == 0) {
        if (n_in != N_IN || out_size != M * D || ws_size < WS_END) { fprintf(stderr, "kernel_launch: unexpected shapes n_in %d out %d ws %zu\n", n_in, out_size, ws_size); grid = -1; return; }
        int dev = 0, cus = 0, per_cu = 0;
        if (hipGetDevice(&dev) != hipSuccess || hipDeviceGetAttribute(&cus, hipDeviceAttributeMultiprocessorCount, dev) != hipSuccess) { grid = -1; return; }
        if (hipFuncSetAttribute((const void*)mega, hipFuncAttributeMaxDynamicSharedMemorySize, LDS_BYTES) != hipSuccess) { fprintf(stderr, "hipFuncSetAttribute failed\n"); grid = -1; return; }
        if (hipOccupancyMaxActiveBlocksPerMultiprocessor(&per_cu, (const void*)mega, 512, LDS_BYTES) != hipSuccess || per_cu < 1) { fprintf(stderr, "occupancy query: %d\n", per_cu); per_cu = 1; }
        (void)hipGetLastError();
        grid = cus;
        fprintf(stderr, "kernel_launch: grid %d (per_cu %d)\n", grid, per_cu);
    }
    if (grid < 0) return;
    if (hipMemsetAsync((char*)d_ws + WS_CTL, 0, 65536, stream) != hipSuccess) { fprintf(stderr, "memset failed\n"); return; }
    Args a{};
    for (int i = 0; i < N_IN; ++i) a.in[i] = (const float*)d_in[i];
    a.out = (float*)d_out; a.ws = (unsigned char*)d_ws;
#ifdef MULTI_LAUNCH
    for (int p = 0; p < NPH; ++p) { a.ph_lo = p; a.ph_hi = p + 1; void* kargs[] = {&a};
        hipError_t e = hipLaunchCooperativeKernel((const void*)mega, dim3(grid), dim3(512), kargs, LDS_BYTES, stream);
        if (e != hipSuccess) { fprintf(stderr, "launch %d failed: %s\n", p, hipGetErrorString(e)); break; } }
#else
    a.ph_lo = 0; a.ph_hi = NPH; a.rep_mask = REP_MASK; void* kargs[] = {&a};
    hipError_t e = hipLaunchCooperativeKernel((const void*)mega, dim3(grid), dim3(512), kargs, LDS_BYTES, stream);
    if (e != hipSuccess) fprintf(stderr, "cooperative launch failed: %s (grid %d)\n", hipGetErrorString(e), grid);
#endif
}
```

```cpp
#define REP_MASK 0
#define PREPREP 0
#include <hip/hip_runtime.h>
#include <hip/hip_cooperative_groups.h>
#include <cstdio>
#include <cstdint>
namespace cg = cooperative_groups;

constexpr int NB = 4, SEQ = 4096, M = NB * SEQ, D = 1024;
constexpr int AB_IN = 3072, C_IN = 4112;
constexpr float EPS = 1e-6f;
constexpr float LOG2E = 1.4426950408889634f;

enum { I_X = 0, I_C, I_ADAW, I_ADAB, I_PREG, I_POSTG, I_RELB, I_ABWIN, I_ABWOUT, I_S5ARE, I_S5AIM, I_S5LOGDT, I_S5BRE, I_S5BIM, I_S5CRE, I_S5CIM,
       I_S5D, I_S5GLUW, I_S5GLUB, I_GDNWIN, I_GDNCONV, I_GDNALOG, I_GDNDTB, I_GDNNORMG, I_GDNWOUT, N_IN };

constexpr size_t MiB = 1u << 20;
constexpr size_t WS_CTL = 0;
constexpr size_t WS_MOD = 1 * MiB;
constexpr size_t WS_LAM = WS_MOD + 128 * 1024;
constexpr size_t WS_DEC = WS_MOD + 256 * 1024;
constexpr size_t WS_WIN0 = 2 * MiB, WS_WOUT0 = 8 * MiB, WS_WGLU = 10 * MiB, WS_WIN1 = 11 * MiB, WS_WEXT = 19 * MiB, WS_WOUT1 = 20 * MiB;
constexpr size_t WS_EXTRA = 22 * MiB;
constexpr size_t WS_EGC = 23 * MiB;
constexpr size_t WS_RA = 24 * MiB;
constexpr size_t WS_RZ = 56 * MiB;
constexpr size_t WS_RB = 184 * MiB;
constexpr size_t WS_SC = WS_RB, WS_XS = WS_RB + 4 * MiB, WS_YB = WS_RB + 8 * MiB, WS_KT = WS_RB + 24 * MiB, WS_ET = WS_RB + 25 * MiB, WS_FT = WS_RB + 33 * MiB;
constexpr size_t WS_SCQ = WS_RB + 44 * MiB;
constexpr size_t WS_WNEG = WS_RB, WS_KTP = WS_RB + 32 * MiB, WS_HALO = WS_RB + 64 * MiB;
constexpr size_t WS_END = 256 * MiB;

constexpr int LDS_BYTES = 147456;

#define GAS __attribute__((address_space(1)))
#define LAS __attribute__((address_space(3)))
typedef unsigned short bf16;
typedef unsigned v4u __attribute__((ext_vector_type(4)));
typedef unsigned v2u __attribute__((ext_vector_type(2)));
typedef float f32x4 __attribute__((ext_vector_type(4)));
typedef float f32x2 __attribute__((ext_vector_type(2)));
typedef short bf16x8 __attribute__((ext_vector_type(8)));
typedef short s16x4 __attribute__((ext_vector_type(4)));
#define LDS_WAIT() asm volatile("s_waitcnt lgkmcnt(0)" ::: "memory")
#define VM_WAIT() asm volatile("s_waitcnt vmcnt(0)" ::: "memory")
__device__ __forceinline__ unsigned f2bf(float f) { unsigned u = __builtin_bit_cast(unsigned, f); return (u + 0x7fffu + ((u >> 16) & 1u)) >> 16; }
typedef __bf16 bf16x2_t __attribute__((ext_vector_type(2)));
__device__ __forceinline__ unsigned pk2(float lo, float hi) { f32x2 v = {lo, hi}; bf16x2_t b = __builtin_convertvector(v, bf16x2_t); return __builtin_bit_cast(unsigned, b); }
__device__ __forceinline__ float bflo(unsigned w) { return __builtin_bit_cast(float, w << 16); }
__device__ __forceinline__ float bfhi(unsigned w) { return __builtin_bit_cast(float, w & 0xffff0000u); }
__device__ __forceinline__ float bf2f(bf16 b) { return __builtin_bit_cast(float, ((unsigned)b) << 16); }
__device__ __forceinline__ float wave_sum(float v) {
#pragma unroll
    for (int o = 1; o < 64; o <<= 1) v += __shfl_xor(v, o);
    return v;
}
__device__ __forceinline__ float sigmoidf_(float x) { return 1.0f / (1.0f + __expf(-x)); }
__device__ __forceinline__ float siluf_(float x) { return x / (1.0f + __expf(-x)); }
__device__ __forceinline__ float gelu_tanh(float x) { const float u = 0.7978845608028654f * (x + 0.044715f * x * x * x); const float e = __expf(2.0f * u); const float t = 1.0f - 2.0f / (e + 1.0f); return 0.5f * x * (1.0f + t); }
typedef GAS unsigned gu32;
#define RLX_AGENT __ATOMIC_RELAXED, __HIP_MEMORY_SCOPE_AGENT
typedef __attribute__((address_space(3))) const char* lds_cptr;
typedef short v4i16_t __attribute__((ext_vector_type(4)));
__device__ __forceinline__ s16x4 vtr(lds_cptr p) { return __builtin_bit_cast(s16x4, __builtin_amdgcn_ds_read_tr16_b64_v4i16((__attribute__((address_space(3))) v4i16_t*)p)); }
#define MFMA16(a, b, c) __builtin_amdgcn_mfma_f32_16x16x32_bf16((a), (b), (c), 0, 0, 0)

#define XB_TMO      128
#define XB_XCNT(j)  (256  + 64 * (j))
#define XB_XSUB(j)  (1280 + 64 * (j))
#define XB_XGEN(j)  (2304 + 64 * (j))
#define XB_TOP      3328
#define XB_TOPGEN   3392
#define XCD_BAR_WORDS 3456
#define XB_SPIN_CAP (1u << 18)

__device__ __forceinline__ unsigned xb_ld(unsigned* p)              { return __hip_atomic_load(p, __ATOMIC_RELAXED, __HIP_MEMORY_SCOPE_AGENT); }
__device__ __forceinline__ unsigned xb_add(unsigned* p, unsigned v) { return __hip_atomic_fetch_add(p, v, __ATOMIC_RELAXED, __HIP_MEMORY_SCOPE_AGENT); }
__device__ __forceinline__ unsigned xb_xcc_id() { return (unsigned)__builtin_amdgcn_s_getreg((3 << 11) | 20) & 0xFu; }
#define XB_SPIN(cond, bar) do { unsigned _sp = 0; while (cond) { __builtin_amdgcn_s_sleep(1); \
    if ((++_sp & 255u) == 0u) { if (xb_ld(&(bar)[XB_TMO])) break; if (_sp > XB_SPIN_CAP) { atomicAdd(&(bar)[XB_TMO], 1u); break; } } } } while (0)

struct XcdBarrier {
    unsigned* bar; unsigned x;
    volatile LAS unsigned* st;
};

__device__ __forceinline__ XcdBarrier xcd_barrier_post(unsigned* bar, volatile LAS unsigned* st) {
    XcdBarrier b; b.bar = bar; b.x = xb_xcc_id(); b.st = st;
    if (threadIdx.x == 0) (void)xb_add(&bar[XB_XCNT(b.x)], 1u);
    return b;
}
__device__ __forceinline__ void xcd_barrier_complete(unsigned* bar, unsigned x, unsigned& nloc, unsigned& nx) {
    const unsigned G = gridDim.x * gridDim.y * gridDim.z;
    unsigned sum, cnt, mine, sp = 0u;
    for (;;) {
        sum = 0u; cnt = 0u; mine = 0u;
#pragma unroll
        for (unsigned j = 0; j < 16; ++j) { const unsigned c = xb_ld(&bar[XB_XCNT(j)]); sum += c; cnt += (c > 0u) ? 1u : 0u; mine = (j == x) ? c : mine; }
        if (sum == G) break;
        __builtin_amdgcn_s_sleep(1);
        if ((++sp & 255u) == 0u) { if (xb_ld(&bar[XB_TMO])) break; if (sp > XB_SPIN_CAP) { atomicAdd(&bar[XB_TMO], 1u); break; } }
    }
    nloc = mine > 0u ? mine : 1u; nx = cnt > 0u ? cnt : 1u;
}

__device__ __forceinline__ void xcd_barrier(const XcdBarrier& b) {
    asm volatile("s_waitcnt vmcnt(0)" ::: "memory");
    __syncthreads();
    if (threadIdx.x == 0) {
        unsigned* bar = b.bar;
        __builtin_amdgcn_s_waitcnt(0);
        unsigned nloc = b.st[0], nx = b.st[1];
        if (nloc == 0u) { xcd_barrier_complete(bar, b.x, nloc, nx); b.st[0] = nloc; b.st[1] = nx; }
        const unsigned old = xb_add(&bar[XB_XSUB(b.x)], 1u);
        const unsigned gen = old / nloc;
        if (old + 1u == (gen + 1u) * nloc) {
            __builtin_amdgcn_fence(__ATOMIC_RELEASE, "agent");
            asm volatile("s_waitcnt vmcnt(0)" ::: "memory");
            const unsigned og = xb_add(&bar[XB_TOP], 1u);
            const unsigned tg = og / nx;
            if (og + 1u == (tg + 1u) * nx) xb_add(&bar[XB_TOPGEN], 1u);
            else XB_SPIN(xb_ld(&bar[XB_TOPGEN]) == tg, bar);
            __builtin_amdgcn_fence(__ATOMIC_ACQUIRE, "agent");
            xb_add(&bar[XB_XGEN(b.x)], 1u);
            asm volatile("s_waitcnt vmcnt(0)" ::: "memory");
        } else {
            XB_SPIN(xb_ld(&bar[XB_XGEN(b.x)]) == gen, bar);
            __builtin_amdgcn_fence(__ATOMIC_ACQUIRE, "agent");
            asm volatile("s_waitcnt vmcnt(0)" ::: "memory");
        }
    }
    __syncthreads();
}
namespace pg8 {
#define PG8_LAS __attribute__((address_space(3)))
typedef unsigned short bf16_t;
typedef short bf16x8 __attribute__((ext_vector_type(8)));
typedef float f32x4 __attribute__((ext_vector_type(4)));
typedef unsigned u32x4 __attribute__((ext_vector_type(4)));
constexpr int BM = 256, BK = 64, HALF = 128, HTB = HALF * BK * 2  , STAGE_BYTES = 8 * HTB, NXCD = 8, WGM = 8;

__host__ __device__ __forceinline__ int lds_byte(int r, int c) { const int st = (r >> 4) * 2 + (c >> 5), rr = r & 15, cc = c & 31, ob = rr * 64 + cc * 2; return st * 1024 + (ob ^ (((ob >> 9) & 1) << 5)); }
__host__ __device__ __forceinline__ void stage_rc(int b, int& R, int& C) { const int st = b / 1024, sb = b % 1024, swz = sb ^ (((sb >> 9) & 1) << 5); R = (st >> 1) * 16 + swz / 64; C = (st & 1) * 32 + (swz % 64) / 2; }
__host__ __device__ __forceinline__ int perm32(int rho) { const int n = rho >> 4, i = rho & 15; return 8 * (i >> 2) + 4 * n + (i & 3); }

struct Unit { int pm, pn; };
struct Gemm { const bf16_t* A; const bf16_t* Bt; int M, N, K; };

struct StaticOrder {
    int nM, nN, nwg, G, c;
    __host__ __device__ void init(int M, int N, int G_, int c_) { nM = M / BM; nN = N / BM; nwg = nM * nN; G = G_; c = c_; }
    __host__ __device__ bool next(int i, Unit& u) const {
        const long L = (long)i * G + c; if (L >= nwg) return false;
        int wgid = (int)L; { const int q = nwg / NXCD, r = nwg % NXCD, xcd = wgid % NXCD, off = wgid / NXCD; wgid = (xcd < r ? xcd * (q + 1) : r * (q + 1) + (xcd - r) * q) + off; }
        const int nig = WGM * nN, gid = wgid / nig, fm = gid * WGM, gsz = (nM - fm) < WGM ? (nM - fm) : WGM;
        u.pm = fm + ((wgid % nig) % gsz); u.pn = (wgid % nig) / gsz; return true;
    }
    __device__ __forceinline__ void a_ready(const Unit&) const {}
    __device__ __forceinline__ void done(const Unit&) const {}
};


__device__ __forceinline__ unsigned cvt_pk_bf16(float lo, float hi) { unsigned r; asm volatile("v_cvt_pk_bf16_f32 %0, %1, %2" : "=v"(r) : "v"(lo), "v"(hi)); return r; }

template <bool HALO> struct EpiBf16 {
    static constexpr bool PERM = true, AFTER_DRAIN = false;
    bf16_t* O; int ldc; bf16_t* halo; int halo_cols;
    __device__ __forceinline__ void operator()(const f32x4 (&acc)[2][2][4][2], const Unit& u, int wr, int wc, int fr, int fq) const {
        const int row0 = u.pm * BM + wr * 64 + fr; const int col0 = u.pn * BM + wc * 32 + 8 * fq;
#pragma unroll
        for (int ai = 0; ai < 2; ++ai)
#pragma unroll
            for (int m = 0; m < 4; ++m) { const int row = row0 + ai * HALF + m * 16; bf16_t* rowp = O + (size_t)row * ldc + col0;
#pragma unroll
                for (int bj = 0; bj < 2; ++bj) { const f32x4 v0 = acc[ai][bj][m][0], v1 = acc[ai][bj][m][1];
                    u32x4 w; w.x = cvt_pk_bf16(v0[0], v0[1]); w.y = cvt_pk_bf16(v0[2], v0[3]); w.z = cvt_pk_bf16(v1[0], v1[1]); w.w = cvt_pk_bf16(v1[2], v1[3]);
                    *(u32x4*)(rowp + bj * HALF) = w;
                    if (HALO) { if (m == 3 && fr >= 13 && (col0 + bj * HALF) < halo_cols) *(u32x4*)(halo + ((size_t)(row >> 6) * 3 + (fr - 13)) * halo_cols + col0 + bj * HALF) = w; }
                } }
    }
};
struct EpiF32 {
    static constexpr bool PERM = false, AFTER_DRAIN = false;
    float* C; int ldc;
    __device__ __forceinline__ void operator()(const f32x4 (&acc)[2][2][4][2], const Unit& u, int wr, int wc, int fr, int fq) const {
        const int row0 = u.pm * BM + wr * 64 + fr, col0 = u.pn * BM + wc * 32 + 4 * fq;
#pragma unroll
        for (int ai = 0; ai < 2; ++ai)
#pragma unroll
            for (int m = 0; m < 4; ++m) { float* rowp = C + (size_t)(row0 + ai * HALF + m * 16) * ldc + col0;
#pragma unroll
                for (int bj = 0; bj < 2; ++bj)
#pragma unroll
                    for (int n = 0; n < 2; ++n) *(f32x4*)(rowp + bj * HALF + n * 16) = acc[ai][bj][m][n]; }
    }
};
struct EpiGlu {
    static constexpr bool PERM = true, AFTER_DRAIN = false;
    const bf16_t* yb; const bf16_t* z0; const float* glu_b; bf16_t* O;
    __device__ __forceinline__ void operator()(const f32x4 (&acc)[2][2][4][2], const Unit& u, int wr, int wc, int fr, int fq) const {
        const int row0 = u.pm * BM + wr * 64 + fr; const int col0 = u.pn * BM + wc * 32 + 8 * fq;
#pragma unroll
        for (int bj = 0; bj < 2; ++bj) { const int c = col0 + bj * HALF;
            const f32x4 b0 = *(const f32x4*)(glu_b + c), b1 = *(const f32x4*)(glu_b + c + 4);
#pragma unroll
            for (int ai = 0; ai < 2; ++ai)
#pragma unroll
                for (int m = 0; m < 4; ++m) { const size_t row = (size_t)(row0 + ai * HALF + m * 16);
                    const u32x4 yw = *(const u32x4*)(yb + row * 512 + c); const u32x4 gw = *(const u32x4*)(z0 + row * 3072 + 2560 + c);
                    const f32x4 v0 = acc[ai][bj][m][0] + b0, v1 = acc[ai][bj][m][1] + b1;
                    float r[8];
#pragma unroll
                    for (int j = 0; j < 4; ++j) { const unsigned ywj = yw[j], gwj = gw[j];
                        const float ylo = __builtin_bit_cast(float, ywj << 16), yhi = __builtin_bit_cast(float, ywj & 0xffff0000u);
                        const float glo = __builtin_bit_cast(float, gwj << 16), ghi = __builtin_bit_cast(float, gwj & 0xffff0000u);
                        const float a0 = (j < 2) ? v0[2 * j] : v1[2 * j - 4], a1 = (j < 2) ? v0[2 * j + 1] : v1[2 * j - 3];
                        r[2 * j] = ylo / (1.0f + __expf(-a0)) * (glo / (1.0f + __expf(-glo)));
                        r[2 * j + 1] = yhi / (1.0f + __expf(-a1)) * (ghi / (1.0f + __expf(-ghi))); }
                    u32x4 w; w.x = cvt_pk_bf16(r[0], r[1]); w.y = cvt_pk_bf16(r[2], r[3]); w.z = cvt_pk_bf16(r[4], r[5]); w.w = cvt_pk_bf16(r[6], r[7]);
                    *(u32x4*)(O + row * 1024 + 512 + c) = w; } }
    }
};
template <class Epi, class Sched, bool ALIGN_EPI = false, bool SP2 = false>
__device__ __forceinline__ void gemm_phase(PG8_LAS unsigned char* lds, const Gemm g, const Sched& S, const Epi& E) {
    const int tid = threadIdx.x, wid = __builtin_amdgcn_readfirstlane(tid >> 6), lane = tid & 63, wr = wid >> 2, wc = wid & 3, fr = lane & 15, fq = lane >> 4;
    const int K = g.K, nt = K / BK;
    unsigned voffA[2], voffB[2];
#pragma unroll
    for (int i = 0; i < 2; ++i) { int R, C; stage_rc(tid * 16 + i * 8192, R, C); const int Rb = Epi::PERM ? ((R & ~31) + perm32(R & 31)) : R;
        voffA[i] = (unsigned)(R * K + C) * 2u; voffB[i] = (unsigned)(Rb * K + C) * 2u; }
    const size_t kstep = (size_t)(BK * 2);
    const size_t hstep = (size_t)HALF * K * 2;
    const size_t tstep = 2 * hstep;
    const unsigned ldsw = (unsigned)wid * 1024u;
    const int aoff = lds_byte(wr * 64 + fr, fq * 8), boff = lds_byte(wc * 32 + fr, fq * 8);
#define PG8_SA(b, h) (((b) * 2 + (h)) * HTB)
#define PG8_SB(b, h) ((4 + (b) * 2 + (h)) * HTB)
#define PG8_STAGE(bufoff, gbase, voff) do { _Pragma("unroll") for (int _i = 0; _i < 2; ++_i) \
        __builtin_amdgcn_global_load_lds((const unsigned*)((const char*)(gbase) + (voff)[_i]), (PG8_LAS unsigned*)(lds + (bufoff) + ldsw + _i * 8192), 16, 0, 0); } while (0)
#define PG8_LDA(dst, b, h) do { _Pragma("unroll") for (int m = 0; m < 4; ++m) _Pragma("unroll") for (int k = 0; k < 2; ++k) dst[m][k] = *(const PG8_LAS bf16x8*)(lds + PG8_SA(b, h) + aoff + m * 2048 + k * 1024); } while (0)
#define PG8_LDB(dst, b, h) do { _Pragma("unroll") for (int n = 0; n < 2; ++n) _Pragma("unroll") for (int k = 0; k < 2; ++k) dst[n][k] = *(const PG8_LAS bf16x8*)(lds + PG8_SB(b, h) + boff + n * 2048 + k * 1024); } while (0)
#define PG8_MMA(ai, bj, At, Bt) do { __builtin_amdgcn_s_setprio(1); _Pragma("unroll") for (int m = 0; m < 4; ++m) _Pragma("unroll") for (int n = 0; n < 2; ++n) _Pragma("unroll") for (int k = 0; k < 2; ++k) \
        acc[ai][bj][m][n] = __builtin_amdgcn_mfma_f32_16x16x32_bf16(Bt[n][k], At[m][k], acc[ai][bj][m][n], 0, 0, 0); __builtin_amdgcn_s_setprio(0); } while (0)
#define PG8_WAIT_V(n) asm volatile("s_waitcnt vmcnt(" #n ")" ::: "memory")
#define PG8_WAIT_L(n) asm volatile("s_waitcnt lgkmcnt(" #n ")" ::: "memory")
#define PG8_BAR __builtin_amdgcn_s_barrier()
#define PG8_SCHED __builtin_amdgcn_sched_barrier(0)
    Unit cur, nxt; int ui = 0;
    if (!S.next(0, cur)) return;
    f32x4 acc[2][2][4][2];
#pragma unroll
    for (int a = 0; a < 2; ++a)
#pragma unroll
        for (int b = 0; b < 2; ++b)
#pragma unroll
            for (int m = 0; m < 4; ++m)
#pragma unroll
                for (int n = 0; n < 2; ++n) acc[a][b][m][n] = (f32x4){0.f, 0.f, 0.f, 0.f};
    bf16x8 At[4][2], B0[2][2], B1[2][2];
    const char* cA = (const char*)g.A + (size_t)cur.pm * tstep; const char* cB = (const char*)g.Bt + (size_t)cur.pn * tstep;
    S.a_ready(cur);
    if constexpr (SP2) {
        PG8_STAGE(PG8_SB(0, 0), cB, voffB); PG8_STAGE(PG8_SB(0, 1), cB + hstep, voffB); PG8_STAGE(PG8_SA(0, 0), cA, voffA); PG8_STAGE(PG8_SA(0, 1), cA + hstep, voffA);
        if (wr == 1) PG8_BAR;
        PG8_WAIT_V(2); PG8_BAR;
        PG8_STAGE(PG8_SB(1, 0), cB + kstep, voffB); PG8_STAGE(PG8_SA(1, 0), cA + kstep, voffA); PG8_STAGE(PG8_SB(1, 1), cB + hstep + kstep, voffB);
        PG8_WAIT_V(6); PG8_BAR;
    } else {
        PG8_STAGE(PG8_SB(0, 0), cB, voffB); PG8_STAGE(PG8_SA(0, 0), cA, voffA); PG8_STAGE(PG8_SB(0, 1), cB + hstep, voffB); PG8_STAGE(PG8_SA(0, 1), cA + hstep, voffA);
        if (wr == 1) PG8_BAR;
        PG8_WAIT_V(4); PG8_BAR;
        PG8_STAGE(PG8_SB(1, 0), cB + kstep, voffB); PG8_STAGE(PG8_SA(1, 0), cA + kstep, voffA); PG8_STAGE(PG8_SB(1, 1), cB + hstep + kstep, voffB);
        PG8_WAIT_V(6); PG8_BAR;
    }
    for (;;) {
        const bool has_next = S.next(ui + 1, nxt);
        const char* nA = has_next ? (const char*)g.A + (size_t)nxt.pm * tstep : cA; const char* nB = has_next ? (const char*)g.Bt + (size_t)nxt.pn * tstep : cB;
        for (int t = 0; t < nt; t += 2) {
            const bool last = (t == nt - 2);
            const char* a1 = cA + (size_t)(t + 1) * kstep;
            const char* a2 = last ? nA : cA + (size_t)(t + 2) * kstep; const char* b2 = last ? nB : cB + (size_t)(t + 2) * kstep;
            const char* a3 = a2 + kstep; const char* b3 = b2 + kstep;
            if (last && has_next) S.a_ready(nxt);
            if constexpr (SP2) {
            PG8_LDB(B0, 0, 0); PG8_LDB(B1, 0, 1); PG8_SCHED; PG8_LDA(At, 0, 0); PG8_STAGE(PG8_SA(1, 1), a1 + hstep, voffA);
            PG8_WAIT_V(8); PG8_WAIT_L(0); PG8_BAR; PG8_MMA(0, 0, At, B0); PG8_MMA(0, 1, At, B1); PG8_BAR; PG8_SCHED;
            PG8_LDA(At, 0, 1); PG8_STAGE(PG8_SB(0, 0), b2, voffB); PG8_STAGE(PG8_SB(0, 1), b2 + hstep, voffB); PG8_STAGE(PG8_SA(0, 0), a2, voffA);
            PG8_WAIT_V(8); PG8_WAIT_L(0); PG8_BAR; PG8_MMA(1, 0, At, B0); PG8_MMA(1, 1, At, B1); PG8_BAR; PG8_SCHED;
            PG8_LDB(B0, 1, 0); PG8_LDB(B1, 1, 1); PG8_SCHED; PG8_LDA(At, 1, 0); PG8_STAGE(PG8_SA(0, 1), a2 + hstep, voffA);
            PG8_WAIT_V(8); PG8_WAIT_L(0); PG8_BAR; PG8_MMA(0, 0, At, B0); PG8_MMA(0, 1, At, B1); PG8_BAR; PG8_SCHED;
            PG8_LDA(At, 1, 1); PG8_STAGE(PG8_SB(1, 0), b3, voffB); PG8_STAGE(PG8_SB(1, 1), b3 + hstep, voffB); PG8_STAGE(PG8_SA(1, 0), a3, voffA);
            PG8_WAIT_V(8); PG8_WAIT_L(0); PG8_BAR; PG8_MMA(1, 0, At, B0); PG8_MMA(1, 1, At, B1); PG8_BAR; PG8_SCHED;
            } else {
            PG8_LDB(B0, 0, 0); PG8_SCHED; PG8_LDA(At, 0, 0); PG8_STAGE(PG8_SA(1, 1), a1 + hstep, voffA);
            PG8_WAIT_L(8); PG8_BAR; PG8_WAIT_L(0); PG8_MMA(0, 0, At, B0); PG8_BAR; PG8_SCHED;
            PG8_LDB(B1, 0, 1); PG8_STAGE(PG8_SB(0, 0), b2, voffB);
            PG8_BAR; PG8_WAIT_L(0); PG8_MMA(0, 1, At, B1); PG8_BAR;
            PG8_LDA(At, 0, 1); PG8_STAGE(PG8_SA(0, 0), a2, voffA);
            PG8_BAR; PG8_WAIT_L(0); PG8_MMA(1, 0, At, B0); PG8_BAR; PG8_SCHED;
            PG8_STAGE(PG8_SB(0, 1), b2 + hstep, voffB);
            PG8_WAIT_V(6); PG8_BAR; PG8_MMA(1, 1, At, B1); PG8_BAR;
            PG8_LDB(B0, 1, 0); PG8_SCHED; PG8_LDA(At, 1, 0); PG8_STAGE(PG8_SA(0, 1), a2 + hstep, voffA);
            PG8_WAIT_L(8); PG8_BAR; PG8_WAIT_L(0); PG8_MMA(0, 0, At, B0); PG8_BAR; PG8_SCHED;
            PG8_LDB(B1, 1, 1); PG8_STAGE(PG8_SB(1, 0), b3, voffB);
            PG8_BAR; PG8_WAIT_L(0); PG8_MMA(0, 1, At, B1); PG8_BAR;
            PG8_LDA(At, 1, 1); PG8_STAGE(PG8_SA(1, 0), a3, voffA);
            PG8_BAR; PG8_WAIT_L(0); PG8_MMA(1, 0, At, B0); PG8_BAR; PG8_SCHED;
            PG8_STAGE(PG8_SB(1, 1), b3 + hstep, voffB);
            PG8_WAIT_V(6); PG8_BAR; PG8_MMA(1, 1, At, B1); PG8_BAR;
            }
        }
        if constexpr (ALIGN_EPI) { if (wr == 0) PG8_BAR; }
        if constexpr (!Epi::AFTER_DRAIN) { E(acc, cur, wr, wc, fr, fq); S.done(cur); }
        if (!has_next) break;
#pragma unroll
        for (int a = 0; a < 2; ++a)
#pragma unroll
            for (int b = 0; b < 2; ++b)
#pragma unroll
                for (int m = 0; m < 4; ++m)
#pragma unroll
                    for (int n = 0; n < 2; ++n) acc[a][b][m][n] = (f32x4){0.f, 0.f, 0.f, 0.f};
        cur = nxt; cA = nA; cB = nB; ++ui;
        if constexpr (ALIGN_EPI) { if (wr == 1) PG8_BAR; }
    }
    PG8_WAIT_V(0);
    if constexpr (!ALIGN_EPI) { if (wr == 0) PG8_BAR; }
    PG8_BAR;
    if constexpr (Epi::AFTER_DRAIN) { E.fused(acc, cur, wr, wc, fr, fq, lds, wid, lane); S.done(cur); }
#undef PG8_SA
#undef PG8_SB
#undef PG8_STAGE
#undef PG8_LDA
#undef PG8_LDB
#undef PG8_MMA
#undef PG8_WAIT_V
#undef PG8_WAIT_L
#undef PG8_BAR
#undef PG8_SCHED
}
}

struct Frame {
    LAS unsigned char* lds;
    int tid, lane, wave, G, bid;
    const float* in[N_IN];
    float* out;
    unsigned char* ws;
};

__device__ __forceinline__ void p0_transpose_item(const float* W, int K, int N, int ldn, bf16* WT, LAS float* scr, int item, int lane) {
    const int nblk = N / 32, kb = item / nblk, nb = item % nblk, k0 = 64 * kb, n0 = 32 * nb;
    float tv[32];
#pragma unroll
    for (int i = 0; i < 32; ++i) { const int kk = 2 * i + (lane >> 5); tv[i] = W[(size_t)(k0 + kk) * ldn + n0 + (lane & 31)]; }
#pragma unroll
    for (int i = 0; i < 32; ++i) { const int kk = 2 * i + (lane >> 5); scr[kk * 33 + (lane & 31)] = tv[i]; }
    LDS_WAIT(); asm volatile("" ::: "memory");
    const int c = lane & 7;
#pragma unroll
    for (int j = 0; j < 4; ++j) { const int n = (lane >> 3) + 8 * j; const LAS float* s = scr + (8 * c) * 33 + n;
        v4u o; o.x = pk2(s[0 * 33], s[1 * 33]); o.y = pk2(s[2 * 33], s[3 * 33]); o.z = pk2(s[4 * 33], s[5 * 33]); o.w = pk2(s[6 * 33], s[7 * 33]);
        *(GAS v4u*)(WT + (size_t)(n0 + n) * K + k0 + 8 * c) = o; }
    LDS_WAIT(); asm volatile("" ::: "memory");
}

__device__ __forceinline__ void p0_mod_item(Frame& F, int item) {
    LAS float* sc = (LAS float*)(F.lds);
    LAS float* red = (LAS float*)(F.lds + 16384);
    const float* c = F.in[I_C];
    for (int i = F.tid; i < 4096; i += 512) sc[i] = siluf_(c[i]);
    __syncthreads();
    const int l = item / 48, nb = item % 48, n = nb * 64 + F.lane;
    const float* W = F.in[I_ADAW] + (size_t)l * 1024 * 3072 + n;
    float a0 = 0.f, a1 = 0.f, a2 = 0.f, a3 = 0.f;
    const int kbase = F.wave * 128;
#pragma unroll 2
    for (int i0 = 0; i0 < 128; i0 += 16) { float w[16];
#pragma unroll
        for (int i = 0; i < 16; ++i) w[i] = W[(size_t)(kbase + i0 + i) * 3072];
#pragma unroll
        for (int i = 0; i < 16; ++i) { const int k = kbase + i0 + i; a0 += sc[k] * w[i]; a1 += sc[1024 + k] * w[i]; a2 += sc[2048 + k] * w[i]; a3 += sc[3072 + k] * w[i]; } }
    red[(F.wave * 4 + 0) * 64 + F.lane] = a0; red[(F.wave * 4 + 1) * 64 + F.lane] = a1; red[(F.wave * 4 + 2) * 64 + F.lane] = a2; red[(F.wave * 4 + 3) * 64 + F.lane] = a3;
    __syncthreads();
    if (F.tid < 256) { const int b = F.tid >> 6, nn = F.tid & 63; float s = 0.f;
#pragma unroll
        for (int w = 0; w < 8; ++w) s += red[(w * 4 + b) * 64 + nn];
        float* mod = (float*)(F.ws + WS_MOD);
        mod[(size_t)(l * 4 + b) * 3072 + nb * 64 + nn] = s + F.in[I_ADAB][l * 3072 + nb * 64 + nn]; }
    __syncthreads();
}

__device__ __forceinline__ void p0_s5_tables(Frame& F, int g, int part) {
    LAS float* pw = (LAS float*)(F.lds);
    LAS float* bb = (LAS float*)(F.lds + 34816);
    LAS float* cc = (LAS float*)(F.lds + 34816 + 8192);
    const float dt = __expf(F.in[I_S5LOGDT][g]);
    for (int i = F.tid; i < 65 * 64; i += 512) { const int tau = i >> 6, p = i & 63;
        const float ar = F.in[I_S5ARE][g * 64 + p], ai = F.in[I_S5AIM][g * 64 + p];
        const float mag = expf((float)tau * (dt * ar)); float sn, cs; sincosf((float)tau * (dt * ai), &sn, &cs);
        pw[2 * i] = mag * cs; pw[2 * i + 1] = mag * sn; }
    for (int i = F.tid; i < 64 * 16; i += 512) { const int p = i >> 4, m = i & 15;
        const float ar = F.in[I_S5ARE][g * 64 + p], ai = F.in[I_S5AIM][g * 64 + p];
        const float mag = expf(dt * ar); float sn, cs; sincosf(dt * ai, &sn, &cs);
        const float abr = mag * cs, abi = mag * sn, den = ar * ar + ai * ai;
        const float fr = ((abr - 1.0f) * ar + abi * ai) / den, fi = (abi * ar - (abr - 1.0f) * ai) / den;
        const float br = F.in[I_S5BRE][(size_t)(g * 64 + p) * 16 + m], bi = F.in[I_S5BIM][(size_t)(g * 64 + p) * 16 + m];
        bb[2 * i] = fr * br - fi * bi; bb[2 * i + 1] = fr * bi + fi * br; }
    for (int i = F.tid; i < 16 * 64; i += 512) { cc[2 * i] = F.in[I_S5CRE][(size_t)g * 1024 + i]; cc[2 * i + 1] = F.in[I_S5CIM][(size_t)g * 1024 + i]; }
    __syncthreads();
    if (part == 0 && F.tid < 64) { float* lam = (float*)(F.ws + WS_LAM); lam[(g * 64 + F.tid) * 2] = pw[2 * (64 * 64 + F.tid)]; lam[(g * 64 + F.tid) * 2 + 1] = pw[2 * (64 * 64 + F.tid) + 1]; }
    if (part == 0) { const int tau = F.tid >> 3, m0 = (F.tid & 7) * 2;
      float acc[2][16];
#pragma unroll
      for (int a = 0; a < 2; ++a)
#pragma unroll
          for (int b = 0; b < 16; ++b) acc[a][b] = 0.f;
      for (int p = 0; p < 64; ++p) { const float wr_ = pw[2 * (tau * 64 + p)], wi_ = pw[2 * (tau * 64 + p) + 1];
#pragma unroll
          for (int a = 0; a < 2; ++a) { const float cr = cc[2 * ((m0 + a) * 64 + p)], ci = cc[2 * ((m0 + a) * 64 + p) + 1];
              const float hr = cr * wr_ - ci * wi_, hi = cr * wi_ + ci * wr_;
#pragma unroll
              for (int b = 0; b < 16; ++b) acc[a][b] += hr * bb[2 * (p * 16 + b)] - hi * bb[2 * (p * 16 + b) + 1]; } }
      bf16* Kt = (bf16*)(F.ws + WS_KT) + (size_t)g * 64 * 256;
#pragma unroll
      for (int a = 0; a < 2; ++a) { unsigned* dst = (unsigned*)(Kt + (size_t)tau * 256 + (m0 + a) * 16);
#pragma unroll
          for (int b = 0; b < 8; ++b) dst[b] = pk2(acc[a][2 * b], acc[a][2 * b + 1]); } }
    if (part == 1 || part == 2) { unsigned* Et = (unsigned*)((bf16*)(F.ws + WS_ET) + (size_t)g * 128 * 1024);
      for (int i = (part - 1) * 64 * 512 + F.tid; i < part * 64 * 512; i += 512) { const int row = i >> 9, k = (i & 511) * 2, part = row >> 6, p = row & 63, t = k >> 4, m = k & 15;
          const float wr_ = pw[2 * ((63 - t) * 64 + p)], wi_ = pw[2 * ((63 - t) * 64 + p) + 1];
          const float b0r = bb[2 * (p * 16 + m)], b0i = bb[2 * (p * 16 + m) + 1], b1r = bb[2 * (p * 16 + m + 1)], b1i = bb[2 * (p * 16 + m + 1) + 1];
          const float v0 = part ? (wr_ * b0i + wi_ * b0r) : (wr_ * b0r - wi_ * b0i), v1 = part ? (wr_ * b1i + wi_ * b1r) : (wr_ * b1r - wi_ * b1i);
          Et[i] = pk2(v0, v1); } }
    if (part == 3) { unsigned* Ft = (unsigned*)((bf16*)(F.ws + WS_FT) + (size_t)g * 1024 * 128);
      for (int i = F.tid; i < 1024 * 64; i += 512) { const int row = i >> 6, pk = (i & 63) * 2, ti = row >> 4, m = row & 15, part = pk >> 6, p = pk & 63;
          float v[2];
#pragma unroll
          for (int e = 0; e < 2; ++e) { const float wr_ = pw[2 * ((ti + 1) * 64 + p + e)], wi_ = pw[2 * ((ti + 1) * 64 + p + e) + 1];
              const float cr = cc[2 * (m * 64 + p + e)], ci = cc[2 * (m * 64 + p + e) + 1];
              v[e] = part ? -(cr * wi_ + ci * wr_) : (cr * wr_ - ci * wi_); }
          Ft[i] = pk2(v[0], v[1]); } }
    __syncthreads();
}

__device__ __forceinline__ void p0_prologue(Frame& F) {
    if (F.bid < 96) p0_mod_item(F, F.bid);
    else if (F.bid < 224) p0_s5_tables(F, (F.bid - 96) >> 2, (F.bid - 96) & 3);
    __syncthreads();
    LAS float* scr = (LAS float*)(F.lds + F.wave * 16384);
    constexpr int I_A = 16 * 96, I_B = 16 * 32, I_C2 = 8 * 16, I_D = 16 * 128, I_E = 16 * 32;
    constexpr int NITEMS = I_A + I_B + I_C2 + I_D + I_E;
    const bool role = F.bid < 224; const int wv = role ? F.bid * 8 + F.wave : (F.bid - 224) * 8 + F.wave;
    for (int k = 0;; ++k) {
        const int it = role ? (k < 2 ? wv + 1792 * k : NITEMS) : 3584 + wv + 256 * k;
        if (it >= NITEMS) break;
        int r = it;
        if (r < I_A) { p0_transpose_item(F.in[I_ABWIN], 1024, 3072, 3072, (bf16*)(F.ws + WS_WIN0), scr, r, F.lane); continue; } r -= I_A;
        if (r < I_B) { p0_transpose_item(F.in[I_ABWOUT], 1024, 1024, 1024, (bf16*)(F.ws + WS_WOUT0), scr, r, F.lane); continue; } r -= I_B;
        if (r < I_C2) { p0_transpose_item(F.in[I_S5GLUW], 512, 512, 512, (bf16*)(F.ws + WS_WGLU), scr, r, F.lane); continue; } r -= I_C2;
        if (r < I_D) { p0_transpose_item(F.in[I_GDNWIN], 1024, 4096, C_IN, (bf16*)(F.ws + WS_WIN1), scr, r, F.lane); continue; } r -= I_D;
        p0_transpose_item(F.in[I_GDNWOUT], 1024, 1024, 1024, (bf16*)(F.ws + WS_WOUT1), scr, r, F.lane);
    }
    { bf16* we = (bf16*)(F.ws + WS_WEXT); const float* W = F.in[I_GDNWIN];
      for (int i = F.bid * 512 + F.tid; i < 16 * 1024; i += F.G * 512) { const int j = i >> 10, k = i & 1023; we[i] = (bf16)f2bf(W[(size_t)k * C_IN + 4096 + j]); } }
}

__device__ __forceinline__ void modnorm_row(const f32x4 (&v)[4], int lane, const float* g, const float* shift, const float* scale, bf16* orow) {
    float s = 0.f;
#pragma unroll
    for (int j = 0; j < 4; ++j) s += (v[j].x * v[j].x + v[j].y * v[j].y) + (v[j].z * v[j].z + v[j].w * v[j].w);
    const float r = rsqrtf(wave_sum(s) * (1.f / D) + EPS);
    GAS unsigned long long* o8 = (GAS unsigned long long*)orow + lane;
#pragma unroll
    for (int j = 0; j < 4; ++j) { const int c = 4 * lane + 256 * j;
        const f32x4 gg = *(const f32x4*)(g + c), sh = *(const f32x4*)(shift + c), sc = *(const f32x4*)(scale + c);
        const float h0 = v[j].x * r * gg.x * (1.f + sc.x) + sh.x, h1 = v[j].y * r * gg.y * (1.f + sc.y) + sh.y;
        const float h2 = v[j].z * r * gg.z * (1.f + sc.z) + sh.z, h3 = v[j].w * r * gg.w * (1.f + sc.w) + sh.w;
        o8[64 * j] = (unsigned long long)pk2(h0, h1) | ((unsigned long long)pk2(h2, h3) << 32); }
}
__device__ __forceinline__ void p1_modnorm(Frame& F, const float* x, int layer) {
    const int gw = F.bid * 8 + F.wave, NGW = F.G * 8;
    const float* mod = (const float*)(F.ws + WS_MOD) + (size_t)layer * 4 * 3072;
    bf16* H = (bf16*)(F.ws + WS_RA);
    for (int m = gw; m < M; m += NGW) { const int b = m >> 12;
        const GAS f32x4* xr = (const GAS f32x4*)(x + (size_t)m * D) + F.lane;
        f32x4 v[4];
#pragma unroll
        for (int j = 0; j < 4; ++j) v[j] = xr[64 * j];
        modnorm_row(v, F.lane, F.in[I_PREG] + layer * 1024, mod + b * 3072, mod + b * 3072 + 1024, H + (size_t)m * D); }
}
template <bool NEXT> __device__ __forceinline__ void p_residual(Frame& F, const float* xin, const bf16* y, float* xout, int layer) {
    const int gw = F.bid * 8 + F.wave, NGW = F.G * 8;
    const float* mod = (const float*)(F.ws + WS_MOD) + (size_t)layer * 4 * 3072;
    const float* modn = (const float*)(F.ws + WS_MOD) + (size_t)(layer + 1) * 4 * 3072;
    const float* pg = F.in[I_POSTG] + layer * 1024;
    bf16* H = (bf16*)(F.ws + WS_RA);
    for (int m = gw; m < M; m += NGW) { const int b = m >> 12;
        const GAS v2u* yr = (const GAS v2u*)(y + (size_t)m * D) + F.lane; const GAS f32x4* xr = (const GAS f32x4*)(xin + (size_t)m * D) + F.lane;
        f32x4 v[4], xv[4]; float s = 0.f;
#pragma unroll
        for (int j = 0; j < 4; ++j) { const v2u yw = yr[64 * j]; v[j] = (f32x4){bflo(yw.x), bfhi(yw.x), bflo(yw.y), bfhi(yw.y)}; xv[j] = xr[64 * j]; s += (v[j].x * v[j].x + v[j].y * v[j].y) + (v[j].z * v[j].z + v[j].w * v[j].w); }
        const float r = rsqrtf(wave_sum(s) * (1.f / D) + EPS);
        GAS f32x4* orow = (GAS f32x4*)(xout + (size_t)m * D) + F.lane;
#pragma unroll
        for (int j = 0; j < 4; ++j) { const int c = 4 * F.lane + 256 * j;
            const f32x4 gg = *(const f32x4*)(pg + c), gt = *(const f32x4*)(mod + b * 3072 + 2048 + c);
            xv[j].x += gt.x * (v[j].x * r * gg.x); xv[j].y += gt.y * (v[j].y * r * gg.y); xv[j].z += gt.z * (v[j].z * r * gg.z); xv[j].w += gt.w * (v[j].w * r * gg.w);
            orow[64 * j] = xv[j]; }
        if (NEXT) modnorm_row(xv, F.lane, F.in[I_PREG] + (layer + 1) * 1024, modn + b * 3072, modn + b * 3072 + 1024, H + (size_t)m * D);
    }
}

__constant__ unsigned char T5B[3][132] = {
{0,1,2,3,4,5,6,7,8,9,10,11,12,13,14,15,16,16,16,16,16,16,17,17,17,17,17,17,17,17,18,18,18,18,18,18,18,18,18,18,19,19,19,19,19,19,19,19,19,19,19,19,19,19,20,20,20,20,20,20,20,20,20,20,20,20,20,20,20,20,20,20,20,21,21,21,21,21,21,21,21,21,21,21,21,21,21,21,21,21,21,21,21,21,21,21,21,21,21,22,22,22,22,22,22,22,22,22,22,22,22,22,22,22,22,22,22,22,22,22,22,22,22,22,22,22,22,22,22,0,0,0},
{0,4,8,12,16,16,17,17,18,18,19,19,19,19,20,20,20,20,20,21,21,21,21,21,21,22,22,22,22,22,22,22,22,22,23,23,23,23,23,23,23,23,23,23,23,23,24,24,24,24,24,24,24,24,24,24,24,24,24,24,24,24,25,25,25,25,25,25,25,25,25,25,25,25,25,25,25,25,25,25,25,25,25,26,26,26,26,26,26,26,26,26,26,26,26,26,26,26,26,26,26,26,26,26,26,26,26,26,26,26,26,26,26,27,27,27,27,27,27,27,27,27,27,27,27,27,27,27,27,0,0,0},
{0,16,18,19,20,21,21,22,22,23,23,23,24,24,24,24,25,25,25,25,25,26,26,26,26,26,26,26,26,27,27,27,27,27,27,27,27,27,27,28,28,28,28,28,28,28,28,28,28,28,28,28,29,29,29,29,29,29,29,29,29,29,29,29,29,29,29,29,29,29,30,30,30,30,30,30,30,30,30,30,30,30,30,30,30,30,30,30,30,30,30,30,30,30,30,31,31,31,31,31,31,31,31,31,31,31,31,31,31,31,31,31,31,31,31,31,31,31,31,31,31,31,31,31,31,31,31,31,31,0,0,0}};

constexpr int ATT_ROWS = 432, ATT_K = 0, ATT_V = ATT_ROWS * 144, ATT_TB = 2 * ATT_ROWS * 144;
constexpr size_t ATT_PART = (size_t)M * 512;
struct AttStage { v4u kv[7], vv[7]; };
__device__ __forceinline__ void attn_stage_load(Frame& F, AttStage& S, int task) {
    const int ci = task >> 9, rem = task & 511, b = rem >> 7, h = (rem >> 4) & 7, cb = rem & 15, sh = 2 * ci, d = 1 << sh;
    const int cls = cb & (d - 1), blk = cb >> sh, nel = SEQ >> sh, e0 = 256 * blk - 128;
    const bf16* zb = (const bf16*)(F.ws + WS_RZ) + (size_t)b * SEQ * 3072;
#pragma unroll
    for (int k = 0; k < 7; ++k) { const int q = F.tid + 512 * k, row = q >> 3, ck = q & 7; int e = e0 + row; e = e < 0 ? 0 : (e > nel - 1 ? nel - 1 : e);
        const bf16* src = zb + (size_t)((e << sh) + cls) * 3072 + 512 + h * 64 + ck * 8;
        if (q < ATT_ROWS * 8) { S.kv[k] = *(const v4u*)src; S.vv[k] = *(const v4u*)(src + 512); } }
}
__device__ __forceinline__ void attn_stage_store(Frame& F, const AttStage& S, int task) {
    const int ci = task >> 9, h = ((task & 511) >> 4) & 7;
    LAS float* TB = (LAS float*)(F.lds + ATT_TB);
    if (F.tid < 256) { const int rel = F.tid - 96; TB[F.tid] = (rel >= 0 && rel <= 128) ? F.in[I_RELB][T5B[ci][rel] * 8 + h] * LOG2E : -1e30f; }
#pragma unroll
    for (int k = 0; k < 7; ++k) { const int q = F.tid + 512 * k, row = q >> 3, ck = q & 7;
        if (q < ATT_ROWS * 8) { *(LAS v4u*)(F.lds + ATT_K + row * 144 + ck * 16) = S.kv[k]; *(LAS v4u*)(F.lds + ATT_V + row * 144 + ck * 16) = S.vv[k]; } }
}
__device__ __forceinline__ void attn_compute(Frame& F, int task) {
    const int ci = task >> 9, rem = task & 511, b = rem >> 7, h = (rem >> 4) & 7, cb = rem & 15, sh = 2 * ci, d = 1 << sh;
    const int cls = cb & (d - 1), blk = cb >> sh, lane = F.lane, jq = lane & 15, g = lane >> 4;
    LAS float* TB = (LAS float*)(F.lds + ATT_TB);
    const bf16* zb = (const bf16*)(F.ws + WS_RZ) + (size_t)b * SEQ * 3072;
    const int e0 = 256 * blk - 128;
    bf16* part = (bf16*)F.out + (size_t)ci * ATT_PART; float* ml = (float*)((bf16*)F.out + 3 * ATT_PART) + (size_t)ci * M * 16;
    for (int it = 0; it < 2; ++it) {
        const int j = F.wave + 8 * it;
        const int qpos = ((256 * blk + 16 * j + jq) << sh) + cls;
        bf16x8 qf[2];
        { const bf16* qp = zb + (size_t)qpos * 3072 + h * 64 + 8 * g; qf[0] = *(const bf16x8*)qp; qf[1] = *(const bf16x8*)(qp + 32); }
        float mrun = -1e30f, lrun = 0.f; f32x4 o[4];
#pragma unroll
        for (int hb = 0; hb < 4; ++hb) o[hb] = (f32x4){0.f, 0.f, 0.f, 0.f};
#pragma unroll 1
        for (int st = 0; st < 3; ++st) {
            const int r0 = 16 * j + 64 * st;
            const LAS unsigned char* kb = F.lds + ATT_K + (r0 + jq) * 144 + 16 * g;
            f32x4 s[4];
#pragma unroll
            for (int tt = 0; tt < 4; ++tt) { s[tt] = (f32x4){0.f, 0.f, 0.f, 0.f};
                s[tt] = MFMA16(*(const LAS bf16x8*)(kb + tt * 16 * 144), qf[0], s[tt]); s[tt] = MFMA16(*(const LAS bf16x8*)(kb + tt * 16 * 144 + 64), qf[1], s[tt]); }
            const int relb = 128 + jq - 64 * st - 4 * g;
            const LAS float* tp = TB + 96 + relb - 63;
            const int rowlim = -e0 - r0 - 4 * g;
            float sv[16]; float tm = -1e30f;
#pragma unroll
            for (int e = 0; e < 16; ++e) { const int tt = e >> 2, rr = e & 3, off = 16 * tt + rr;
                float sc = s[tt][rr] * (0.125f * LOG2E) + tp[63 - off];
                sc = (off < rowlim) ? -1e30f : sc;
                sv[e] = sc; tm = fmaxf(tm, sc); }
            tm = fmaxf(tm, __shfl_xor(tm, 16)); tm = fmaxf(tm, __shfl_xor(tm, 32));
            if (__any(tm > mrun)) {
                const float mnew = fmaxf(mrun, tm), alpha = __builtin_amdgcn_exp2f(mrun - mnew); mrun = mnew; lrun *= alpha;
#pragma unroll
                for (int hb = 0; hb < 4; ++hb) o[hb] = o[hb] * alpha; }
            float ps = 0.f;
#pragma unroll
            for (int e = 0; e < 16; ++e) { sv[e] = __builtin_amdgcn_exp2f(sv[e] - mrun); ps += sv[e]; }
            lrun += ps;
            const lds_cptr va = (lds_cptr)(F.lds + ATT_V) + (r0 + 4 * g + (jq >> 2)) * 144 + 8 * (jq & 3);
#pragma unroll
            for (int hf = 0; hf < 2; ++hf) { v4u pw; pw.x = pk2(sv[8 * hf + 0], sv[8 * hf + 1]); pw.y = pk2(sv[8 * hf + 2], sv[8 * hf + 3]); pw.z = pk2(sv[8 * hf + 4], sv[8 * hf + 5]); pw.w = pk2(sv[8 * hf + 6], sv[8 * hf + 7]);
                const bf16x8 pf = __builtin_bit_cast(bf16x8, pw);
#pragma unroll
                for (int hb = 0; hb < 4; ++hb) { const s16x4 lo4 = vtr(va + 32 * hb + (32 * hf) * 144), hi4 = vtr(va + 32 * hb + (32 * hf + 16) * 144);
                    const bf16x8 vf = (bf16x8){lo4[0], lo4[1], lo4[2], lo4[3], hi4[0], hi4[1], hi4[2], hi4[3]};
                    o[hb] = MFMA16(vf, pf, o[hb]); } }
        }
        float lt = lrun + __shfl_xor(lrun, 16); lt += __shfl_xor(lt, 32);
        const size_t row = (size_t)b * SEQ + qpos;
#pragma unroll
        for (int hb = 0; hb < 4; ++hb) { v2u w; w.x = pk2(o[hb][0], o[hb][1]); w.y = pk2(o[hb][2], o[hb][3]); *(v2u*)(part + row * 512 + h * 64 + 16 * hb + 4 * g) = w; }
        if (g == 0) *(f32x2*)(ml + (row * 8 + h) * 2) = (f32x2){mrun, lt};
    }
}
__device__ __forceinline__ void attn_phase(Frame& F) {
    AttStage S;
    int t = F.bid; if (t >= 1536) return;
    attn_stage_load(F, S, t);
    for (; t < 1536; t += F.G) {
        __syncthreads();
        attn_stage_store(F, S, t);
        __syncthreads();
        if (t + F.G < 1536) attn_stage_load(F, S, t + F.G);
        attn_compute(F, t);
    }
}
__device__ __forceinline__ void attn_merge(Frame& F, int w0, int nw) {
    const int lane = F.lane, h = lane >> 3;
    const bf16* part = (const bf16*)F.out; const float* ml = (const float*)((const bf16*)F.out + 3 * ATT_PART);
    const bf16* z0 = (const bf16*)(F.ws + WS_RZ); bf16* O = (bf16*)(F.ws + WS_RA);
    for (int m = w0; m < M; m += nw) {
        v4u pv[3]; f32x2 mlv[3];
#pragma unroll
        for (int c = 0; c < 3; ++c) { pv[c] = *(const v4u*)(part + (size_t)c * ATT_PART + (size_t)m * 512 + lane * 8); mlv[c] = *(const f32x2*)(ml + (size_t)c * M * 16 + ((size_t)m * 8 + h) * 2); }
        const v4u gw = *(const v4u*)(z0 + (size_t)m * 3072 + 2048 + lane * 8);
        const float mm = fmaxf(fmaxf(mlv[0].x, mlv[1].x), mlv[2].x);
        const float w0_ = __builtin_amdgcn_exp2f(mlv[0].x - mm), w1_ = __builtin_amdgcn_exp2f(mlv[1].x - mm), w2_ = __builtin_amdgcn_exp2f(mlv[2].x - mm);
        const float inv = 1.0f / (w0_ * mlv[0].y + w1_ * mlv[1].y + w2_ * mlv[2].y);
        v4u ow;
#pragma unroll
        for (int e = 0; e < 4; ++e) { const float a = (w0_ * bflo(pv[0][e]) + w1_ * bflo(pv[1][e]) + w2_ * bflo(pv[2][e])) * inv, c2 = (w0_ * bfhi(pv[0][e]) + w1_ * bfhi(pv[1][e]) + w2_ * bfhi(pv[2][e])) * inv;
            ow[e] = pk2(a * siluf_(bflo(gw[e])), c2 * siluf_(bfhi(gw[e]))); }
        *(v4u*)(O + (size_t)m * 1024 + lane * 8) = ow; }
}

__device__ __forceinline__ void s5_pass1(Frame& F, int task) {
    const int g = task >> 6, ct = (task >> 2) & 15, kq = task & 3, n = F.lane & 15, gq = F.lane >> 4;
    const int cgi = ct * 16 + n, b = cgi >> 6, c = cgi & 63;
    const bf16* Et = (const bf16*)(F.ws + WS_ET) + (size_t)g * 128 * 1024 + (size_t)n * 1024 + 8 * gq + 256 * kq;
    const bf16* ub = (const bf16*)(F.ws + WS_RZ) + (size_t)(b * SEQ + c * 64 + 16 * kq) * 3072 + 1536 + g * 16 + 8 * (gq & 1);
    f32x4 acc[8];
#pragma unroll
    for (int st = 0; st < 8; ++st) acc[st] = (f32x4){0.f, 0.f, 0.f, 0.f};
#pragma unroll 2
    for (int s = 0; s < 8; ++s) { const int tok = 2 * s + (gq >> 1);
        const bf16x8 bfr = *(const bf16x8*)(ub + (size_t)tok * 3072);
#pragma unroll
        for (int st = 0; st < 8; ++st) { const bf16x8 afr = *(const bf16x8*)(Et + (size_t)st * 16 * 1024 + 32 * s); acc[st] = MFMA16(afr, bfr, acc[st]); } }
    float* SC = (float*)(F.ws + WS_SCQ) + (size_t)kq * (NB * 32 * 64 * 128) + (size_t)((b * 32 + g) * 64 + c) * 128 + 4 * gq;
#pragma unroll
    for (int st = 0; st < 8; ++st) *(f32x4*)(SC + 16 * st) = acc[st];
}
__device__ __forceinline__ void s5_carry(Frame& F) {
    const int idx = F.bid * 512 + F.tid; if (idx >= NB * 32 * 64) return;
    const int b = idx >> 11, g = (idx >> 6) & 31, p = idx & 63;
    const float* lam = (const float*)(F.ws + WS_LAM); const float lr = lam[(g * 64 + p) * 2], li = lam[(g * 64 + p) * 2 + 1];
    const float* sc = (const float*)(F.ws + WS_SCQ) + (size_t)((b * 32 + g) * 64) * 128 + p;
    float* xs = (float*)(F.ws + WS_XS) + (size_t)((b * 32 + g) * 64) * 128 + p;
    constexpr size_t QS = (size_t)NB * 32 * 64 * 128;
    float xr = 0.f, xi = 0.f;
#pragma unroll 8
    for (int c = 0; c < 64; ++c) { xs[c * 128] = xr; xs[c * 128 + 64] = xi;
        const float sr = (sc[c * 128] + sc[QS + c * 128]) + (sc[2 * QS + c * 128] + sc[3 * QS + c * 128]);
        const float si = (sc[c * 128 + 64] + sc[QS + c * 128 + 64]) + (sc[2 * QS + c * 128 + 64] + sc[3 * QS + c * 128 + 64]);
        const float nr = lr * xr - li * xi + sr, ni = lr * xi + li * xr + si; xr = nr; xi = ni; }
}
__device__ __forceinline__ void s5_pass2(Frame& F, int task) {
    const int g = task >> 3, ct = 2 * (task & 7) + (F.wave >> 2), q = F.wave & 3, n = F.lane & 15, gq = F.lane >> 4;
    __syncthreads();
    { const v4u* src = (const v4u*)((const bf16*)(F.ws + WS_KT) + (size_t)g * 64 * 256);
#pragma unroll
      for (int k = 0; k < 4; ++k) *(LAS v4u*)(F.lds + (F.tid + 512 * k) * 16) = src[F.tid + 512 * k]; }
    __syncthreads();
    const LAS unsigned char* KtL = F.lds + n * 32 + (gq & 1) * 16;
    const int cgi = ct * 16 + n, b = cgi >> 6, c = cgi & 63;
    const bf16* Ft = (const bf16*)(F.ws + WS_FT) + (size_t)g * 1024 * 128 + (size_t)n * 128 + 8 * gq;
    const float* XS = (const float*)(F.ws + WS_XS) + (size_t)((b * 32 + g) * 64 + c) * 128 + 8 * gq;
    const bf16* zrow = (const bf16*)(F.ws + WS_RZ) + (size_t)(b * SEQ + c * 64) * 3072 + 1536 + g * 16;
    f32x4 acc[16];
#pragma unroll
    for (int ii = 0; ii < 16; ++ii) acc[ii] = (f32x4){0.f, 0.f, 0.f, 0.f};
    for (int sp = 0; sp < 4; ++sp) { const f32x4 x0 = *(const f32x4*)(XS + 32 * sp), x1 = *(const f32x4*)(XS + 32 * sp + 4);
        v4u xw; xw.x = pk2(x0.x, x0.y); xw.y = pk2(x0.z, x0.w); xw.z = pk2(x1.x, x1.y); xw.w = pk2(x1.z, x1.w); const bf16x8 xf = __builtin_bit_cast(bf16x8, xw);
#pragma unroll
        for (int ii = 0; ii < 16; ++ii) { const int i = q + 4 * ii; const bf16x8 afr = *(const bf16x8*)(Ft + (size_t)i * 16 * 128 + 32 * sp); acc[ii] = MFMA16(afr, xf, acc[ii]); } }
    for (int s = 0; s < 32; ++s) { const int tok = 2 * s + (gq >> 1);
        const bf16x8 bfr = *(const bf16x8*)(zrow + (size_t)tok * 3072 + 8 * (gq & 1));
#pragma unroll
        for (int ii = 0; ii < 16; ++ii) { const int i = q + 4 * ii;
            if ((i >> 1) >= s) { const int tau = i - tok; const bf16x8 ld = *(const LAS bf16x8*)(KtL + (tau < 0 ? 0 : tau) * 512);
                const bf16x8 afr = tau < 0 ? (bf16x8){0, 0, 0, 0, 0, 0, 0, 0} : ld; acc[ii] = MFMA16(afr, bfr, acc[ii]); } } }
    const f32x4 dsk = *(const f32x4*)(F.in[I_S5D] + g * 16 + 4 * gq);
    bf16* YB = (bf16*)(F.ws + WS_YB) + (size_t)(b * SEQ + c * 64) * 512 + g * 16 + 4 * gq;
#pragma unroll
    for (int ii = 0; ii < 16; ++ii) { const int i = q + 4 * ii; const v2u uw = *(const v2u*)(zrow + (size_t)i * 3072 + 4 * gq);
        const float y0 = gelu_tanh(acc[ii][0] + dsk.x * bflo(uw.x)), y1 = gelu_tanh(acc[ii][1] + dsk.y * bfhi(uw.x));
        const float y2 = gelu_tanh(acc[ii][2] + dsk.z * bflo(uw.y)), y3 = gelu_tanh(acc[ii][3] + dsk.w * bfhi(uw.y));
        v2u w; w.x = pk2(y0, y1); w.y = pk2(y2, y3); *(v2u*)(YB + (size_t)i * 512) = w; }
}

__device__ __forceinline__ int perm_pos(int o) { return (o & ~31) | (((o >> 2) & 3) << 3) | (((o >> 4) & 1) << 2) | (o & 3); }

__device__ __forceinline__ void gdn_extras_item(Frame& F, int item) {
    if (F.wave >= 4) return;
    const int n = F.lane & 15, g = F.lane >> 4, row0 = item * 64 + F.wave * 16;
    const bf16* A = (const bf16*)(F.ws + WS_RA) + (size_t)(row0 + n) * 1024 + 8 * g;
    const bf16* B = (const bf16*)(F.ws + WS_WEXT) + (size_t)n * 1024 + 8 * g;
    f32x4 acc0 = (f32x4){0.f, 0.f, 0.f, 0.f}, acc1 = acc0;
#pragma unroll 4
    for (int s = 0; s < 32; s += 2) { acc0 = MFMA16(*(const bf16x8*)(A + 32 * s), *(const bf16x8*)(B + 32 * s), acc0); acc1 = MFMA16(*(const bf16x8*)(A + 32 * s + 32), *(const bf16x8*)(B + 32 * s + 32), acc1); }
    float* ex = (float*)(F.ws + WS_EXTRA);
#pragma unroll
    for (int e = 0; e < 4; ++e) ex[(size_t)(row0 + 4 * g + e) * 16 + n] = acc0[e] + acc1[e];
}

#ifndef PREPREP
#define PREPREP 0
#endif
constexpr int GP_QS = 0, GP_KS = 17408, GP_VS = 34816, GP_LS = 52224, GP_LSLOT = 8448, GP_SM = GP_LS + 8 * GP_LSLOT;
constexpr int GP_TW = 6144;
__host__ __device__ constexpr int lrow_off(int i) { return 4 * (2 * (i >> 2) * (i >> 2) + (i >> 2) + ((i & 3) == 0 ? 0 : ((i & 3) == 1 ? (i >> 2) : ((i & 3) == 2 ? 2 * (i >> 2) + 1 : 3 * (i >> 2) + 2)))); }
template <int I0, int I1> __device__ __forceinline__ void inv_rows(float (&t)[64], f32x4 (&cur)[4], const LAS float* Ls, int lane) {
#pragma unroll
    for (int i = I0; i < I1; ++i) {
        float a0 = (i == lane) ? 1.f : 0.f, a1 = 0.f;
#pragma unroll
        for (int jb = 0; jb < (i + 15) / 16; ++jb) {
            const bool same = (jb + 1) * 16 < i; const int ni = same ? i : i + 1, njb = same ? jb + 1 : 0;
            f32x4 nxt[4];
#pragma unroll
            for (int q = 0; q < 4; ++q) nxt[q] = cur[q];
            if (ni < 64) {
#pragma unroll
                for (int q = 0; q < 4; ++q) if (16 * njb + 4 * q < ni) nxt[q] = *(const LAS f32x4*)(Ls + lrow_off(ni) + 16 * njb + 4 * q); }
            asm volatile("" ::: "memory");
#pragma unroll
            for (int q = 0; q < 4; ++q) { const int j = 16 * jb + 4 * q;
                if (j + 0 < i) a0 -= cur[q].x * t[j + 0];
                if (j + 1 < i) a1 -= cur[q].y * t[j + 1];
                if (j + 2 < i) a0 -= cur[q].z * t[j + 2];
                if (j + 3 < i) a1 -= cur[q].w * t[j + 3]; }
#pragma unroll
            for (int q = 0; q < 4; ++q) cur[q] = nxt[q];
        }
        t[i] = a0 + a1; asm volatile("" : "+v"(t[i]) :: "memory"); }
}
__device__ __forceinline__ void gdn_prep_batch(Frame& F, int batch) {
    const int b = batch >> 6, c = batch & 63, tid = F.tid, lane = F.lane, wave = F.wave;
    LAS unsigned char* L = F.lds;
    LAS float* bet = (LAS float*)(L + GP_SM); LAS float* gcs = bet + 512;
    bf16* z1 = (bf16*)(F.ws + WS_RZ);
    const size_t row0 = (size_t)b * SEQ + c * 64;
    const int n = lane & 15, g = lane >> 4;
    __syncthreads();
    { const float* ex = (const float*)(F.ws + WS_EXTRA) + (row0 + lane) * 16; const int h = wave;
      const float braw = ex[h], araw = ex[8 + h] + F.in[I_GDNDTB][h];
      const float sp = araw > 20.f ? araw : log1pf(expf(araw));
      float v = -expf(F.in[I_GDNALOG][h]) * sp;
#pragma unroll
      for (int o = 1; o < 64; o <<= 1) { const float u = __shfl_up(v, o); if (lane >= o) v += u; }
      const float glast = __shfl(v, 63);
      bet[h * 64 + lane] = 1.0f / (1.0f + expf(-braw)); gcs[h * 64 + lane] = v;
      float* egc = (float*)(F.ws + WS_EGC); egc[(row0 + lane) * 8 + h] = expf(v); egc[(size_t)M * 8 + (row0 + lane) * 8 + h] = expf(glast - v);
      if (lane == 0) ((float*)(F.ws + WS_DEC))[(b * 8 + h) * 64 + c] = expf(glast); }
    for (int h = 0; h < 8; ++h) {
        if (h) __syncthreads();
        for (int rp1_ = 0; rp1_ < ((PREPREP & 1) ? 2 : 1); ++rp1_) {
          const int tb = wave; const bool zero_head = (tb == 0) && (c == 0);
          const bf16* halo = (const bf16*)(F.ws + WS_HALO) + (size_t)(b * 64 + c - 1) * 3 * 3072;
          unsigned raw[3][11]; f32x2 cwt[3][4];
#pragma unroll
          for (int w3 = 0; w3 < 3; ++w3) { const int ch = w3 * 1024 + h * 128 + 2 * lane;
#pragma unroll
              for (int j = 0; j < 4; ++j) cwt[w3][j] = *(const f32x2*)(F.in[I_GDNCONV] + j * 3072 + ch);
#pragma unroll
              for (int r = 0; r < 11; ++r) { const int tl = 8 * tb - 3 + r;
                  const bf16* src = (tl >= 0) ? z1 + (row0 + tl) * 4096 + ch : halo + (size_t)(tl + 3) * 3072 + ch;
                  raw[w3][r] = (tl < 0 && zero_head) ? 0u : *(const unsigned*)src; } }
          asm volatile("" ::: "memory");
#pragma unroll
          for (int w3 = 0; w3 < 3; ++w3) {
              float s0[8], s1[8];
#pragma unroll
              for (int k = 0; k < 8; ++k) { float a0 = 0.f, a1 = 0.f;
#pragma unroll
                  for (int j = 0; j < 4; ++j) { a0 += cwt[w3][j].x * bflo(raw[w3][k + j]); a1 += cwt[w3][j].y * bfhi(raw[w3][k + j]); }
                  s0[k] = siluf_(a0); s1[k] = siluf_(a1); }
#pragma unroll
              for (int k = 0; k < 8; ++k) { float r = 1.0f;
                  if (w3 < 2) { const float ss = wave_sum(s0[k] * s0[k] + s1[k] * s1[k]); r = rsqrtf(ss + EPS) * (w3 == 0 ? 0.08838834764831845f : 1.0f); }
                  *(LAS unsigned*)(L + w3 * 17408 + (8 * tb + k) * 272 + 4 * lane) = pk2(s0[k] * r, s1[k] * r); } } }
        __syncthreads();
        for (int rp2_ = 0; rp2_ < ((PREPREP & 4) ? 2 : 1); ++rp2_) {
        { LAS float* Ls = (LAS float*)(L + GP_LS + h * GP_LSLOT);
#pragma unroll
          for (int x = 0; x < 2; ++x) { const int tl = wave + 8 * x, it = tl >> 2, jt = tl & 3;
              const int i = 16 * it + n, j0 = 16 * jt + 4 * g;
              bf16* aq = z1 + (row0 + i) * 4096 + 1024 + h * 128 + ((jt >> 1) * 32 + 8 * g + 4 * (jt & 1));
              if (jt > it) { *(v2u*)aq = (v2u){0u, 0u}; continue; }
              f32x4 kk = (f32x4){0.f, 0.f, 0.f, 0.f}, qk = kk;
#pragma unroll
              for (int s = 0; s < 4; ++s) { const bf16x8 af = *(const LAS bf16x8*)(L + GP_KS + (16 * jt + n) * 272 + 64 * s + 16 * g);
                  const bf16x8 bk = *(const LAS bf16x8*)(L + GP_KS + (16 * it + n) * 272 + 64 * s + 16 * g);
                  const bf16x8 bq = *(const LAS bf16x8*)(L + GP_QS + (16 * it + n) * 272 + 64 * s + 16 * g);
                  kk = MFMA16(af, bk, kk); qk = MFMA16(af, bq, qk); }
              const float gi = gcs[h * 64 + i], bi = bet[h * 64 + i]; f32x4 lv; float av[4];
#pragma unroll
              for (int e = 0; e < 4; ++e) { const int j = j0 + e; const float dcy = __expf(gi - gcs[h * 64 + j]);
                  lv[e] = (j < i) ? bi * kk[e] * dcy : 0.f; av[e] = (j <= i) ? qk[e] * dcy : 0.f; }
              if (j0 < i) { const int a4 = i >> 2, b4 = i & 3; const int ro = 4 * (2 * a4 * a4 + a4 + (b4 == 0 ? 0 : (b4 == 1 ? a4 : (b4 == 2 ? 2 * a4 + 1 : 3 * a4 + 2))));
                  *(LAS f32x4*)(Ls + ro + j0) = lv; }
              v2u w; w.x = pk2(av[0], av[1]); w.y = pk2(av[2], av[3]); *(v2u*)aq = w; } }
        for (int q = tid; q < 1024; q += 512) { const int t = q >> 4, ck = q & 15, J = ck >> 2, gg = ck & 3;
            const v2u lo = *(const LAS v2u*)(L + GP_QS + t * 272 + (32 * J + 4 * gg) * 2), hi = *(const LAS v2u*)(L + GP_QS + t * 272 + (32 * J + 16 + 4 * gg) * 2);
            *(v4u*)(z1 + (row0 + t) * 4096 + h * 128 + 32 * J + 8 * gg) = (v4u){lo.x, lo.y, hi.x, hi.y}; }
        { bf16* kT = (bf16*)(F.ws + WS_KTP) + (size_t)((b * 8 + h) * 64 + c) * 8192;
#pragma unroll
          for (int x = 0; x < 4; ++x) { const int op = wave + 8 * x, isv = op >> 4, db = (op >> 1) & 7, J = op & 1;
              const lds_cptr a = (lds_cptr)(L + (isv ? GP_VS : GP_KS)) + (32 * J + 4 * g + (n >> 2)) * 272 + (16 * db + 4 * (n & 3)) * 2;
              const s16x4 lo4 = vtr(a), hi4 = vtr(a + 16 * 272);
              const v4u val = __builtin_bit_cast(v4u, (bf16x8){lo4[0], lo4[1], lo4[2], lo4[3], hi4[0], hi4[1], hi4[2], hi4[3]});
              const int d = 16 * db + n;
              if (isv) *(v4u*)(z1 + (row0 + (d >> 1)) * 4096 + 2048 + h * 128 + (d & 1) * 64 + 32 * J + 8 * g) = val;
              else *(v4u*)(kT + (size_t)d * 64 + 32 * J + 8 * g) = val; } }
        }
    }
    VM_WAIT();
    __syncthreads();
    for (int rp3_ = 0; rp3_ < ((PREPREP & 2) ? 2 : 1); ++rp3_) { const int h = wave;
      const LAS float* Ls = (const LAS float*)(L + GP_LS + h * GP_LSLOT);
      float t[64];
      t[0] = (__lane_id() == 0) ? 1.f : 0.f;
      f32x4 cur[4];
      cur[0] = *(const LAS f32x4*)(Ls + lrow_off(1)); cur[1] = cur[0]; cur[2] = cur[0]; cur[3] = cur[0];
      int lane_o = lane; asm volatile("" : "+v"(lane_o));
      inv_rows<1, 16>(t, cur, Ls, lane_o); inv_rows<16, 32>(t, cur, Ls, lane_o); inv_rows<32, 48>(t, cur, Ls, lane_o); inv_rows<48, 64>(t, cur, Ls, lane_o);
      LAS unsigned char* TB = L + wave * GP_TW;
      const float bc = bet[h * 64 + lane], bw = bc * __expf(gcs[h * 64 + lane]);
      const int sc = lane >> 5, kp = (((lane >> 2) & 3) << 3) | (((lane >> 4) & 1) << 2) | (lane & 3);
      bf16* uT = (bf16*)(F.ws + WS_RA) + (size_t)((b * 8 + h) * 64 + c) * 8192;
      const bf16* kT = (const bf16*)(F.ws + WS_KTP) + (size_t)((b * 8 + h) * 64 + c) * 8192;
#pragma unroll
      for (int pass = 0; pass < 2; ++pass) {
          const float scl = pass ? bw : bc;
#pragma unroll
          for (int i = 0; i < 64; ++i) { const int it = i >> 4; if (it >= 2 || sc == 0) { const int blk = (it < 2) ? it : (2 + 2 * (it - 2) + sc);
              *(LAS bf16*)(TB + blk * 1024 + (i & 15) * 64 + kp * 2) = (bf16)(pk2(t[i] * scl, 0.f) & 0xffffu); } }
          asm volatile("s_waitcnt lgkmcnt(0)" ::: "memory");
#pragma unroll 1
          for (int d = 0; d < 8; ++d) {
              bf16x8 opf[2];
#pragma unroll
              for (int s = 0; s < 2; ++s) { const int dd = 16 * d + n;
                  opf[s] = pass ? *(const bf16x8*)(kT + (size_t)dd * 64 + 32 * s + 8 * g)
                                : *(const bf16x8*)(z1 + (row0 + (dd >> 1)) * 4096 + 2048 + h * 128 + (dd & 1) * 64 + 32 * s + 8 * g); }
#pragma unroll
              for (int it = 0; it < 4; ++it) { f32x4 acc = (f32x4){0.f, 0.f, 0.f, 0.f};
#pragma unroll
                  for (int s = 0; s < 2; ++s) { if (s == 1 && it < 2) continue; const int blk = (it < 2) ? it : (2 + 2 * (it - 2) + s);
                      const bf16x8 tf = *(const LAS bf16x8*)(TB + blk * 1024 + n * 64 + g * 16);
                      acc = pass ? MFMA16(opf[s], tf, acc) : MFMA16(tf, opf[s], acc); }
                  if (pass == 0) { v2u uw; uw.x = pk2(acc[0], acc[1]); uw.y = pk2(acc[2], acc[3]); *(v2u*)(uT + (size_t)(16 * d + n) * 64 + 16 * it + 4 * g) = uw; }
                  else { v2u ww; ww.x = pk2(-acc[0], -acc[1]); ww.y = pk2(-acc[2], -acc[3]);
                      *(v2u*)((bf16*)(F.ws + WS_WNEG) + (row0 + 16 * it + n) * 1024 + h * 128 + ((d >> 1) * 32 + 8 * g + 4 * (d & 1))) = ww; } } }
          asm volatile("s_waitcnt lgkmcnt(0)" ::: "memory");
      } }
}

constexpr int GS_W = 0, GS_Q = 17408, GS_K = 34816, GS_A = 53248, GS_U = 62464, GS_E = 64768, GS_BUF = 65536;
struct ScanRole { const bf16* src; size_t cstep, delta; int dst, ddelta; };
__device__ __forceinline__ ScanRole gdn_scan_role(Frame& F, int b, int h) {
    const int lw = F.wave - 1, lane = F.lane; const size_t rowb = (size_t)b * SEQ;
    const bf16* z1 = (const bf16*)(F.ws + WS_RZ);
    ScanRole R;
    int cpr, tpb, tix, dstride; size_t sstride; const bf16* base;
    if (lw < 2)      { base = (const bf16*)(F.ws + WS_WNEG) + rowb * 1024 + h * 128; sstride = 1024; cpr = 16; tpb = 128; tix = lw * 64 + lane; R.dst = GS_W; dstride = 272; R.cstep = 64 * 1024; }
    else if (lw < 4) { base = z1 + rowb * 4096 + h * 128; sstride = 4096; cpr = 16; tpb = 128; tix = (lw - 2) * 64 + lane; R.dst = GS_Q; dstride = 272; R.cstep = 64 * 4096; }
    else if (lw < 6) { base = (const bf16*)(F.ws + WS_KTP) + (size_t)((b * 8 + h) * 64) * 8192; sstride = 64; cpr = 8; tpb = 128; tix = (lw - 4) * 64 + lane; R.dst = GS_K; dstride = 144; R.cstep = 8192; }
    else             { base = z1 + rowb * 4096 + 1024 + h * 128; sstride = 4096; cpr = 8; tpb = 64; tix = lane; R.dst = GS_A; dstride = 144; R.cstep = 64 * 4096; }
    const int r0 = tix / cpr, ck = tix % cpr;
    R.src = base + (size_t)r0 * sstride + ck * 8; R.delta = (size_t)(tpb / cpr) * sstride;
    R.dst += r0 * dstride + ck * 16; R.ddelta = (tpb / cpr) * dstride;
    return R;
}
struct ScanLd { v4u v[8]; v4u u[2]; float e[3]; };
__device__ __forceinline__ void gdn_scan_load(Frame& F, ScanLd& L, const ScanRole& R, int b, int h, int c, int dv0) {
    const bf16* s = R.src + (size_t)c * R.cstep;
#pragma unroll
    for (int k = 0; k < 8; ++k) L.v[k] = *(const v4u*)(s + (size_t)k * R.delta);
    if (F.wave == 7) { const int lane = F.lane; const size_t row0 = (size_t)b * SEQ + c * 64;
        const bf16* uT = (const bf16*)(F.ws + WS_RA) + (size_t)((b * 8 + h) * 64 + c) * 8192 + (size_t)dv0 * 64 + (lane >> 3) * 64 + (lane & 7) * 8;
        L.u[0] = *(const v4u*)uT; L.u[1] = *(const v4u*)(uT + 8 * 64);
        const float* egc = (const float*)(F.ws + WS_EGC); L.e[0] = egc[(row0 + lane) * 8 + h]; L.e[1] = egc[(size_t)M * 8 + (row0 + lane) * 8 + h];
        L.e[2] = ((const float*)(F.ws + WS_DEC))[(b * 8 + h) * 64 + c]; }
}
__device__ __forceinline__ void gdn_scan_store(Frame& F, const ScanLd& L, const ScanRole& R, LAS unsigned char* buf) {
#pragma unroll
    for (int k = 0; k < 8; ++k) *(LAS v4u*)(buf + R.dst + k * R.ddelta) = L.v[k];
    if (F.wave == 7) { const int lane = F.lane;
        *(LAS v4u*)(buf + GS_U + (lane >> 3) * 144 + (lane & 7) * 16) = L.u[0]; *(LAS v4u*)(buf + GS_U + (8 + (lane >> 3)) * 144 + (lane & 7) * 16) = L.u[1];
        ((LAS float*)(buf + GS_E))[lane] = L.e[0]; ((LAS float*)(buf + GS_E))[64 + lane] = L.e[1]; if (lane == 0) ((LAS float*)(buf + GS_E))[128] = L.e[2]; }
}
__device__ __forceinline__ void gdn_scan_task(Frame& F, int task) {
    const int b = task >> 6, h = (task >> 3) & 7, dv0 = (task & 7) * 16, lane = F.lane, n = lane & 15, g = lane >> 4;
    __syncthreads();
    ScanLd LD; ScanRole RL = gdn_scan_role(F, b, h);
    if (F.wave != 0) { gdn_scan_load(F, LD, RL, b, h, 0, dv0); gdn_scan_store(F, LD, RL, F.lds); }
    __syncthreads();
    f32x4 S[8];
#pragma unroll
    for (int d = 0; d < 8; ++d) S[d] = (f32x4){0.f, 0.f, 0.f, 0.f};
    bf16* z1 = (bf16*)(F.ws + WS_RZ);
    for (int c = 0; c < 64; ++c) {
        LAS unsigned char* buf = F.lds + (c & 1) * GS_BUF;
        if (F.wave != 0) { if (c + 1 < 64) { gdn_scan_load(F, LD, RL, b, h, c + 1, dv0); gdn_scan_store(F, LD, RL, F.lds + ((c + 1) & 1) * GS_BUF); } }
        else {
            const float dec = ((const LAS float*)(buf + GS_E))[128];
            bf16x8 Sb[4];
#pragma unroll
            for (int kq = 0; kq < 4; ++kq) { v4u w; w.x = pk2(S[2 * kq][0], S[2 * kq][1]); w.y = pk2(S[2 * kq][2], S[2 * kq][3]); w.z = pk2(S[2 * kq + 1][0], S[2 * kq + 1][1]); w.w = pk2(S[2 * kq + 1][2], S[2 * kq + 1][3]); Sb[kq] = __builtin_bit_cast(bf16x8, w); }
            f32x4 vn[4];
#pragma unroll
            for (int it = 0; it < 4; ++it) { const v2u uw = *(const LAS v2u*)(buf + GS_U + n * 144 + (16 * it + 4 * g) * 2);
                f32x4 a = (f32x4){bflo(uw.x), bfhi(uw.x), bflo(uw.y), bfhi(uw.y)};
#pragma unroll
                for (int kq = 0; kq < 4; ++kq) a = MFMA16(*(const LAS bf16x8*)(buf + GS_W + (16 * it + n) * 272 + 64 * kq + 16 * g), Sb[kq], a);
                vn[it] = a; }
            asm volatile("" ::: "memory");
            bf16x8 Vb[2], Vs[2];
            const LAS float* eg = (const LAS float*)(buf + GS_E);
#pragma unroll
            for (int J = 0; J < 2; ++J) { const f32x4 a = vn[2 * J], c2 = vn[2 * J + 1];
                v4u w; w.x = pk2(a[0], a[1]); w.y = pk2(a[2], a[3]); w.z = pk2(c2[0], c2[1]); w.w = pk2(c2[2], c2[3]); Vb[J] = __builtin_bit_cast(bf16x8, w);
                const f32x4 e0 = *(const LAS f32x4*)(eg + 64 + 32 * J + 4 * g), e1 = *(const LAS f32x4*)(eg + 64 + 32 * J + 16 + 4 * g);
                v4u s; s.x = pk2(a[0] * e0.x, a[1] * e0.y); s.y = pk2(a[2] * e0.z, a[3] * e0.w); s.z = pk2(c2[0] * e1.x, c2[1] * e1.y); s.w = pk2(c2[2] * e1.z, c2[3] * e1.w); Vs[J] = __builtin_bit_cast(bf16x8, s); }
#pragma unroll
            for (int it = 0; it < 4; ++it) { f32x4 qo = (f32x4){0.f, 0.f, 0.f, 0.f};
#pragma unroll
                for (int kq = 0; kq < 4; ++kq) qo = MFMA16(Sb[kq], *(const LAS bf16x8*)(buf + GS_Q + (16 * it + n) * 272 + 64 * kq + 16 * g), qo);
                qo = qo * eg[16 * it + n];
#pragma unroll
                for (int J = 0; J < 2; ++J) { if (J == 1 && it < 2) continue; qo = MFMA16(Vb[J], *(const LAS bf16x8*)(buf + GS_A + (16 * it + n) * 144 + 64 * J + 16 * g), qo); }
                v2u w; w.x = pk2(qo[0], qo[1]); w.y = pk2(qo[2], qo[3]);
                *(v2u*)(z1 + ((size_t)b * SEQ + c * 64 + 16 * it + n) * 4096 + 2048 + h * 128 + dv0 + 4 * g) = w; }
            asm volatile("" ::: "memory");
#pragma unroll
            for (int d = 0; d < 8; ++d) { f32x4 a = S[d] * dec;
#pragma unroll
                for (int J = 0; J < 2; ++J) a = MFMA16(*(const LAS bf16x8*)(buf + GS_K + (16 * d + n) * 144 + 64 * J + 16 * g), Vs[J], a);
                S[d] = a; }
        }
        __syncthreads();
    }
}

__device__ __forceinline__ void gdn_outnorm(Frame& F) {
    const int gw = F.bid * 8 + F.wave, NGW = F.G * 8, lane = F.lane;
    const bf16* z1 = (const bf16*)(F.ws + WS_RZ); bf16* og = (bf16*)(F.ws + WS_RA);
    const float* ng = F.in[I_GDNNORMG] + (lane & 7) * 16;
    for (int m = gw; m < M; m += NGW) {
        const v4u o0 = *(const v4u*)(z1 + (size_t)m * 4096 + 2048 + lane * 16), o1 = *(const v4u*)(z1 + (size_t)m * 4096 + 2048 + lane * 16 + 8);
        const v4u g0 = *(const v4u*)(z1 + (size_t)m * 4096 + 3072 + lane * 16), g1 = *(const v4u*)(z1 + (size_t)m * 4096 + 3072 + lane * 16 + 8);
        float ov[16], gv[16];
#pragma unroll
        for (int e = 0; e < 4; ++e) { ov[2 * e] = bflo(o0[e]); ov[2 * e + 1] = bfhi(o0[e]); ov[8 + 2 * e] = bflo(o1[e]); ov[8 + 2 * e + 1] = bfhi(o1[e]);
            gv[2 * e] = bflo(g0[e]); gv[2 * e + 1] = bfhi(g0[e]); gv[8 + 2 * e] = bflo(g1[e]); gv[8 + 2 * e + 1] = bfhi(g1[e]); }
        float s = 0.f;
#pragma unroll
        for (int e = 0; e < 16; ++e) s += ov[e] * ov[e];
        s += __shfl_xor(s, 1); s += __shfl_xor(s, 2); s += __shfl_xor(s, 4);
        const float r = rsqrtf(s * (1.f / 128.f) + EPS);
        float rv[16];
#pragma unroll
        for (int e = 0; e < 16; ++e) rv[e] = ov[e] * r * ng[e] * siluf_(gv[e]);
        v4u w0, w1; w0.x = pk2(rv[0], rv[1]); w0.y = pk2(rv[2], rv[3]); w0.z = pk2(rv[4], rv[5]); w0.w = pk2(rv[6], rv[7]);
        w1.x = pk2(rv[8], rv[9]); w1.y = pk2(rv[10], rv[11]); w1.z = pk2(rv[12], rv[13]); w1.w = pk2(rv[14], rv[15]);
        *(v4u*)(og + (size_t)m * 1024 + lane * 16) = w0; *(v4u*)(og + (size_t)m * 1024 + lane * 16 + 8) = w1; }
}

struct Args { const float* in[N_IN]; float* out; unsigned char* ws; int ph_lo, ph_hi, rep_mask, pad; };
#ifndef REP_MASK
#define REP_MASK 0
#endif
#ifndef P3SUB
#define P3SUB 0
#endif
constexpr int NPH = 16;

__global__ void __launch_bounds__(512, 2) mega(Args args) {
    extern __shared__ __attribute__((aligned(16))) unsigned char lds[];
    cg::grid_group grid = cg::this_grid();
    Frame F;
    F.lds = (LAS unsigned char*)lds;
    F.tid = threadIdx.x; F.lane = F.tid & 63; F.wave = __builtin_amdgcn_readfirstlane(F.tid >> 6);
    F.G = gridDim.x; F.bid = blockIdx.x;
#pragma unroll
    for (int i = 0; i < N_IN; ++i) F.in[i] = args.in[i];
    F.out = args.out; F.ws = args.ws;
    const int lo = args.ph_lo, hi = args.ph_hi;
#ifdef PH_ONLY
#define IN(k) ((k) == PH_ONLY && lo <= (k) && (k) < hi)
#else
#define IN(k) (lo <= (k) && (k) < hi)
#endif
#define SEAM(k) do { if (IN(k) && IN((k) + 1)) xcd_barrier(bar); } while (0)
    volatile LAS unsigned* MISC = (volatile LAS unsigned*)(F.lds + LDS_BYTES - 256);
    if (F.tid < 64) MISC[F.tid] = 0u;
    __syncthreads();
    XcdBarrier bar = xcd_barrier_post((unsigned*)(F.ws + WS_CTL) + 4096, MISC + 8);
    if (lo < 0) grid.sync();
    const int gw = F.bid * 8 + F.wave, NGW = F.G * 8;
#ifdef TIME_PH
    unsigned long long tp0_ = 0, tp1_ = 0;
#define TSTAMP0(k) if ((k) == TIME_PH) tp0_ = __builtin_amdgcn_s_memrealtime();
#define TSTAMP1(k) if ((k) == TIME_PH) tp1_ = __builtin_amdgcn_s_memrealtime();
#else
#define TSTAMP0(k)
#define TSTAMP1(k)
#endif
#define RUNPH(k, ...) TSTAMP0(k) if (IN(k)) { { __VA_ARGS__ } if ((REP_MASK >> (k)) & 1) { xcd_barrier(bar); { __VA_ARGS__ } } } SEAM(k); TSTAMP1(k)

    RUNPH(0,  p0_prologue(F); )
    RUNPH(1,  p1_modnorm(F, F.in[I_X], 0); )
    RUNPH(2,  pg8::Gemm g{(const bf16*)(F.ws + WS_RA), (const bf16*)(F.ws + WS_WIN0), M, AB_IN, D}; pg8::StaticOrder S; S.init(M, AB_IN, F.G, F.bid);
        pg8::EpiBf16<false> E{(bf16*)(F.ws + WS_RZ), AB_IN, nullptr, 0};
        pg8::gemm_phase<pg8::EpiBf16<false>, pg8::StaticOrder, true, true>(F.lds, g, S, E); )
    RUNPH(3,  for (int r3_ = 0; r3_ < ((P3SUB & 1) ? 2 : 1); ++r3_) { for (int t = gw; t < 2048; t += NGW) s5_pass1(F, t); }
        for (int r3_ = 0; r3_ < ((P3SUB & 2) ? 2 : 1); ++r3_) { attn_phase(F); } )
    RUNPH(4,  s5_carry(F); if (F.bid >= 16) attn_merge(F, (F.bid - 16) * 8 + F.wave, (F.G - 16) * 8); )
    RUNPH(5,  for (int t = F.bid; t < 256; t += F.G) s5_pass2(F, t); )
    RUNPH(6,  pg8::Gemm g{(const bf16*)(F.ws + WS_YB), (const bf16*)(F.ws + WS_WGLU), M, 512, 512}; pg8::StaticOrder S; S.init(M, 512, F.G, F.bid);
        pg8::EpiGlu E{(const bf16*)(F.ws + WS_YB), (const bf16*)(F.ws + WS_RZ), F.in[I_S5GLUB], (bf16*)(F.ws + WS_RA)};
        pg8::gemm_phase<pg8::EpiGlu, pg8::StaticOrder, true, true>(F.lds, g, S, E); )
    RUNPH(7,  pg8::Gemm g{(const bf16*)(F.ws + WS_RA), (const bf16*)(F.ws + WS_WOUT0), M, D, D}; pg8::StaticOrder S; S.init(M, D, F.G, F.bid);
        pg8::EpiBf16<false> E{(bf16*)(F.ws + WS_RZ), D, nullptr, 0};
        pg8::gemm_phase<pg8::EpiBf16<false>, pg8::StaticOrder, true, true>(F.lds, g, S, E); )
    RUNPH(8,  p_residual<true>(F, F.in[I_X], (const bf16*)(F.ws + WS_RZ), F.out, 0); )
    RUNPH(9,  for (int t = F.bid; t < 256; t += F.G) gdn_extras_item(F, t);
        pg8::Gemm g{(const bf16*)(F.ws + WS_RA), (const bf16*)(F.ws + WS_WIN1), M, 4096, D}; pg8::StaticOrder S; S.init(M, 4096, F.G, F.bid);
        pg8::EpiBf16<true> E{(bf16*)(F.ws + WS_RZ), 4096, (bf16*)(F.ws + WS_HALO), 3072};
        pg8::gemm_phase<pg8::EpiBf16<true>, pg8::StaticOrder, true, true>(F.lds, g, S, E); )
    RUNPH(10,  for (int t = F.bid; t < 256; t += F.G) gdn_prep_batch(F, t); )
    RUNPH(11,  for (int t = F.bid; t < 256; t += F.G) { const int tt = (F.G == 256) ? (((t & 7) * 4 + (t >> 6)) * 8 + ((t >> 3) & 7)) : t; gdn_scan_task(F, tt); }     )
    RUNPH(12,  gdn_outnorm(F); )
    RUNPH(13,  pg8::Gemm g{(const bf16*)(F.ws + WS_RA), (const bf16*)(F.ws + WS_WOUT1), M, D, D}; pg8::StaticOrder S; S.init(M, D, F.G, F.bid);
        pg8::EpiBf16<false> E{(bf16*)(F.ws + WS_RZ), D, nullptr, 0};
        pg8::gemm_phase<pg8::EpiBf16<false>, pg8::StaticOrder, true, true>(F.lds, g, S, E); )
    RUNPH(14,  p_residual<false>(F, F.out, (const bf16*)(F.ws + WS_RZ), F.out, 1); )
#ifdef TIME_PH
    if (F.bid == 0) { __syncthreads(); if (F.tid == 0) F.out[0] = (float)(tp1_ - tp0_) * 0.01f; }
#endif
#undef IN
#undef SEAM
}

extern "C" void kernel_launch(void* const* d_in, const int* in_sizes, int n_in, void* d_out, int out_size, void* d_ws, size_t ws_size, hipStream_t stream) {
    static int grid = 0;
    if (grid == 0) {
        if (n_in != N_IN || out_size != M * D || ws_size < WS_END) { fprintf(stderr, "kernel_launch: unexpected shapes n_in %d out %d ws %zu\n", n_in, out_size, ws_size); grid = -1; return; }
        int dev = 0, cus = 0, per_cu = 0;
        if (hipGetDevice(&dev) != hipSuccess || hipDeviceGetAttribute(&cus, hipDeviceAttributeMultiprocessorCount, dev) != hipSuccess) { grid = -1; return; }
        if (hipFuncSetAttribute((const void*)mega, hipFuncAttributeMaxDynamicSharedMemorySize, LDS_BYTES) != hipSuccess) { fprintf(stderr, "hipFuncSetAttribute failed\n"); grid = -1; return; }
        if (hipOccupancyMaxActiveBlocksPerMultiprocessor(&per_cu, (const void*)mega, 512, LDS_BYTES) != hipSuccess || per_cu < 1) { fprintf(stderr, "occupancy query: %d\n", per_cu); per_cu = 1; }
        (void)hipGetLastError();
        grid = cus;
        fprintf(stderr, "kernel_launch: grid %d (per_cu %d)\n", grid, per_cu);
    }
    if (grid < 0) return;
    if (hipMemsetAsync((char*)d_ws + WS_CTL, 0, 65536, stream) != hipSuccess) { fprintf(stderr, "memset failed\n"); return; }
    Args a{};
    for (int i = 0; i < N_IN; ++i) a.in[i] = (const float*)d_in[i];
    a.out = (float*)d_out; a.ws = (unsigned char*)d_ws;
#ifdef MULTI_LAUNCH
    for (int p = 0; p < NPH; ++p) { a.ph_lo = p; a.ph_hi = p + 1; void* kargs[] = {&a};
        hipError_t e = hipLaunchCooperativeKernel((const void*)mega, dim3(grid), dim3(512), kargs, LDS_BYTES, stream);
        if (e != hipSuccess) { fprintf(stderr, "launch %d failed: %s\n", p, hipGetErrorString(e)); break; } }
#else
    a.ph_lo = 0; a.ph_hi = NPH; a.rep_mask = REP_MASK; void* kargs[] = {&a};
    hipError_t e = hipLaunchCooperativeKernel((const void*)mega, dim3(grid), dim3(512), kargs, LDS_BYTES, stream);
    if (e != hipSuccess) fprintf(stderr, "cooperative launch failed: %s (grid %d)\n", hipGetErrorString(e), grid);
#endif
}
```
